# Optimizing an MI355X kernel written in HIP

```python
import jax, jax.numpy as jnp
from jax import lax
import numpy as np

D_MODEL = 2048
BATCH = 2
SEQ = 16384
DEPTH = 2

N_HEADS = 16
HEAD_DIM = D_MODEL // N_HEADS
GRID_W = 64
WIN_ROWS = 8
WIN_COLS = 16
N_META = 16
CONV_W = 3
D_FF = 7 * D_MODEL // 2
N_EXPERTS = 8
TOP_K = 2
D_EXPERT = 7 * D_MODEL // 2
MOE_BLOCK = 1024
N_MIXERS = 2
RMS_EPS = 1e-6
N_ATTN_LAYERS = (DEPTH + 1) // 2
N_CONV_LAYERS = DEPTH // 2
N_DENSE_LAYERS = (DEPTH + 1) // 2
N_MOE_LAYERS = DEPTH // 2

kernel_name = "hybrid_natten_shortconv_moe_encoder"


def rms_norm(x, g):
    xf = x.astype(jnp.float32)
    y = xf * lax.rsqrt(jnp.mean(xf * xf, axis=-1, keepdims=True) + RMS_EPS)
    return (y * g.astype(jnp.float32)).astype(x.dtype)


def neighbourhood_attention(h, w_qkv, q_gain, k_gain, rel_bias, meta_bias, w_o):
    b, L, d = h.shape
    n_tok = L - N_META
    rows = n_tok // GRID_W
    kr = min(WIN_ROWS, rows)
    qkv = (h @ w_qkv).reshape(b, L, 3, N_HEADS, HEAD_DIM)
    q = rms_norm(qkv[:, :, 0], q_gain) * (HEAD_DIM ** -0.5)
    k = rms_norm(qkv[:, :, 1], k_gain)
    v = qkv[:, :, 2]
    q_m, k_m, v_m = q[:, :N_META], k[:, :N_META], v[:, :N_META]

    def to_grid(t):
        return t[:, N_META:].reshape(b, rows, GRID_W, N_HEADS, HEAD_DIM)

    q_g, k_g, v_g = to_grid(q), to_grid(k), to_grid(v)

    s_mm = jnp.einsum('bqhd,bmhd->bhqm', q_m, k_m).astype(jnp.float32) + meta_bias[None, :, None, :]
    p_mm = jax.nn.softmax(s_mm, axis=-1).astype(v.dtype)
    o_m = jnp.einsum('bhqm,bmhd->bqhd', p_mm, v_m).reshape(b, N_META, d)

    cols = np.arange(GRID_W)
    col_start = np.clip(cols - WIN_COLS // 2, 0, GRID_W - WIN_COLS)
    col_idx = col_start[:, None] + np.arange(WIN_COLS)[None, :]
    dc_idx = col_idx - cols[:, None] + (WIN_COLS - 1)
    n_loc = kr * WIN_COLS

    def row_attend(args):
        r, q_row = args
        r0 = jnp.clip(r - WIN_ROWS // 2, 0, rows - kr)
        k_rows = lax.dynamic_slice_in_dim(k_g, r0, kr, axis=1)
        v_rows = lax.dynamic_slice_in_dim(v_g, r0, kr, axis=1)
        k_sel = k_rows[:, :, col_idx]
        v_sel = v_rows[:, :, col_idx]
        dr_idx = r0 + jnp.arange(kr) - r + (WIN_ROWS - 1)
        bias = rel_bias[:, dr_idx[:, None, None], dc_idx[None]]
        s_loc = jnp.einsum('bqhd,biqjhd->bhqij', q_row, k_sel).astype(jnp.float32)
        s_loc = (s_loc + bias.transpose(0, 2, 1, 3)[None]).reshape(b, N_HEADS, GRID_W, n_loc)
        s_met = jnp.einsum('bqhd,bmhd->bhqm', q_row, k_m).astype(jnp.float32) + meta_bias[None, :, None, :]
        p = jax.nn.softmax(jnp.concatenate([s_loc, s_met], axis=-1), axis=-1).astype(v_g.dtype)
        p_loc = p[..., :n_loc].reshape(b, N_HEADS, GRID_W, kr, WIN_COLS)
        p_met = p[..., n_loc:]
        return (jnp.einsum('bhqij,biqjhd->bqhd', p_loc, v_sel)
                + jnp.einsum('bhqm,bmhd->bqhd', p_met, v_m))

    o_g = lax.map(row_attend, (jnp.arange(rows), jnp.moveaxis(q_g, 1, 0)))
    o_g = jnp.moveaxis(o_g, 0, 1).reshape(b, n_tok, d)
    return jnp.concatenate([o_m, o_g], axis=1) @ w_o


def short_conv_mixer(h, w_in, conv_w, w_out):
    L = h.shape[1]
    bg, cg, u = jnp.split(h @ w_in, 3, axis=-1)
    z = cg * u
    pad = CONV_W // 2
    zp = jnp.pad(z, ((0, 0), (pad, pad), (0, 0)))
    y = sum(zp[:, j:j + L] * conv_w[:, j] for j in range(CONV_W))
    return (bg * y) @ w_out


def swiglu(h, w_gate, w_up, w_down):
    return (jax.nn.silu(h @ w_gate) * (h @ w_up)) @ w_down


def moe_swiglu(h, w_router, w_gate, w_up, w_down):
    b, L, d = h.shape
    n = b * L
    xf = h.reshape(n, d)
    logits = (xf @ w_router).astype(jnp.float32)
    top_logit, top_e = lax.top_k(logits, TOP_K)
    gates = jax.nn.softmax(top_logit, axis=-1)
    flat_e = top_e.reshape(-1)
    flat_tok = jnp.arange(n * TOP_K) // TOP_K
    order = jnp.argsort(flat_e)
    sorted_e = flat_e[order]
    sorted_tok = flat_tok[order]
    counts = jnp.bincount(flat_e, length=N_EXPERTS)
    group_start = jnp.cumsum(counts) - counts
    padded = (counts + MOE_BLOCK - 1) // MOE_BLOCK * MOE_BLOCK
    padded_end = jnp.cumsum(padded)
    padded_start = padded_end - padded
    dest = padded_start[sorted_e] + (jnp.arange(n * TOP_K) - group_start[sorted_e])
    n_blocks = -(-(n * TOP_K) // MOE_BLOCK) + N_EXPERTS
    total = n_blocks * MOE_BLOCK
    buf_tok = jnp.full((total,), n, dtype=jnp.int32).at[dest].set(sorted_tok.astype(jnp.int32))
    x_ext = jnp.concatenate([xf, jnp.zeros((1, d), xf.dtype)], axis=0)
    x_buf = x_ext[buf_tok].reshape(n_blocks, MOE_BLOCK, d)
    block_e = jnp.minimum(jnp.searchsorted(padded_end, jnp.arange(n_blocks) * MOE_BLOCK, side='right'),
                          N_EXPERTS - 1)

    def expert_block(args):
        xb, e = args
        return (jax.nn.silu(xb @ w_gate[e]) * (xb @ w_up[e])) @ w_down[e]

    y_buf = lax.map(expert_block, (x_buf, block_e)).reshape(total, d)
    w_assign = gates.reshape(-1)[order].astype(h.dtype)
    y = jax.ops.segment_sum(y_buf[dest] * w_assign[:, None], sorted_tok, num_segments=n)
    return y.reshape(b, L, d)


def setup_inputs(seed: int = 0) -> dict:
    key = jax.random.key(seed)
    ks = jax.random.split(key, 24)
    D = D_MODEL

    def nrm(k, shape, fan_in):
        return jax.random.normal(k, shape, jnp.float32) * (fan_in ** -0.5)

    def gain(k, shape):
        return 1.0 + 0.02 * jax.random.normal(k, shape, jnp.float32)

    return {
        "x": jax.random.normal(ks[0], (BATCH, SEQ, D), jnp.float32),
        "meta_tokens": jax.random.normal(ks[1], (N_META, D), jnp.float32),
        "attn_norm": gain(ks[2], (N_ATTN_LAYERS, D)),
        "w_qkv": nrm(ks[3], (N_ATTN_LAYERS, D, 3 * D), D),
        "q_gain": gain(ks[4], (N_ATTN_LAYERS, HEAD_DIM)),
        "k_gain": gain(ks[5], (N_ATTN_LAYERS, HEAD_DIM)),
        "rel_bias": 0.1 * jax.random.normal(ks[6], (N_ATTN_LAYERS, N_HEADS, 2 * WIN_ROWS - 1, 2 * WIN_COLS - 1), jnp.float32),
        "meta_bias": 0.1 * jax.random.normal(ks[7], (N_ATTN_LAYERS, N_HEADS, N_META), jnp.float32),
        "w_o": nrm(ks[8], (N_ATTN_LAYERS, D, D), D),
        "conv_norm": gain(ks[9], (N_CONV_LAYERS, D)),
        "w_in": nrm(ks[10], (N_CONV_LAYERS, D, 3 * D), D),
        "conv_w": nrm(ks[11], (N_CONV_LAYERS, D, CONV_W), CONV_W),
        "w_out": nrm(ks[12], (N_CONV_LAYERS, D, D), D),
        "dense_norm": gain(ks[13], (N_DENSE_LAYERS, D)),
        "w_gate": nrm(ks[14], (N_DENSE_LAYERS, D, D_FF), D),
        "w_up": nrm(ks[15], (N_DENSE_LAYERS, D, D_FF), D),
        "w_down": nrm(ks[16], (N_DENSE_LAYERS, D_FF, D), D_FF),
        "moe_norm": gain(ks[17], (N_MOE_LAYERS, D)),
        "w_router": nrm(ks[18], (N_MOE_LAYERS, D, N_EXPERTS), D),
        "moe_gate": nrm(ks[19], (N_MOE_LAYERS, N_EXPERTS, D, D_EXPERT), D),
        "moe_up": nrm(ks[20], (N_MOE_LAYERS, N_EXPERTS, D, D_EXPERT), D),
        "moe_down": nrm(ks[21], (N_MOE_LAYERS, N_EXPERTS, D_EXPERT, D), D_EXPERT),
    }


def reference(x, meta_tokens, attn_norm, w_qkv, q_gain, k_gain, rel_bias, meta_bias, w_o,
              conv_norm, w_in, conv_w, w_out, dense_norm, w_gate, w_up, w_down,
              moe_norm, w_router, moe_gate, moe_up, moe_down):
    b = x.shape[0]
    meta = jnp.broadcast_to(meta_tokens[None].astype(x.dtype), (b, N_META, D_MODEL))
    h = jnp.concatenate([meta, x], axis=1)
    for i in range(DEPTH):
        j = i // N_MIXERS
        if i % N_MIXERS == 0:
            h = h + neighbourhood_attention(rms_norm(h, attn_norm[j]), w_qkv[j], q_gain[j], k_gain[j],
                                            rel_bias[j], meta_bias[j], w_o[j])
        else:
            h = h + short_conv_mixer(rms_norm(h, conv_norm[j]), w_in[j], conv_w[j], w_out[j])
        f = i // 2
        if i % 2 == 0:
            h = h + swiglu(rms_norm(h, dense_norm[f]), w_gate[f], w_up[f], w_down[f])
        else:
            h = h + moe_swiglu(rms_norm(h, moe_norm[f]), w_router[f], moe_gate[f], moe_up[f], moe_down[f])
    return h[:, N_META:]
```

```cpp
#include <hip/hip_runtime.h>
#include <cstdio>
#include <cstdint>

#ifndef MK_N_LAUNCHES
#define MK_N_LAUNCHES 1
#endif

#define LAS __attribute__((address_space(3)))
#define GAS __attribute__((address_space(1)))
typedef unsigned short bf16_t;
typedef short bf16x8 __attribute__((ext_vector_type(8)));
typedef short bf16x4 __attribute__((ext_vector_type(4)));
typedef float f32x4 __attribute__((ext_vector_type(4)));
typedef float f32x2 __attribute__((ext_vector_type(2)));
typedef unsigned u32x4 __attribute__((ext_vector_type(4)));
typedef unsigned u32x2 __attribute__((ext_vector_type(2)));
typedef int i32x4 __attribute__((ext_vector_type(4)));
typedef int i32x8 __attribute__((ext_vector_type(8)));

constexpr int D = 2048, NB = 2, SEQ = 16384, M = NB * SEQ, NMETA = 16, NH = 16, HD = 128, GW = 64, GR = 256;
constexpr int FF = 7168, NE = 8, NQKV = 3 * D, NGU = 2 * FF;
constexpr float RMS_EPS = 1e-6f;
constexpr float LOG2E = 1.4426950408889634f;
constexpr int NWAVES = 8, NTHREADS = 512;
constexpr int MAXTILES = 264;

constexpr size_t MiB = 1u << 20;
constexpr size_t WS_CTL = 0, CTL_ZERO_BYTES = 64 * 1024;
constexpr size_t WS_META = 1 * MiB;
constexpr size_t MT_QKV = WS_META, MT_O = MT_QKV + 16 * NQKV * 4, MT_H1 = MT_O + 16 * D * 4, MT_GU = MT_H1 + 16 * D * 4, MT_H2 = MT_GU + 16 * NGU * 4,
                 MT_CGU = MT_H2 + 16 * D * 4, MT_END = MT_CGU + 16 * 2 * D * 4;
static_assert(MT_END <= 3 * MiB, "meta scratch");
constexpr size_t WS_RS1 = 5 * MiB + 512 * 1024, WS_RS2 = WS_RS1 + (size_t)M * 8 * 4;
constexpr size_t WS_MOE = 4 * MiB;
constexpr size_t MO_TOKE = WS_MOE, MO_TOKG = MO_TOKE + (size_t)M * 8, MO_CNT = MO_TOKG + (size_t)M * 8, MO_ROWINFO = MO_CNT + 256 * 8 * 4,
                 MO_ROWGATE = MO_ROWINFO + (size_t)MAXTILES * 256 * 4, MO_TILEE = MO_ROWGATE + (size_t)MAXTILES * 256 * 4, MO_END = MO_TILEE + 2048;
static_assert(MO_END <= 5 * MiB + 512 * 1024, "moe tables");
constexpr size_t WS_WB = 8 * MiB;
constexpr size_t W_QKV = WS_WB, W_O = W_QKV + (size_t)NQKV * D * 2, W_GU = W_O + (size_t)D * D * 2, W_DN = W_GU + (size_t)NGU * D * 2,
                 W_IN = W_DN + (size_t)D * FF * 2, W_OUT = W_IN + (size_t)NQKV * D * 2, W_MGU = W_OUT + (size_t)D * D * 2, W_MDN = W_MGU + (size_t)NE * NGU * D,
                 W_END = W_MDN + (size_t)NE * D * FF;
static_assert(W_END == (8 + 148 + 336) * MiB, "weights");
constexpr size_t WS_XA = W_END;
constexpr size_t WS_BIG = WS_XA + (size_t)M * D * 2;
constexpr size_t WS_XBUF = WS_BIG + (size_t)MAXTILES * 256 * FF;
constexpr size_t W_QKV8 = WS_XBUF + (size_t)MAXTILES * 256 * D;
constexpr size_t W_O8 = W_QKV8 + (size_t)NQKV * D;
constexpr size_t W_GU8 = W_O8 + (size_t)D * D;
constexpr size_t WS_H1B = W_GU8 + (size_t)NGU * D;
constexpr size_t WS_H2B = WS_H1B + (size_t)M * D * 2;
constexpr size_t W_DN8 = WS_H2B + (size_t)M * D * 2;
constexpr size_t WS_END = W_DN8 + (size_t)D * FF;
static_assert((size_t)MAXTILES * 256 * FF >= (size_t)M * FF * 2, "BIG holds the dense act too");
constexpr size_t WS_XQ = WS_XA + (size_t)M * D;
constexpr size_t WS_Y1 = WS_XA;

constexpr int CW_TMO = 0, CW_NTILES = 64, CW_BAR = 4096;

constexpr int RING_BYTES = 131072;
constexpr int MISC_OFF = RING_BYTES;
constexpr int LDS_BYTES = 163840 - 1024;
constexpr int XBW_OFF = LDS_BYTES - 64;

#define RLX_AGENT __ATOMIC_RELAXED, __HIP_MEMORY_SCOPE_AGENT
#define LDS_WAIT() asm volatile("s_waitcnt lgkmcnt(0)" ::: "memory")
#define VM_WAIT() asm volatile("s_waitcnt vmcnt(0)" ::: "memory")
typedef __bf16 bf16v2 __attribute__((ext_vector_type(2)));
__device__ __forceinline__ unsigned cvt_pk_bf16(float lo, float hi) { const f32x2 v = (f32x2){lo, hi}; return __builtin_bit_cast(unsigned, __builtin_convertvector(v, bf16v2)); }
__device__ __forceinline__ float bf2f(unsigned short b) { return __builtin_bit_cast(float, (unsigned)b << 16); }
__device__ __forceinline__ float bflo(unsigned w) { return __builtin_bit_cast(float, w << 16); }
__device__ __forceinline__ float bfhi(unsigned w) { return __builtin_bit_cast(float, w & 0xffff0000u); }
__device__ __forceinline__ float wave_sum(float v) {
#pragma unroll
    for (int o = 1; o < 64; o <<= 1) v += __shfl_xor(v, o);
    return v;
}
__device__ __forceinline__ float wave_max(float v) {
#pragma unroll
    for (int o = 1; o < 64; o <<= 1) v = fmaxf(v, __shfl_xor(v, o));
    return v;
}
__device__ __forceinline__ void ld8bf(const bf16_t* p, float (&z)[8]) { const u32x4 w = *(const u32x4*)p;
    z[0] = bflo(w.x); z[1] = bfhi(w.x); z[2] = bflo(w.y); z[3] = bfhi(w.y); z[4] = bflo(w.z); z[5] = bfhi(w.z); z[6] = bflo(w.w); z[7] = bfhi(w.w); }
__device__ __forceinline__ void lds_add(LAS int* p, int v) { __hip_atomic_fetch_add((int*)p, v, __ATOMIC_RELAXED, __HIP_MEMORY_SCOPE_WORKGROUP); }
__device__ __forceinline__ unsigned ld_agent(const unsigned* p) { return __hip_atomic_load(p, RLX_AGENT); }
__device__ __forceinline__ float ld_agent_f(const float* p) { return __builtin_bit_cast(float, __hip_atomic_load((const unsigned*)p, RLX_AGENT)); }
__device__ __forceinline__ int ld_agent_i(const int* p) { return (int)__hip_atomic_load((const unsigned*)p, RLX_AGENT); }


constexpr float SC_X = 16.f, SC_WGU = 32.f, SC_ACT = 8.f, SC_WDN = 64.f, SC_O = 64.f;
__device__ __forceinline__ float sat8(float v) { return __builtin_amdgcn_fmed3f(v, -448.f, 448.f); }
__device__ __forceinline__ unsigned pk4_fp8(float a, float b, float c, float d) { int w = 0; w = __builtin_amdgcn_cvt_pk_fp8_f32(sat8(a), sat8(b), w, false); w = __builtin_amdgcn_cvt_pk_fp8_f32(sat8(c), sat8(d), w, true); return (unsigned)w; }

constexpr float SC_A8B = 24.f;
constexpr float SC_A8 = 28.f, SC_W8 = 1536.f;
constexpr float SC_O8 = 160.f;
constexpr float SC_YR = 20.f;
constexpr float SC_ACTR = 32.f, SC_WDR = 2880.f;
__device__ __forceinline__ void wht_inlane8(float (&v)[8]) {
#pragma unroll
    for (int h = 1; h < 8; h <<= 1)
#pragma unroll
        for (int i = 0; i < 8; ++i) if ((i & h) == 0) { const float a = v[i], b = v[i + h]; v[i] = a + b; v[i + h] = a - b; }
}
__device__ __forceinline__ unsigned q8m(float v) { const float MG = 12582912.f; return __builtin_bit_cast(unsigned, __builtin_amdgcn_fmed3f(v + MG, MG - 127.f, MG + 127.f)); }
__device__ __forceinline__ unsigned pk4_i8(float a, float b, float c, float d) {
    const unsigned lo = __builtin_amdgcn_perm(q8m(b), q8m(a), 0x0c0c0400u), hi = __builtin_amdgcn_perm(q8m(d), q8m(c), 0x0c0c0400u);
    return __builtin_amdgcn_perm(hi, lo, 0x05040100u); }

namespace pg8 {
constexpr int BM = 256, BK = 64, HALF = 128, HTB = HALF * BK * 2, STAGE_BYTES = 8 * HTB, NXCD = 8;
__host__ __device__ __forceinline__ int lds_byte(int r, int c) { const int st = (r >> 4) * 2 + (c >> 5), rr = r & 15, cc = c & 31, ob = rr * 64 + cc * 2; return st * 1024 + (ob ^ (((ob >> 9) & 1) << 5)); }
__host__ __device__ __forceinline__ void stage_rc(int b, int& R, int& C) { const int st = b / 1024, sb = b % 1024, swz = sb ^ (((sb >> 9) & 1) << 5); R = (st >> 1) * 16 + swz / 64; C = (st & 1) * 32 + (swz % 64) / 2; }
__host__ __device__ __forceinline__ int perm32(int rho) { const int n = rho >> 4, i = rho & 15; return 8 * (i >> 2) + 4 * n + (i & 3); }

struct Unit { int pm, pn, pb, po, ui; };
struct Gemm { const void* A; const void* Bt; int KB; };

__device__ __forceinline__ bool tile_of(int i, int G, int c, int nM, int nN, int& pm, int& pn, int wgm_moe = 0) {
    const int WGM = wgm_moe ? wgm_moe : (nN <= 24 ? 4 : 8);
    const int nwg = nM * nN; const long L = (long)i * G + c; if (L >= nwg) return false;
    int wgid = (int)L; { const int q = nwg / NXCD, r = nwg % NXCD, xcd = wgid % NXCD, off = wgid / NXCD; wgid = (xcd < r ? xcd * (q + 1) : r * (q + 1) + (xcd - r) * q) + off; }
    const int nig = WGM * nN, gid = wgid / nig, fm = gid * WGM, gsz = (nM - fm) < WGM ? (nM - fm) : WGM;
    pm = fm + ((wgid % nig) % gsz); pn = (wgid % nig) / gsz; return true;
}
struct StaticOrder {
    static constexpr bool GATHER = false;
    int nM, nN, G, c;
    __device__ __forceinline__ void init(int M_, int N_, int G_, int c_) { nM = M_ / BM; nN = N_ / BM; G = G_; c = c_; }
    __device__ __forceinline__ bool next(int i, Unit& u) const { int pm, pn; if (!tile_of(i, G, c, nM, nN, pm, pn)) return false; u.pm = pm; u.pn = pn; u.pb = pn; u.po = pm; return true; }
};
__device__ __forceinline__ int lds_ld_i32(unsigned addr) { int r; asm volatile("ds_read_b32 %0, %1\n\ts_waitcnt lgkmcnt(0)" : "=v"(r) : "v"(addr) : "memory"); return r; }
template <bool GA> struct MoeOrderT {
    static constexpr bool GATHER = GA;
    int nM, nN, G, c, t0; LAS const int* tile_e; bool a_local; const int* rowinfo; LAS unsigned char* gl;
    __device__ __forceinline__ bool next(int i, Unit& u) const {
        int pm, pn; if (!tile_of(i, G, c, nM, nN, pm, pn, nN > 24 ? 4 : 0)) return false;
        const int e = __builtin_amdgcn_readfirstlane(lds_ld_i32((unsigned)(size_t)(tile_e + t0 + pm)));
        u.pn = pn; u.pb = e * nN + pn; u.pm = a_local ? pm : t0 + pm; u.po = a_local ? t0 + pm : pm; return true; }
    __device__ __forceinline__ bool row_tile(int i, int& tile) const { int pm, pn; if (!tile_of(i, G, c, nM, nN, pm, pn, nN > 24 ? 4 : 0)) return false; tile = t0 + pm; return true; }
};
typedef MoeOrderT<false> MoeOrder;
typedef MoeOrderT<true> MoeGatherOrder;

struct EpiStoreBf16 {
    static constexpr bool PERM = true, RS_LDS = false;
    bf16_t* O; int ldc; float sc;
    __device__ __forceinline__ void operator()(const f32x4 (&acc)[2][2][4][2], const Unit& u, int wr, int wc, int fr, int fq) const {
        const int row0 = u.po * BM + wr * 64 + fr, col0 = u.pn * BM + wc * 32 + 8 * fq;
#pragma unroll
        for (int ai = 0; ai < 2; ++ai)
#pragma unroll
            for (int m = 0; m < 4; ++m) { bf16_t* rowp = O + (size_t)(row0 + ai * HALF + m * 16) * ldc + col0;
#pragma unroll
                for (int bj = 0; bj < 2; ++bj) { const f32x4 v0 = acc[ai][bj][m][0] * sc, v1 = acc[ai][bj][m][1] * sc;
                    u32x4 w; w.x = cvt_pk_bf16(v0[0], v0[1]); w.y = cvt_pk_bf16(v0[2], v0[3]); w.z = cvt_pk_bf16(v1[0], v1[1]); w.w = cvt_pk_bf16(v1[2], v1[3]);
                    *(u32x4*)(rowp + bj * HALF) = w; } }
    }
};
struct EpiQKV {
    static constexpr bool PERM = true, RS_LDS = false;
    bf16_t* O; int ldc; float sc; const float* q_gain; const float* k_gain; LAS float* P;
    __device__ __forceinline__ void operator()(const f32x4 (&acc)[2][2][4][2], const Unit& u, int wr, int wc, int fr, int fq) const {
        const int rl0 = wr * 64 + fr, row0 = u.po * BM + rl0, col0 = u.pn * BM + wc * 32 + 8 * fq;
        if (u.pn >= 16) {
#pragma unroll
            for (int ai = 0; ai < 2; ++ai)
#pragma unroll
                for (int m = 0; m < 4; ++m) { bf16_t* rowp = O + (size_t)(row0 + ai * HALF + m * 16) * ldc + col0;
#pragma unroll
                    for (int bj = 0; bj < 2; ++bj) { const f32x4 v0 = acc[ai][bj][m][0] * sc, v1 = acc[ai][bj][m][1] * sc;
                        u32x4 w; w.x = cvt_pk_bf16(v0[0], v0[1]); w.y = cvt_pk_bf16(v0[2], v0[3]); w.z = cvt_pk_bf16(v1[0], v1[1]); w.w = cvt_pk_bf16(v1[2], v1[3]);
                        *(u32x4*)(rowp + bj * HALF) = w; } }
            return;
        }
#pragma unroll
        for (int ai = 0; ai < 2; ++ai)
#pragma unroll
            for (int m = 0; m < 4; ++m)
#pragma unroll
                for (int bj = 0; bj < 2; ++bj) { const f32x4 a = acc[ai][bj][m][0], b = acc[ai][bj][m][1];
                    float ss = (a.x * a.x + a.y * a.y) + (a.z * a.z + a.w * a.w) + (b.x * b.x + b.y * b.y) + (b.z * b.z + b.w * b.w);
                    ss += __shfl_xor(ss, 16); ss += __shfl_xor(ss, 32);
                    if (fq == 0) P[((rl0 + ai * HALF + m * 16) * 2 + bj) * 4 + wc] = ss; }
        asm volatile("s_waitcnt lgkmcnt(0)" ::: "memory"); __builtin_amdgcn_s_barrier(); asm volatile("" ::: "memory");
        const bool isq = u.pn < 8; const float* gn = (isq ? q_gain : k_gain) + wc * 32 + 8 * fq; const float gs = isq ? 0.08838834764831845f * LOG2E : 1.0f;
        const f32x4 g0 = *(const f32x4*)gn * gs, g1 = *(const f32x4*)(gn + 4) * gs;
#pragma unroll
        for (int ai = 0; ai < 2; ++ai)
#pragma unroll
            for (int m = 0; m < 4; ++m) { bf16_t* rowp = O + (size_t)(row0 + ai * HALF + m * 16) * ldc + col0;
#pragma unroll
                for (int bj = 0; bj < 2; ++bj) { const f32x4 q = *(const LAS f32x4*)(P + ((rl0 + ai * HALF + m * 16) * 2 + bj) * 4);
                    const float r = __builtin_amdgcn_rsqf(((q.x + q.y) + (q.z + q.w)) * (sc * sc) * (1.0f / HD) + RMS_EPS) * sc;
                    const f32x4 v0 = acc[ai][bj][m][0] * g0 * r, v1 = acc[ai][bj][m][1] * g1 * r;
                    u32x4 w; w.x = cvt_pk_bf16(v0[0], v0[1]); w.y = cvt_pk_bf16(v0[2], v0[3]); w.z = cvt_pk_bf16(v1[0], v1[1]); w.w = cvt_pk_bf16(v1[2], v1[3]);
                    *(u32x4*)(rowp + bj * HALF) = w; } }
    }
};
template <bool BASE_BF16> struct EpiResidNormB {
    static constexpr bool PERM = true, RS_LDS = false;
    const void* base; bf16_t* ob; unsigned char* hb; float* rsp; int ldc; LAS float* P; float sc; float hsc;
    __device__ __forceinline__ void operator()(const f32x4 (&acc)[2][2][4][2], const Unit& u, int wr, int wc, int fr, int fq) const {
        const int rl0 = wr * 64 + fr, row0 = u.po * BM + rl0, col0 = u.pn * BM + wc * 32 + 8 * fq;
#pragma unroll
        for (int ai = 0; ai < 2; ++ai)
#pragma unroll
            for (int m = 0; m < 4; ++m) { const int row = row0 + ai * HALF + m * 16; const size_t off = (size_t)row * ldc + col0; float ss = 0.f;
#pragma unroll
                for (int bj = 0; bj < 2; ++bj) { f32x4 b0, b1;
                    if constexpr (BASE_BF16) { const u32x4 w = *(const u32x4*)((const bf16_t*)base + off + bj * HALF);
                        b0 = (f32x4){bflo(w.x), bfhi(w.x), bflo(w.y), bfhi(w.y)}; b1 = (f32x4){bflo(w.z), bfhi(w.z), bflo(w.w), bfhi(w.w)}; }
                    else { const f32x4* bp = (const f32x4*)((const float*)base + off + bj * HALF); b0 = bp[0]; b1 = bp[1]; }
                    const f32x4 v0 = b0 + acc[ai][bj][m][0] * sc, v1 = b1 + acc[ai][bj][m][1] * sc;
                    u32x4 w; w.x = cvt_pk_bf16(v0[0], v0[1]); w.y = cvt_pk_bf16(v0[2], v0[3]); w.z = cvt_pk_bf16(v1[0], v1[1]); w.w = cvt_pk_bf16(v1[2], v1[3]);
                    *(u32x4*)(ob + off + bj * HALF) = w;
                    u32x2 q; q.x = pk4_i8(v0[0] * hsc, v0[1] * hsc, v0[2] * hsc, v0[3] * hsc); q.y = pk4_i8(v1[0] * hsc, v1[1] * hsc, v1[2] * hsc, v1[3] * hsc);
                    *(u32x2*)(hb + off + bj * HALF) = q;
                    ss += ((v0.x * v0.x + v0.y * v0.y) + (v0.z * v0.z + v0.w * v0.w)) + ((v1.x * v1.x + v1.y * v1.y) + (v1.z * v1.z + v1.w * v1.w)); }
                ss += __shfl_xor(ss, 16); ss += __shfl_xor(ss, 32);
                if (fq == 0) P[(rl0 + ai * HALF + m * 16) * 4 + wc] = ss; }
        asm volatile("s_waitcnt lgkmcnt(0)" ::: "memory"); __builtin_amdgcn_s_barrier(); asm volatile("" ::: "memory");
        const int t = threadIdx.x;
        if (t < BM) { const LAS f32x4* pp = (const LAS f32x4*)(P + t * 4); const f32x4 q = *pp; rsp[(size_t)(u.po * BM + t) * 8 + u.pn] = (q.x + q.y) + (q.z + q.w); }
    }
};
struct EpiResidB {
    static constexpr bool PERM = true, RS_LDS = false;
    const bf16_t* base; bf16_t* ob; int ldc; float sc;
    __device__ __forceinline__ void operator()(const f32x4 (&acc)[2][2][4][2], const Unit& u, int wr, int wc, int fr, int fq) const {
        const int row0 = u.po * BM + wr * 64 + fr, col0 = u.pn * BM + wc * 32 + 8 * fq;
#pragma unroll
        for (int ai = 0; ai < 2; ++ai)
#pragma unroll
            for (int m = 0; m < 4; ++m) { const size_t off = (size_t)(row0 + ai * HALF + m * 16) * ldc + col0;
#pragma unroll
                for (int bj = 0; bj < 2; ++bj) { const u32x4 b = *(const u32x4*)(base + off + bj * HALF);
                    const f32x4 v0 = (f32x4){bflo(b.x), bfhi(b.x), bflo(b.y), bfhi(b.y)} + acc[ai][bj][m][0] * sc, v1 = (f32x4){bflo(b.z), bfhi(b.z), bflo(b.w), bfhi(b.w)} + acc[ai][bj][m][1] * sc;
                    u32x4 w; w.x = cvt_pk_bf16(v0[0], v0[1]); w.y = cvt_pk_bf16(v0[2], v0[3]); w.z = cvt_pk_bf16(v1[0], v1[1]); w.w = cvt_pk_bf16(v1[2], v1[3]);
                    *(u32x4*)(ob + off + bj * HALF) = w; } }
    }
};
__device__ __forceinline__ void rs_prefetch(const float* rs, LAS float* PR, const Unit& u, int wid, int tid) {
    __builtin_amdgcn_global_load_lds((const unsigned*)(rs + (size_t)(u.po * BM) * 8 + tid * 4), (LAS unsigned*)((LAS unsigned char*)PR + (u.ui & 1) * 8192 + wid * 1024), 16, 0, 0); }
__device__ __forceinline__ float row_rstd8(const LAS float* PR, const Unit& u, int rl) { const LAS f32x4* p = (const LAS f32x4*)(PR + (u.ui & 1) * 2048 + rl * 8); const f32x4 a = p[0], b = p[1];
    return __builtin_amdgcn_rsqf((((a.x + a.y) + (a.z + a.w)) + ((b.x + b.y) + (b.z + b.w))) * (1.0f / D) + RMS_EPS); }
__device__ __forceinline__ float silu_mul(float g, float u) { return g * u * __builtin_amdgcn_rcpf(1.0f + __builtin_amdgcn_exp2f(-g * LOG2E)); }
struct EpiSwiGLU {
    static constexpr bool PERM = true, RS_LDS = true;
    unsigned char* O; int ldc; const float* rs; float sc; LAS float* PR;
    __device__ __forceinline__ void prefetch(const Unit& u, int wid, int tid) const { rs_prefetch(rs, PR, u, wid, tid); }
    __device__ __forceinline__ void operator()(const f32x4 (&acc)[2][2][4][2], const Unit& u, int wr, int wc, int fr, int fq) const {
        const int row0 = u.po * BM + wr * 64 + fr, col0 = u.pn * HALF + wc * 32 + 8 * fq; const float qs = SC_ACTR * 0.35355339059327373f;
#pragma unroll
        for (int ai = 0; ai < 2; ++ai)
#pragma unroll
            for (int m = 0; m < 4; ++m) { const int row = row0 + ai * HALF + m * 16; unsigned char* rowp = O + (size_t)row * ldc + col0;
                const float r = row_rstd8(PR, u, wr * 64 + fr + ai * HALF + m * 16) * sc;
                const f32x4 g0 = acc[ai][0][m][0] * r, g1 = acc[ai][0][m][1] * r, u0 = acc[ai][1][m][0] * r, u1 = acc[ai][1][m][1] * r;
                float a[8] = {silu_mul(g0[0], u0[0]), silu_mul(g0[1], u0[1]), silu_mul(g0[2], u0[2]), silu_mul(g0[3], u0[3]), silu_mul(g1[0], u1[0]), silu_mul(g1[1], u1[1]), silu_mul(g1[2], u1[2]), silu_mul(g1[3], u1[3])};
                wht_inlane8(a);
                u32x2 w; w.x = pk4_i8(a[0] * qs, a[1] * qs, a[2] * qs, a[3] * qs); w.y = pk4_i8(a[4] * qs, a[5] * qs, a[6] * qs, a[7] * qs);
                *(u32x2*)rowp = w; }
    }
};
struct EpiWin {
    static constexpr bool PERM = true, RS_LDS = true;
    bf16_t* O; int ldc; const float* rs; float sc; LAS float* PR;
    __device__ __forceinline__ void prefetch(const Unit& u, int wid, int tid) const { rs_prefetch(rs, PR, u, wid, tid); }
    __device__ __forceinline__ void operator()(const f32x4 (&acc)[2][2][4][2], const Unit& u, int wr, int wc, int fr, int fq) const {
        const int row0 = u.po * BM + wr * 64 + fr;
        float rr[2][4];
#pragma unroll
        for (int ai = 0; ai < 2; ++ai)
#pragma unroll
            for (int m = 0; m < 4; ++m) rr[ai][m] = row_rstd8(PR, u, wr * 64 + fr + ai * HALF + m * 16) * sc;
        if (u.pn < 8) {
            const int col0 = u.pn * BM + wc * 32 + 8 * fq;
#pragma unroll
            for (int ai = 0; ai < 2; ++ai)
#pragma unroll
                for (int m = 0; m < 4; ++m) { bf16_t* rowp = O + (size_t)(row0 + ai * HALF + m * 16) * ldc + col0;
#pragma unroll
                    for (int bj = 0; bj < 2; ++bj) { const f32x4 v0 = acc[ai][bj][m][0] * rr[ai][m], v1 = acc[ai][bj][m][1] * rr[ai][m];
                        u32x4 w; w.x = cvt_pk_bf16(v0[0], v0[1]); w.y = cvt_pk_bf16(v0[2], v0[3]); w.z = cvt_pk_bf16(v1[0], v1[1]); w.w = cvt_pk_bf16(v1[2], v1[3]);
                        *(u32x4*)(rowp + bj * HALF) = w; } }
        } else {
            const int col0 = D + (u.pn - 8) * HALF + wc * 32 + 8 * fq;
#pragma unroll
            for (int ai = 0; ai < 2; ++ai)
#pragma unroll
                for (int m = 0; m < 4; ++m) { bf16_t* rowp = O + (size_t)(row0 + ai * HALF + m * 16) * ldc + col0;
                    const float r2 = rr[ai][m] * rr[ai][m]; const f32x4 a0 = acc[ai][0][m][0] * acc[ai][1][m][0] * r2, a1 = acc[ai][0][m][1] * acc[ai][1][m][1] * r2;
                    u32x4 w; w.x = cvt_pk_bf16(a0[0], a0[1]); w.y = cvt_pk_bf16(a0[2], a0[3]); w.z = cvt_pk_bf16(a1[0], a1[1]); w.w = cvt_pk_bf16(a1[2], a1[3]);
                    *(u32x4*)rowp = w; }
        }
    }
};
struct EpiSwiGLU8 {
    static constexpr bool PERM = true, RS_LDS = false;
    unsigned char* O; int ldc;
    __device__ __forceinline__ void operator()(const f32x4 (&acc)[2][2][4][2], const Unit& u, int wr, int wc, int fr, int fq) const {
        const int row0 = u.po * BM + wr * 64 + fr, col0 = u.pn * HALF + wc * 32 + 8 * fq; const float si = 1.0f / (SC_A8 * SC_W8);
#pragma unroll
        for (int ai = 0; ai < 2; ++ai)
#pragma unroll
            for (int m = 0; m < 4; ++m) { unsigned char* rowp = O + (size_t)(row0 + ai * HALF + m * 16) * ldc + col0;
                const f32x4 g0 = acc[ai][0][m][0] * si, g1 = acc[ai][0][m][1] * si, u0 = acc[ai][1][m][0] * (si * SC_ACT), u1 = acc[ai][1][m][1] * (si * SC_ACT);
                u32x2 w; w.x = pk4_fp8(silu_mul(g0[0], u0[0]), silu_mul(g0[1], u0[1]), silu_mul(g0[2], u0[2]), silu_mul(g0[3], u0[3]));
                w.y = pk4_fp8(silu_mul(g1[0], u1[0]), silu_mul(g1[1], u1[1]), silu_mul(g1[2], u1[2]), silu_mul(g1[3], u1[3]));
                __builtin_nontemporal_store(w, (u32x2*)rowp); }
    }
};
struct EpiMoeDown {
    static constexpr bool PERM = true, RS_LDS = false;
    bf16_t* Y0; bf16_t* Y1; const int* rowinfo; const float* rowgate; float osc;
    __device__ __forceinline__ void operator()(const f32x4 (&acc)[2][2][4][2], const Unit& u, int wr, int wc, int fr, int fq) const {
        const int row0 = u.po * BM + wr * 64 + fr, col0 = u.pn * BM + wc * 32 + 8 * fq;
#pragma unroll
        for (int ai = 0; ai < 2; ++ai)
#pragma unroll
            for (int m = 0; m < 4; ++m) { const int r = row0 + ai * HALF + m * 16; const int info = rowinfo[r]; const float g = rowgate[r] * osc;
                if (info >= 0) { const int tok = info & 0xffff; bf16_t* rowp = ((info >> 16) == 0 ? Y0 : Y1) + (size_t)tok * D + col0;
#pragma unroll
                    for (int bj = 0; bj < 2; ++bj) { const f32x4 v0 = acc[ai][bj][m][0] * g, v1 = acc[ai][bj][m][1] * g;
                        u32x4 w; w.x = cvt_pk_bf16(v0[0], v0[1]); w.y = cvt_pk_bf16(v0[2], v0[3]); w.z = cvt_pk_bf16(v1[0], v1[1]); w.w = cvt_pk_bf16(v1[2], v1[3]);
                        *(u32x4*)(rowp + bj * HALF) = w; } } }
    }
};

template <class Epi, class Sched, int FMT = -1>
__device__ __forceinline__ void gemm_phase(LAS unsigned char* lds, const Gemm g, const Sched& S, const Epi& E) {
    const int tid = threadIdx.x, wid = __builtin_amdgcn_readfirstlane(tid >> 6), lane = tid & 63, wr = wid >> 2, wc = wid & 3, fr = lane & 15, fq = lane >> 4;
    const int KB = g.KB, nt = KB / (BK * 2);
    constexpr bool GA = Sched::GATHER;
    unsigned voffA, voffB; int gR, gC2;
    { int R, C; stage_rc(tid * 16, R, C); const int Rb = Epi::PERM ? ((R & ~31) + perm32(R & 31)) : R; voffA = (unsigned)(R * KB + C * 2); voffB = (unsigned)(Rb * KB + C * 2); gR = R; gC2 = C * 2; }
    const size_t pstep = (size_t)64 * KB;
    const size_t kstep = (size_t)(BK * 2);
    const size_t hstep = (size_t)HALF * KB;
    const size_t tstep = 2 * hstep;
    const size_t hstepA = GA ? 0 : hstep;
    const unsigned ldsw = (unsigned)wid * 1024u;
    const int aoff = lds_byte(wr * 64 + fr, fq * 8), boff = lds_byte(wc * 32 + fr, fq * 8);
#define PG8_SA(b, h) (((b) * 2 + (h)) * HTB)
#define PG8_SB(b, h) ((4 + (b) * 2 + (h)) * HTB)
#define PG8_STAGE2(bufoff, gbase, v0, v1, pst) do { _Pragma("unroll") for (int _i = 0; _i < 2; ++_i) { unsigned _vo = _i ? (v1) : (v0); asm volatile("" : "+v"(_vo)); \
        const char* _gb = (const char*)(gbase) + _i * (pst); asm volatile("" : "+s"(_gb)); \
        __builtin_amdgcn_global_load_lds((const unsigned*)(_gb + _vo), (LAS unsigned*)(lds + (bufoff) + ldsw + _i * 8192), 16, 0, 0); } } while (0)
#define PG8_STAGE(bufoff, gbase, voff) PG8_STAGE2(bufoff, gbase, voff, voff, pstep)
#define PG8_STAGE_A(bufoff, gbase, h, nx) do { if constexpr (GA) PG8_STAGE2(bufoff, gbase, ((nx) ? vn[h][0] : vc[h][0]), ((nx) ? vn[h][1] : vc[h][1]), 0); else PG8_STAGE2(bufoff, gbase, voffA, voffA, pstep); } while (0)
#define PG8_GISSUE(tile, slot) __builtin_amdgcn_global_load_lds((const unsigned*)(S.rowinfo + (size_t)(tile) * 256 + lane * 4), (LAS unsigned*)(S.gl + wid * 2048 + (slot) * 1024), 16, 0, 0)
#define PG8_GREAD(dst, slot) do { _Pragma("unroll") for (int _h = 0; _h < 2; ++_h) _Pragma("unroll") for (int _i = 0; _i < 2; ++_i) { \
        const int _info = lds_ld_i32((unsigned)(size_t)(S.gl + wid * 2048 + (slot) * 1024) + (unsigned)((_h * 128 + _i * 64 + gR) * 4)); \
        dst[_h][_i] = (unsigned)((_info < 0 ? 0 : (_info & 0xffff)) * KB + gC2); } } while (0)
#define PG8_LDA(dst, b, h) do { _Pragma("unroll") for (int m = 0; m < 4; ++m) { dst[m].lo = *(const LAS i32x4*)(lds + PG8_SA(b, h) + aoff + m * 2048); dst[m].hi = *(const LAS i32x4*)(lds + PG8_SA(b, h) + aoff + m * 2048 + 1024); } } while (0)
#define PG8_LDB(dst, b, h) do { _Pragma("unroll") for (int n = 0; n < 2; ++n) { dst[n].lo = *(const LAS i32x4*)(lds + PG8_SB(b, h) + boff + n * 2048); dst[n].hi = *(const LAS i32x4*)(lds + PG8_SB(b, h) + boff + n * 2048 + 1024); } } while (0)
#define PG8_MMA(ai, bj, At, Bt) do { __builtin_amdgcn_s_setprio(1); _Pragma("unroll") for (int m = 0; m < 4; ++m) _Pragma("unroll") for (int n = 0; n < 2; ++n) { \
        if constexpr (FMT == 0) acc[ai][bj][m][n] = __builtin_amdgcn_mfma_scale_f32_16x16x128_f8f6f4(Bt[n], At[m], acc[ai][bj][m][n], 0, 0, 0, 0x7f7f7f7f, 0, 0x7f7f7f7f); \
        else if constexpr (FMT == 8) { const i32x4 _bl = Bt[n].lo, _bh = Bt[n].hi, _al = At[m].lo, _ah = At[m].hi; i32x4 _c = __builtin_bit_cast(i32x4, acc[ai][bj][m][n]); \
               _c = __builtin_amdgcn_mfma_i32_16x16x64_i8(_bl, _al, _c, 0, 0, 0); _c = __builtin_amdgcn_mfma_i32_16x16x64_i8(_bh, _ah, _c, 0, 0, 0); acc[ai][bj][m][n] = __builtin_bit_cast(f32x4, _c); } \
        else { const i32x4 _bl = Bt[n].lo, _bh = Bt[n].hi, _al = At[m].lo, _ah = At[m].hi; \
               acc[ai][bj][m][n] = __builtin_amdgcn_mfma_f32_16x16x32_bf16(__builtin_bit_cast(bf16x8, _bl), __builtin_bit_cast(bf16x8, _al), acc[ai][bj][m][n], 0, 0, 0); \
               acc[ai][bj][m][n] = __builtin_amdgcn_mfma_f32_16x16x32_bf16(__builtin_bit_cast(bf16x8, _bh), __builtin_bit_cast(bf16x8, _ah), acc[ai][bj][m][n], 0, 0, 0); } } __builtin_amdgcn_s_setprio(0); } while (0)
#define PG8_WAIT_V(n) asm volatile("s_waitcnt vmcnt(" #n ")" ::: "memory")
#define PG8_WAIT_L(n) asm volatile("s_waitcnt lgkmcnt(" #n ")" ::: "memory")
#define PG8_BAR __builtin_amdgcn_s_barrier()
#define PG8_SCHED __builtin_amdgcn_sched_barrier(0)
    Unit cur, nxt; int ui = 0;
    if (!S.next(0, cur)) return;
    cur.ui = 0;
    if constexpr (Epi::RS_LDS) E.prefetch(cur, wid, tid);
    f32x4 acc[2][2][4][2];
#pragma unroll
    for (int a = 0; a < 2; ++a)
#pragma unroll
        for (int b = 0; b < 2; ++b)
#pragma unroll
            for (int m = 0; m < 4; ++m)
#pragma unroll
                for (int n = 0; n < 2; ++n) acc[a][b][m][n] = (f32x4){0.f, 0.f, 0.f, 0.f};
    i32x8 At[4], B0[2], B1[2];
    unsigned vc[2][2], vn[2][2];
    if constexpr (GA) { int t1; PG8_GISSUE(cur.pm, 0); if (S.row_tile(1, t1)) PG8_GISSUE(t1, 1); asm volatile("s_waitcnt vmcnt(0)" ::: "memory"); PG8_GREAD(vc, 0);
#pragma unroll
        for (int h = 0; h < 2; ++h) { vn[h][0] = vc[h][0]; vn[h][1] = vc[h][1]; } }
    const char* cA = GA ? (const char*)g.A : (const char*)g.A + (size_t)cur.pm * tstep; const char* cB = (const char*)g.Bt + (size_t)cur.pb * tstep;
    PG8_STAGE(PG8_SB(0, 0), cB, voffB); PG8_STAGE(PG8_SB(0, 1), cB + hstep, voffB); PG8_STAGE_A(PG8_SA(0, 0), cA, 0, false); PG8_STAGE_A(PG8_SA(0, 1), cA + hstepA, 1, false);
    if (wr == 1) PG8_BAR;
    PG8_WAIT_V(2); PG8_BAR;
    PG8_STAGE(PG8_SB(1, 0), cB + kstep, voffB); PG8_STAGE_A(PG8_SA(1, 0), cA + kstep, 0, false); PG8_STAGE(PG8_SB(1, 1), cB + hstep + kstep, voffB);
    PG8_WAIT_V(6); PG8_BAR;
    for (;;) {
        const bool has_next = S.next(ui + 1, nxt); nxt.ui = ui + 1;
        if constexpr (GA) { if (has_next) PG8_GREAD(vn, (ui + 1) & 1); int t2; if (S.row_tile(ui + 2, t2)) PG8_GISSUE(t2, ui & 1); }
        const char* nA = GA ? cA : (has_next ? (const char*)g.A + (size_t)nxt.pm * tstep : cA); const char* nB = has_next ? (const char*)g.Bt + (size_t)nxt.pb * tstep : cB;
        for (int t = 0; t < nt; t += 2) {
            const bool last = (t == nt - 2);
            const char* a1 = cA + (size_t)(t + 1) * kstep;
            const char* a2 = last ? nA : cA + (size_t)(t + 2) * kstep; const char* b2 = last ? nB : cB + (size_t)(t + 2) * kstep;
            const char* a3 = a2 + kstep; const char* b3 = b2 + kstep;
            PG8_LDB(B0, 0, 0); PG8_LDB(B1, 0, 1); PG8_SCHED; PG8_LDA(At, 0, 0); PG8_STAGE_A(PG8_SA(1, 1), a1 + hstepA, 1, false);
            PG8_WAIT_V(8); PG8_WAIT_L(0); PG8_BAR; PG8_MMA(0, 0, At, B0); PG8_MMA(0, 1, At, B1); PG8_BAR; PG8_SCHED;
            PG8_LDA(At, 0, 1); PG8_STAGE(PG8_SB(0, 0), b2, voffB); PG8_STAGE(PG8_SB(0, 1), b2 + hstep, voffB); PG8_STAGE_A(PG8_SA(0, 0), a2, 0, last);
            PG8_WAIT_V(8); PG8_WAIT_L(0); PG8_BAR; PG8_MMA(1, 0, At, B0); PG8_MMA(1, 1, At, B1); PG8_BAR; PG8_SCHED;
            PG8_LDB(B0, 1, 0); PG8_LDB(B1, 1, 1); PG8_SCHED; PG8_LDA(At, 1, 0); PG8_STAGE_A(PG8_SA(0, 1), a2 + hstepA, 1, last);
            PG8_WAIT_V(8); PG8_WAIT_L(0); PG8_BAR; PG8_MMA(0, 0, At, B0); PG8_MMA(0, 1, At, B1); PG8_BAR; PG8_SCHED;
            PG8_LDA(At, 1, 1); PG8_STAGE(PG8_SB(1, 0), b3, voffB); PG8_STAGE(PG8_SB(1, 1), b3 + hstep, voffB); PG8_STAGE_A(PG8_SA(1, 0), a3, 0, last);
            PG8_WAIT_V(8); PG8_WAIT_L(0); PG8_BAR; PG8_MMA(1, 0, At, B0); PG8_MMA(1, 1, At, B1); PG8_BAR; PG8_SCHED;
        }
        if (wr == 0) PG8_BAR;
        if constexpr (FMT == 8) {
#pragma unroll
            for (int a = 0; a < 2; ++a)
#pragma unroll
                for (int b = 0; b < 2; ++b)
#pragma unroll
                    for (int m = 0; m < 4; ++m)
#pragma unroll
                        for (int n = 0; n < 2; ++n) acc[a][b][m][n] = __builtin_convertvector(__builtin_bit_cast(i32x4, acc[a][b][m][n]), f32x4); }
        E(acc, cur, wr, wc, fr, fq);
        if (!has_next) break;
        if constexpr (Epi::RS_LDS) E.prefetch(nxt, wid, tid);
#pragma unroll
        for (int a = 0; a < 2; ++a)
#pragma unroll
            for (int b = 0; b < 2; ++b)
#pragma unroll
                for (int m = 0; m < 4; ++m)
#pragma unroll
                    for (int n = 0; n < 2; ++n) acc[a][b][m][n] = (f32x4){0.f, 0.f, 0.f, 0.f};
        cur = nxt; cA = nA; cB = nB; ++ui;
        if constexpr (GA) {
#pragma unroll
            for (int h = 0; h < 2; ++h) { vc[h][0] = vn[h][0]; vc[h][1] = vn[h][1]; } }
        if (wr == 1) PG8_BAR;
    }
    PG8_WAIT_V(0);
    PG8_BAR;
#undef PG8_SA
#undef PG8_SB
#undef PG8_STAGE
#undef PG8_STAGE2
#undef PG8_STAGE_A
#undef PG8_GISSUE
#undef PG8_GREAD
#undef PG8_LDA
#undef PG8_LDB
#undef PG8_MMA
#undef PG8_WAIT_V
#undef PG8_WAIT_L
#undef PG8_BAR
#undef PG8_SCHED
}
}

#define XB_TMO      128
#define XB_XCNT(j)  (256  + 64 * (j))
#define XB_XSUB(j)  (1280 + 64 * (j))
#define XB_XGEN(j)  (2304 + 64 * (j))
#define XB_TOP      3328
#define XB_TOPGEN   3392
#define XCD_BAR_WORDS 3456
#define XB_SPIN_CAP (1u << 20)
__device__ __forceinline__ unsigned xb_ld(unsigned* p)              { return __hip_atomic_load(p, __ATOMIC_RELAXED, __HIP_MEMORY_SCOPE_AGENT); }
__device__ __forceinline__ unsigned xb_add(unsigned* p, unsigned v) { return __hip_atomic_fetch_add(p, v, __ATOMIC_RELAXED, __HIP_MEMORY_SCOPE_AGENT); }
__device__ __forceinline__ unsigned xb_xcc_id() { return (unsigned)__builtin_amdgcn_s_getreg((3 << 11) | 20) & 0xFu; }
#define XB_SPIN(cond, bar) do { unsigned _sp = 0; while (cond) { __builtin_amdgcn_s_sleep(1); \
    if ((++_sp & 255u) == 0u) { if (xb_ld(&(bar)[XB_TMO])) break; if (_sp > XB_SPIN_CAP) { atomicAdd(&(bar)[XB_TMO], 1u); break; } } } } while (0)
struct XcdBarrier { unsigned* bar; unsigned x; volatile LAS unsigned* st; };
__device__ __forceinline__ XcdBarrier xcd_barrier_post(unsigned* bar, volatile LAS unsigned* st) {
    XcdBarrier b; b.bar = bar; b.x = xb_xcc_id(); b.st = st;
    if (threadIdx.x == 0) (void)xb_add(&bar[XB_XCNT(b.x)], 1u);
    return b;
}
__device__ __forceinline__ void xcd_barrier_complete(unsigned* bar, unsigned x, unsigned& nloc, unsigned& nx) {
    const unsigned G = gridDim.x * gridDim.y * gridDim.z;
    unsigned sum, cnt, mine, sp = 0u;
    for (;;) {
        sum = 0u; cnt = 0u; mine = 0u;
#pragma unroll
        for (unsigned j = 0; j < 16; ++j) { const unsigned c = xb_ld(&bar[XB_XCNT(j)]); sum += c; cnt += (c > 0u) ? 1u : 0u; mine = (j == x) ? c : mine; }
        if (sum == G) break;
        __builtin_amdgcn_s_sleep(1);
        if ((++sp & 255u) == 0u) { if (xb_ld(&bar[XB_TMO])) break; if (sp > XB_SPIN_CAP) { atomicAdd(&bar[XB_TMO], 1u); break; } }
    }
    nloc = mine > 0u ? mine : 1u; nx = cnt > 0u ? cnt : 1u;
}
__device__ __forceinline__ void xcd_barrier(const XcdBarrier& b) {
    asm volatile("s_waitcnt vmcnt(0)" ::: "memory");
    __syncthreads();
    if (threadIdx.x == 0) {
        unsigned* bar = b.bar;
        __builtin_amdgcn_s_waitcnt(0);
        unsigned nloc = b.st[0], nx = b.st[1];
        if (nloc == 0u) { xcd_barrier_complete(bar, b.x, nloc, nx); b.st[0] = nloc; b.st[1] = nx; }
        const unsigned old = xb_add(&bar[XB_XSUB(b.x)], 1u);
        const unsigned gen = old / nloc;
        if (old + 1u == (gen + 1u) * nloc) {
            __builtin_amdgcn_fence(__ATOMIC_RELEASE, "agent");
            asm volatile("s_waitcnt vmcnt(0)" ::: "memory");
            const unsigned og = xb_add(&bar[XB_TOP], 1u);
            const unsigned tg = og / nx;
            if (og + 1u == (tg + 1u) * nx) xb_add(&bar[XB_TOPGEN], 1u);
            else XB_SPIN(xb_ld(&bar[XB_TOPGEN]) == tg, bar);
            __builtin_amdgcn_fence(__ATOMIC_ACQUIRE, "agent");
            xb_add(&bar[XB_XGEN(b.x)], 1u);
            asm volatile("s_waitcnt vmcnt(0)" ::: "memory");
        } else {
            XB_SPIN(xb_ld(&bar[XB_XGEN(b.x)]) == gen, bar);
            __builtin_amdgcn_fence(__ATOMIC_ACQUIRE, "agent");
            asm volatile("s_waitcnt vmcnt(0)" ::: "memory");
        }
    }
    __syncthreads();
}

constexpr int P0S = 65;
__device__ __forceinline__ void p0_load_tile(const float* W, int N, int k0, int n0, LAS float* scr, int lane, const float* kgain = nullptr) {
    f32x4 v[16];
#pragma unroll
    for (int i = 0; i < 16; ++i) v[i] = *(const f32x4*)(W + (size_t)(k0 + 4 * i + (lane >> 4)) * N + n0 + 4 * (lane & 15));
    if (kgain) {
#pragma unroll
        for (int i = 0; i < 16; ++i) v[i] = v[i] * kgain[k0 + 4 * i + (lane >> 4)]; }
#pragma unroll
    for (int i = 0; i < 16; ++i) { LAS float* d = scr + (4 * i + (lane >> 4)) * P0S + 4 * (lane & 15); d[0] = v[i].x; d[1] = v[i].y; d[2] = v[i].z; d[3] = v[i].w; }
    LDS_WAIT(); asm volatile("" ::: "memory");
}
__device__ __forceinline__ void p0_transpose_item(const float* W, int K, int N, bf16_t* WT, int k0, int n0, int drow0, LAS float* scr, int lane, const float* kgain = nullptr) {
    p0_load_tile(W, N, k0, n0, scr, lane, kgain);
    const int c = lane & 7;
#pragma unroll
    for (int j = 0; j < 8; ++j) { const int n = (lane >> 3) + 8 * j; const LAS float* s = scr + (8 * c) * P0S + n;
        u32x4 o; o.x = cvt_pk_bf16(s[0 * P0S], s[1 * P0S]); o.y = cvt_pk_bf16(s[2 * P0S], s[3 * P0S]); o.z = cvt_pk_bf16(s[4 * P0S], s[5 * P0S]); o.w = cvt_pk_bf16(s[6 * P0S], s[7 * P0S]);
        *(u32x4*)(WT + (size_t)(drow0 + n) * K + k0 + 8 * c) = o; }
    LDS_WAIT(); asm volatile("" ::: "memory");
}
template <int BLK>
__device__ __forceinline__ void p0_item_dn(const float* W, int K, int N, bf16_t* WT  , unsigned char* WT8, float wsc, int k0, int n0, LAS float* scr, int lane) {
    p0_load_tile(W, N, k0, n0, scr, lane, nullptr);
    if (WT) { const int c = lane & 7;
#pragma unroll
      for (int j = 0; j < 8; ++j) { const int n = (lane >> 3) + 8 * j; const LAS float* s = scr + (8 * c) * P0S + n;
          u32x4 o; o.x = cvt_pk_bf16(s[0 * P0S], s[1 * P0S]); o.y = cvt_pk_bf16(s[2 * P0S], s[3 * P0S]); o.z = cvt_pk_bf16(s[4 * P0S], s[5 * P0S]); o.w = cvt_pk_bf16(s[6 * P0S], s[7 * P0S]);
          *(u32x4*)(WT + (size_t)(n0 + n) * K + k0 + 8 * c) = o; } }
    { const int c = lane & 3; const float sc = wsc * (BLK == 32 ? 0.17677669529663687f : 0.35355339059327373f);
#pragma unroll
      for (int j = 0; j < 4; ++j) { const int n = (lane >> 2) + 16 * j; const LAS float* s = scr + (16 * c) * P0S + n;
          float f[16];
#pragma unroll
          for (int e = 0; e < 16; ++e) f[e] = s[e * P0S];
#pragma unroll
          for (int h = 1; h < (BLK == 32 ? 16 : 8); h <<= 1)
#pragma unroll
              for (int i = 0; i < 16; ++i) if ((i & h) == 0) { const float a = f[i], b = f[i + h]; f[i] = a + b; f[i + h] = a - b; }
#pragma unroll
          for (int e = 0; e < 16; ++e) { if constexpr (BLK == 32) { const float o = __shfl_xor(f[e], 1); f[e] = ((c & 1) ? o - f[e] : f[e] + o) * sc; } else f[e] *= sc; }
          u32x4 o; o.x = pk4_i8(f[0], f[1], f[2], f[3]); o.y = pk4_i8(f[4], f[5], f[6], f[7]); o.z = pk4_i8(f[8], f[9], f[10], f[11]); o.w = pk4_i8(f[12], f[13], f[14], f[15]);
          *(u32x4*)(WT8 + (size_t)(n0 + n) * K + k0 + 16 * c) = o; } }
    LDS_WAIT(); asm volatile("" ::: "memory");
}
__device__ __forceinline__ void p0_matrix(const float* W, int K, int N, bf16_t* WT, int ilv_half  , int r, LAS float* scr, int lane, const float* kgain = nullptr) {
    const int nblk = N / 64, kb = (r / (4 * nblk)) * 4 + (r & 3), nb = (r >> 2) % nblk, n0 = 64 * nb;
    const int drow0 = ilv_half < 0 ? n0 : (n0 / 128) * 256 + ilv_half * 128 + (n0 % 128);
    p0_transpose_item(W, K, N, WT, 64 * kb, n0, drow0, scr, lane, kgain);
}
__device__ __forceinline__ void p0_transpose_item8(const float* W, int K, int N, unsigned char* WT, int k0, int n0, int drow0, float sc, LAS float* scr, int lane) {
    p0_load_tile(W, N, k0, n0, scr, lane);
    const int c = lane & 3;
#pragma unroll
    for (int j = 0; j < 4; ++j) { const int n = (lane >> 2) + 16 * j; const LAS float* s = scr + (16 * c) * P0S + n;
        u32x4 o; o.x = pk4_fp8(s[0 * P0S] * sc, s[1 * P0S] * sc, s[2 * P0S] * sc, s[3 * P0S] * sc); o.y = pk4_fp8(s[4 * P0S] * sc, s[5 * P0S] * sc, s[6 * P0S] * sc, s[7 * P0S] * sc);
        o.z = pk4_fp8(s[8 * P0S] * sc, s[9 * P0S] * sc, s[10 * P0S] * sc, s[11 * P0S] * sc); o.w = pk4_fp8(s[12 * P0S] * sc, s[13 * P0S] * sc, s[14 * P0S] * sc, s[15 * P0S] * sc);
        *(u32x4*)(WT + (size_t)(drow0 + n) * K + k0 + 16 * c) = o; }
    LDS_WAIT(); asm volatile("" ::: "memory");
}
__device__ __forceinline__ void p0_matrix8(const float* W, int K, int N, unsigned char* WT, int ilv_half, float sc, int r, LAS float* scr, int lane) {
    const int nblk = N / 64, kb = (r / (4 * nblk)) * 4 + (r & 3), nb = (r >> 2) % nblk, n0 = 64 * nb;
    const int drow0 = ilv_half < 0 ? n0 : (n0 / 128) * 256 + ilv_half * 128 + (n0 % 128);
    p0_transpose_item8(W, K, N, WT, 64 * kb, n0, drow0, sc, scr, lane);
}

__device__ __forceinline__ void p0_transpose_item_i8(const float* W, int K, int N, unsigned char* WT, int k0, int n0, int drow0, float sc, LAS float* scr, int lane, const float* kgain) {
    p0_load_tile(W, N, k0, n0, scr, lane, kgain);
    const int c = lane & 3;
#pragma unroll
    for (int j = 0; j < 4; ++j) { const int n = (lane >> 2) + 16 * j; const LAS float* s = scr + (16 * c) * P0S + n;
        u32x4 o; o.x = pk4_i8(s[0 * P0S] * sc, s[1 * P0S] * sc, s[2 * P0S] * sc, s[3 * P0S] * sc); o.y = pk4_i8(s[4 * P0S] * sc, s[5 * P0S] * sc, s[6 * P0S] * sc, s[7 * P0S] * sc);
        o.z = pk4_i8(s[8 * P0S] * sc, s[9 * P0S] * sc, s[10 * P0S] * sc, s[11 * P0S] * sc); o.w = pk4_i8(s[12 * P0S] * sc, s[13 * P0S] * sc, s[14 * P0S] * sc, s[15 * P0S] * sc);
        *(u32x4*)(WT + (size_t)(drow0 + n) * K + k0 + 16 * c) = o; }
    LDS_WAIT(); asm volatile("" ::: "memory");
}
__device__ __forceinline__ void p0_matrix_i8(const float* W, int K, int N, unsigned char* WT, int ilv_half, float sc, int r, LAS float* scr, int lane, const float* kgain) {
    const int nblk = N / 64, kb = (r / (4 * nblk)) * 4 + (r & 3), nb = (r >> 2) % nblk, n0 = 64 * nb;
    const int drow0 = ilv_half < 0 ? n0 : (n0 / 128) * 256 + ilv_half * 128 + (n0 % 128);
    p0_transpose_item_i8(W, K, N, WT, 64 * kb, n0, drow0, sc, scr, lane, kgain);
}

__device__ __forceinline__ void rms_rows_to_bf16(const float* x, const float* gain, bf16_t* o, int m0, int step, int m1, int lane) {
    f32x4 g[4][2];
#pragma unroll
    for (int j = 0; j < 4; ++j) { const f32x4* gp = (const f32x4*)(gain + 8 * (lane + 64 * j)); g[j][0] = gp[0]; g[j][1] = gp[1]; }
    for (int m = m0; m < m1; m += step) {
        const float* xrow = x + (size_t)m * D; bf16_t* orow = o + (size_t)m * D;
        f32x4 v[4][2]; float s = 0.f;
#pragma unroll
        for (int j = 0; j < 4; ++j) { const f32x4* p = (const f32x4*)(xrow + 8 * (lane + 64 * j)); v[j][0] = p[0]; v[j][1] = p[1]; }
#pragma unroll
        for (int j = 0; j < 4; ++j)
            s += (v[j][0].x * v[j][0].x + v[j][0].y * v[j][0].y) + (v[j][0].z * v[j][0].z + v[j][0].w * v[j][0].w) + (v[j][1].x * v[j][1].x + v[j][1].y * v[j][1].y) + (v[j][1].z * v[j][1].z + v[j][1].w * v[j][1].w);
        const float rstd = 1.0f / sqrtf(wave_sum(s) * (1.0f / D) + RMS_EPS);
#pragma unroll
        for (int j = 0; j < 4; ++j) { const f32x4 a = v[j][0] * rstd * g[j][0], b = v[j][1] * rstd * g[j][1];
            u32x4 w; w.x = cvt_pk_bf16(a.x, a.y); w.y = cvt_pk_bf16(a.z, a.w); w.z = cvt_pk_bf16(b.x, b.y); w.w = cvt_pk_bf16(b.z, b.w);
            *(u32x4*)(orow + 8 * (lane + 64 * j)) = w; }
    }
}

__device__ __forceinline__ void rms_rows_to_i8(const float* x, const float* gain, unsigned char* o, int m0, int step, int m1, int lane) {
    f32x4 g[4][2];
#pragma unroll
    for (int j = 0; j < 4; ++j) { const f32x4* gp = (const f32x4*)(gain + 8 * (lane + 64 * j)); g[j][0] = gp[0] * SC_A8; g[j][1] = gp[1] * SC_A8; }
    for (int m = m0; m < m1; m += step) {
        const float* xrow = x + (size_t)m * D; unsigned char* orow = o + (size_t)m * D;
        f32x4 v[4][2]; float s = 0.f;
#pragma unroll
        for (int j = 0; j < 4; ++j) { const f32x4* p = (const f32x4*)(xrow + 8 * (lane + 64 * j)); v[j][0] = p[0]; v[j][1] = p[1]; }
#pragma unroll
        for (int j = 0; j < 4; ++j)
            s += (v[j][0].x * v[j][0].x + v[j][0].y * v[j][0].y) + (v[j][0].z * v[j][0].z + v[j][0].w * v[j][0].w) + (v[j][1].x * v[j][1].x + v[j][1].y * v[j][1].y) + (v[j][1].z * v[j][1].z + v[j][1].w * v[j][1].w);
        const float rstd = 1.0f / sqrtf(wave_sum(s) * (1.0f / D) + RMS_EPS);
#pragma unroll
        for (int j = 0; j < 4; ++j) { const f32x4 a = v[j][0] * rstd * g[j][0], b = v[j][1] * rstd * g[j][1];
            u32x2 w; w.x = pk4_i8(a.x, a.y, a.z, a.w); w.y = pk4_i8(b.x, b.y, b.z, b.w); *(u32x2*)(orow + 8 * (lane + 64 * j)) = w; }
    }
}


__device__ __forceinline__ void meta_rstd(const float* src, LAS float* rs, int wave, int lane) {
#pragma unroll
    for (int rr = 0; rr < 2; ++rr) { const int row = 2 * wave + rr; float s = 0.f;
#pragma unroll
        for (int j = 0; j < 8; ++j) { const f32x4 v = *(const f32x4*)(src + (size_t)row * D + 4 * (lane + 64 * j)); s += (v.x * v.x + v.y * v.y) + (v.z * v.z + v.w * v.w); }
        s = wave_sum(s); if (lane == 0) rs[row] = 1.0f / sqrtf(s * (1.0f / D) + RMS_EPS); }
    __syncthreads();
}

struct FNorm { const float* src; const float* gain; const LAS float* rstd; int K;
    __device__ __forceinline__ void operator()(int row, int k, float (&a)[8]) const { const f32x4* p = (const f32x4*)(src + (size_t)row * K + k); const float r = rstd[row]; f32x4 x = p[0] * r, y = p[1] * r;
        if (gain) { const f32x4* gp = (const f32x4*)(gain + k); x = x * gp[0]; y = y * gp[1]; } a[0] = x.x; a[1] = x.y; a[2] = x.z; a[3] = x.w; a[4] = y.x; a[5] = y.y; a[6] = y.z; a[7] = y.w; } };
struct FCvt { const float* src; int K;
    __device__ __forceinline__ void operator()(int row, int k, float (&a)[8]) const { const f32x4* p = (const f32x4*)(src + (size_t)row * K + k); const f32x4 x = p[0], y = p[1];
        a[0] = x.x; a[1] = x.y; a[2] = x.z; a[3] = x.w; a[4] = y.x; a[5] = y.y; a[6] = y.z; a[7] = y.w; } };
template <int WF, int C, class AL, class CM, class EP>
__device__ __forceinline__ void meta_gemm_mc(const void* Btv, int K, int ngroups, float wsc, const AL& A, const CM& colmap, const EP& E, int gw, int NGW, int lane) {
    for (int g = gw; g < ngroups; g += NGW) {
#pragma unroll 1
        for (int rb = 0; rb < 16; rb += 4) {
            float acc[4][C];
#pragma unroll
            for (int r = 0; r < 4; ++r)
#pragma unroll
                for (int c = 0; c < C; ++c) acc[r][c] = 0.f;
#pragma unroll 1
            for (int k = lane * 8; k < K; k += 512) {
                float a[4][8];
#pragma unroll
                for (int r = 0; r < 4; ++r) A(rb + r, k, a[r]);
#pragma unroll
                for (int c = 0; c < C; ++c) { const int n = colmap(g, c); float wf[8];
                    if constexpr (WF == 0) { const u32x4 w = *(const u32x4*)((const bf16_t*)Btv + (size_t)n * K + k);
                        wf[0] = bflo(w.x); wf[1] = bfhi(w.x); wf[2] = bflo(w.y); wf[3] = bfhi(w.y); wf[4] = bflo(w.z); wf[5] = bfhi(w.z); wf[6] = bflo(w.w); wf[7] = bfhi(w.w); }
                    else { const u32x2 w = *(const u32x2*)((const unsigned char*)Btv + (size_t)n * K + k);
                        if constexpr (WF == 1) {
#pragma unroll
                            for (int e = 0; e < 4; ++e) { wf[e] = (float)((int)(w.x << (24 - 8 * e)) >> 24); wf[4 + e] = (float)((int)(w.y << (24 - 8 * e)) >> 24); } }
                        else { wf[0] = __builtin_amdgcn_cvt_f32_fp8((int)w.x, 0); wf[1] = __builtin_amdgcn_cvt_f32_fp8((int)w.x, 1); wf[2] = __builtin_amdgcn_cvt_f32_fp8((int)w.x, 2); wf[3] = __builtin_amdgcn_cvt_f32_fp8((int)w.x, 3);
                               wf[4] = __builtin_amdgcn_cvt_f32_fp8((int)w.y, 0); wf[5] = __builtin_amdgcn_cvt_f32_fp8((int)w.y, 1); wf[6] = __builtin_amdgcn_cvt_f32_fp8((int)w.y, 2); wf[7] = __builtin_amdgcn_cvt_f32_fp8((int)w.y, 3); } }
#pragma unroll
                    for (int r = 0; r < 4; ++r)
#pragma unroll
                        for (int e = 0; e < 8; ++e) acc[r][c] += a[r][e] * wf[e]; }
            }
#pragma unroll
            for (int r = 0; r < 4; ++r)
#pragma unroll
                for (int c = 0; c < C; ++c) acc[r][c] = wave_sum(acc[r][c]) * wsc;
            E(rb, g, acc, lane);
        }
    }
}
template <int C> struct CMCons { __device__ __forceinline__ int operator()(int g, int c) const { return g * C + c; } };
struct CMGateUp { __device__ __forceinline__ int operator()(int g, int c) const { const int ch = 4 * g + (c & 3); return (ch >> 7) * 256 + (ch & 127) + (c >> 2) * 128; } };
template <int C> struct EStoreC { float* out; int ldc;
    __device__ __forceinline__ void operator()(int rb, int g, const float (&v)[4][C], int lane) const {
#pragma unroll
        for (int r = 0; r < 4; ++r)
#pragma unroll
            for (int c = 0; c < C; ++c) if (lane == r * C + c) out[(size_t)(rb + r) * ldc + g * C + c] = v[r][c]; } };
template <int C> struct EResidC { const float* base; float* out; int ldc;
    __device__ __forceinline__ void operator()(int rb, int g, const float (&v)[4][C], int lane) const {
#pragma unroll
        for (int r = 0; r < 4; ++r)
#pragma unroll
            for (int c = 0; c < C; ++c) if (lane == r * C + c) { const size_t o = (size_t)(rb + r) * ldc + g * C + c; out[o] = base[o] + v[r][c]; } } };
struct ESiluAct { float* act;
    __device__ __forceinline__ void operator()(int rb, int g, const float (&v)[4][8], int lane) const {
#pragma unroll
        for (int r = 0; r < 4; ++r)
#pragma unroll
            for (int c = 0; c < 4; ++c) if (lane == r * 4 + c) act[(size_t)(rb + r) * FF + 4 * g + c] = pg8::silu_mul(v[r][c], v[r][c + 4]); } };

namespace att {
constexpr int NSLOT = 3, SLOT = 32768, OFF_KM = 98304, OFF_VM = OFF_KM + 4096, OFF_QM = OFF_VM + 4096, OFF_BIAS = OFF_QM + 4096, OFF_MB = OFF_BIAS + 4096, OFF_SC = OFF_MB + 256;
constexpr int BIAS_SLACK = 256;
__device__ __forceinline__ int swzK(int key) { return ((key >> 3) & 3) * 4 + (key & 3); }
__device__ __forceinline__ int gswV(int row) { return ((row & 3) << 2) | ((row >> 2) & 3); }
__device__ __forceinline__ int r0_of(int r) { const int a = r - 4; return a < 0 ? 0 : (a > GR - 8 ? GR - 8 : a); }
__device__ __forceinline__ bf16x4 tr_read(unsigned addr) { bf16x4 r; asm volatile("ds_read_b64_tr_b16 %0, %1" : "=v"(r) : "v"(addr)); return r; }

__device__ __forceinline__ void meta_step(LAS unsigned char* lds, const bf16x8 (&qf)[4], float Mq, f32x4 (&O)[8], float& lsum, int fr, int fq, int lane) {
    f32x4 s = (f32x4){0.f, 0.f, 0.f, 0.f};
#pragma unroll
    for (int ks = 0; ks < 4; ++ks) { const bf16x8 kf = *(const LAS bf16x8*)(lds + OFF_KM + fr * 256 + (((4 * ks + fq) ^ fr) << 4)); s = __builtin_amdgcn_mfma_f32_16x16x32_bf16(kf, qf[ks], s, 0, 0, 0); }
    const LAS float* mb = (const LAS float*)(lds + OFF_MB);
    float p[4];
#pragma unroll
    for (int i = 0; i < 4; ++i) { p[i] = __builtin_amdgcn_exp2f(s[i] + mb[4 * fq + i] - Mq); lsum += p[i]; }
    u32x4 pw; pw.x = cvt_pk_bf16(p[0], p[1]); pw.y = cvt_pk_bf16(p[2], p[3]); pw.z = 0u; pw.w = 0u;
    const bf16x8 pf = __builtin_bit_cast(bf16x8, pw);
    const int g = lane >> 4, q = (lane & 15) >> 2, pp = lane & 3, row = 4 * g + q;
    const unsigned vbase = (unsigned)(size_t)(lds + OFF_VM) + 256u * row + 8u * (pp & 1);
    bf16x4 v[8];
#pragma unroll
    for (int dt = 0; dt < 8; ++dt) v[dt] = tr_read(vbase + 16u * ((unsigned)(2 * dt + (pp >> 1)) ^ (unsigned)gswV(row)));
    asm volatile("s_waitcnt lgkmcnt(0)" : "+v"(v[0]), "+v"(v[1]), "+v"(v[2]), "+v"(v[3]), "+v"(v[4]), "+v"(v[5]), "+v"(v[6]), "+v"(v[7]) :: "memory");
#pragma unroll
    for (int dt = 0; dt < 8; ++dt) { bf16x8 vf; vf[0] = v[dt][0]; vf[1] = v[dt][1]; vf[2] = v[dt][2]; vf[3] = v[dt][3]; vf[4] = v[dt][0]; vf[5] = v[dt][1]; vf[6] = v[dt][2]; vf[7] = v[dt][3];
        O[dt] = __builtin_amdgcn_mfma_f32_16x16x32_bf16(vf, pf, O[dt], 0, 0, 0); }
}

__device__ __forceinline__ void attn_phase(LAS unsigned char* lds, const bf16_t* qkv, const float* qkv_m, const float* q_gain, const float* k_gain, const float* rel_bias,
                                           const float* meta_bias, bf16_t* o, float* o_m, int G, int bid) {
    const int tid = threadIdx.x, wid = __builtin_amdgcn_readfirstlane(tid >> 6), lane = tid & 63, fr = lane & 15, fq = lane >> 4;
    const int UPW = (NB * NH * (GR / 2)) / G;
    const int u0 = bid * UPW, bh = u0 / (GR / 2), b = bh / NH, h = bh % NH;
    const float QSCALE = 0.08838834764831845f * LOG2E;
    if (tid < 256) { const int m = tid >> 4, ch = tid & 15;
        { const f32x4* p = (const f32x4*)(qkv_m + (size_t)m * NQKV + D + h * HD + ch * 8); const f32x4 a = p[0], c = p[1];
          float ss = (a.x * a.x + a.y * a.y) + (a.z * a.z + a.w * a.w) + (c.x * c.x + c.y * c.y) + (c.z * c.z + c.w * c.w);
          ss += __shfl_xor(ss, 1); ss += __shfl_xor(ss, 2); ss += __shfl_xor(ss, 4); ss += __shfl_xor(ss, 8);
          const float r = 1.0f / sqrtf(ss * (1.0f / HD) + RMS_EPS); const f32x4* gp = (const f32x4*)(k_gain + ch * 8); const f32x4 x = a * gp[0] * r, y = c * gp[1] * r;
          u32x4 w; w.x = cvt_pk_bf16(x.x, x.y); w.y = cvt_pk_bf16(x.z, x.w); w.z = cvt_pk_bf16(y.x, y.y); w.w = cvt_pk_bf16(y.z, y.w);
          *(LAS u32x4*)(lds + OFF_KM + m * 256 + ((ch ^ m) << 4)) = w; }
        { const f32x4* p = (const f32x4*)(qkv_m + (size_t)m * NQKV + 2 * D + h * HD + ch * 8); const f32x4 a = p[0], c = p[1];
          u32x4 w; w.x = cvt_pk_bf16(a.x, a.y); w.y = cvt_pk_bf16(a.z, a.w); w.z = cvt_pk_bf16(c.x, c.y); w.w = cvt_pk_bf16(c.z, c.w);
          *(LAS u32x4*)(lds + OFF_VM + m * 256 + ((ch ^ gswV(m)) << 4)) = w; }
        { const f32x4* p = (const f32x4*)(qkv_m + (size_t)m * NQKV + h * HD + ch * 8); const f32x4 a = p[0], c = p[1];
          float ss = (a.x * a.x + a.y * a.y) + (a.z * a.z + a.w * a.w) + (c.x * c.x + c.y * c.y) + (c.z * c.z + c.w * c.w);
          ss += __shfl_xor(ss, 1); ss += __shfl_xor(ss, 2); ss += __shfl_xor(ss, 4); ss += __shfl_xor(ss, 8);
          const float r = QSCALE / sqrtf(ss * (1.0f / HD) + RMS_EPS); const f32x4* gp = (const f32x4*)(q_gain + ch * 8); const f32x4 x = a * gp[0] * r, y = c * gp[1] * r;
          u32x4 w; w.x = cvt_pk_bf16(x.x, x.y); w.y = cvt_pk_bf16(x.z, x.w); w.z = cvt_pk_bf16(y.x, y.y); w.w = cvt_pk_bf16(y.z, y.w);
          *(LAS u32x4*)(lds + OFF_QM + m * 256 + (ch << 4)) = w; }
    }
    { LAS float* bt = (LAS float*)(lds + OFF_BIAS); for (int i = tid; i < 1024; i += NTHREADS) { const int j = i - BIAS_SLACK; bt[i] = (j >= 0 && j < 15 * 31) ? rel_bias[h * 465 + j] * LOG2E : 0.f; }
      if (tid < 16) ((LAS float*)(lds + OFF_MB))[tid] = meta_bias[h * 16 + tid] * LOG2E; }
    __syncthreads();
    float maxbias, KB;
    { const LAS float* bt = (const LAS float*)(lds + OFF_BIAS) + BIAS_SLACK; float mx = -1e30f;
      for (int i = lane; i < 465; i += 64) mx = fmaxf(mx, bt[i]);
      if (lane < 16) mx = fmaxf(mx, ((const LAS float*)(lds + OFF_MB))[lane]);
      maxbias = wave_max(mx);
      KB = wave_max(fmaxf(fabsf(k_gain[lane]), fabsf(k_gain[lane + 64]))) * 11.313708498984761f * 1.01f; }
    const int j = wid & 3, cq = 16 * j + fr, kc0 = (16 * j - 8) < 0 ? 0 : ((16 * j - 8) > 32 ? 32 : (16 * j - 8));
    const int c0 = (cq - 8) < 0 ? 0 : ((cq - 8) > GW - 16 ? GW - 16 : (cq - 8)), dlo = c0 - cq;
    const int cb = kc0 + 8 * fq - cq + 15;
    unsigned vmask = 0u;
#pragma unroll
    for (int t = 0; t < 2; ++t)
#pragma unroll
        for (int i = 0; i < 4; ++i) { const int dc = kc0 + 8 * fq + 4 * t + i - cq; if (dc >= dlo && dc <= dlo + 15) vmask |= 1u << (4 * t + i); }
    unsigned koff[2];
#pragma unroll
    for (int t = 0; t < 2; ++t) { const int key = kc0 + 8 * (fr >> 2) + (fr & 3) + 4 * t; koff[t] = (unsigned)(key * 256) | ((unsigned)swzK(key) << 16); }
    const int tg = lane >> 4, tq = (lane & 15) >> 2, tp = lane & 3;
    unsigned vrow[2], vsw[2];
#pragma unroll
    for (int t = 0; t < 2; ++t) { const int row = kc0 + 8 * tg + 4 * t + tq; vrow[t] = (unsigned)(row * 256 + 8 * (tp & 1)); vsw[t] = (unsigned)gswV(row); }
    unsigned dK[2], dV[2];
#pragma unroll
    for (int ii = 0; ii < 2; ++ii) { const int p = tid + 512 * ii, key = p >> 4, sc = p & 15; dK[ii] = (unsigned)(key * (NQKV * 2) + ((sc ^ swzK(key)) << 4)); dV[ii] = (unsigned)(key * (NQKV * 2) + ((sc ^ gswV(key)) << 4)); }
    const char* kbase = (const char*)qkv + ((size_t)b * SEQ * NQKV + D + h * HD) * 2;
    const unsigned ldsw = (unsigned)wid * 1024u;
#define ATT_ISSUE(krow, slot) do { const char* _s = kbase + (size_t)(krow) * (GW * NQKV * 2); _Pragma("unroll") for (int _i = 0; _i < 2; ++_i) { \
        __builtin_amdgcn_global_load_lds((const unsigned*)(_s + dK[_i]), (LAS unsigned*)(lds + (slot) * SLOT + ldsw + _i * 8192), 16, 0, 0); \
        __builtin_amdgcn_global_load_lds((const unsigned*)(_s + D * 2 + dV[_i]), (LAS unsigned*)(lds + (slot) * SLOT + 16384 + ldsw + _i * 8192), 16, 0, 0); } } while (0)

    if (b == 0 && (bid % (G / (NB * NH))) == 0 && wid == 0) {
        bf16x8 qf[4]; float ssq = 0.f;
#pragma unroll
        for (int ks = 0; ks < 4; ++ks) { qf[ks] = *(const LAS bf16x8*)(lds + OFF_QM + fr * 256 + ((4 * ks + fq) << 4));
#pragma unroll
            for (int e = 0; e < 8; ++e) { const float f = bf2f((unsigned short)qf[ks][e]); ssq += f * f; } }
        ssq += __shfl_xor(ssq, 16); ssq += __shfl_xor(ssq, 32);
        const float Mq = sqrtf(ssq) * KB + maxbias;
        f32x4 O[8]; float lsum = 0.f;
#pragma unroll
        for (int dt = 0; dt < 8; ++dt) O[dt] = (f32x4){0.f, 0.f, 0.f, 0.f};
        meta_step(lds, qf, Mq, O, lsum, fr, fq, lane);
        lsum += __shfl_xor(lsum, 16); lsum += __shfl_xor(lsum, 32);
        const float inv = 1.0f / lsum;
#pragma unroll
        for (int dt = 0; dt < 8; ++dt) *(f32x4*)(o_m + (size_t)fr * D + h * HD + 16 * dt + 4 * fq) = O[dt] * inv;
    }

    int iu = 0, irp = (u0 % (GR / 2)), ilo = r0_of(2 * irp), ihi = r0_of(2 * irp + 1) + 7, ii_ = ilo, gI = 0;
#define ATT_ADV() do { if (++ii_ > ihi) { ++iu; ++irp; if (iu < UPW) { ilo = r0_of(2 * irp); ihi = r0_of(2 * irp + 1) + 7; ii_ = ilo; } } } while (0)
    for (int d = 0; d < 2; ++d) if (iu < UPW) { ATT_ISSUE(ii_, gI % NSLOT); ATT_ADV(); ++gI; }
    int gC = 0;
    for (int ku = 0; ku < UPW; ++ku) {
        const int rp = (u0 % (GR / 2)) + ku, qr = 2 * rp + (wid >> 2), r0w = r0_of(qr), lo = r0_of(2 * rp), hi = r0_of(2 * rp + 1) + 7;
        const size_t qrow = (size_t)b * SEQ + (size_t)qr * GW + cq;
        bf16x8 qf[4]; float ssq = 0.f;
#pragma unroll
        for (int ks = 0; ks < 4; ++ks) { qf[ks] = *(const bf16x8*)(qkv + qrow * NQKV + h * HD + 32 * ks + 8 * fq);
#pragma unroll
            for (int e = 0; e < 8; ++e) { const float f = bf2f((unsigned short)qf[ks][e]); ssq += f * f; } }
        ssq += __shfl_xor(ssq, 16); ssq += __shfl_xor(ssq, 32);
        const float Mq = sqrtf(ssq) * KB + maxbias;
        f32x4 O[8]; float lsum = 0.f;
#pragma unroll
        for (int dt = 0; dt < 8; ++dt) O[dt] = (f32x4){0.f, 0.f, 0.f, 0.f};
        for (int i = lo; i <= hi; ++i) {
            if (gI > gC + 1) asm volatile("s_waitcnt vmcnt(4)" ::: "memory"); else asm volatile("s_waitcnt vmcnt(0)" ::: "memory");
            __builtin_amdgcn_s_barrier();
            if (iu < UPW) { ATT_ISSUE(ii_, gI % NSLOT); ATT_ADV(); ++gI; }
            if (i >= r0w && i <= r0w + 7) {
                const int slot = gC % NSLOT; const int dr = i - qr;
                LAS unsigned char* sk = lds + slot * SLOT;
                f32x4 s[2];
#pragma unroll
                for (int t = 0; t < 2; ++t) { s[t] = (f32x4){0.f, 0.f, 0.f, 0.f};
#pragma unroll
                    for (int ks = 0; ks < 4; ++ks) { const bf16x8 kf = *(const LAS bf16x8*)(sk + (koff[t] & 0xffffu) + ((((unsigned)(4 * ks + fq)) ^ (koff[t] >> 16)) << 4));
                        s[t] = __builtin_amdgcn_mfma_f32_16x16x32_bf16(kf, qf[ks], s[t], 0, 0, 0); } }
                const LAS float* bt = (const LAS float*)(lds + OFF_BIAS) + BIAS_SLACK + (dr + 7) * 31 + cb;
                float p[8];
#pragma unroll
                for (int t = 0; t < 2; ++t)
#pragma unroll
                    for (int e = 0; e < 4; ++e) { const float v = __builtin_amdgcn_exp2f(s[t][e] + bt[4 * t + e] - Mq); p[4 * t + e] = ((vmask >> (4 * t + e)) & 1u) ? v : 0.f; lsum += p[4 * t + e]; }
                u32x4 pw; pw.x = cvt_pk_bf16(p[0], p[1]); pw.y = cvt_pk_bf16(p[2], p[3]); pw.z = cvt_pk_bf16(p[4], p[5]); pw.w = cvt_pk_bf16(p[6], p[7]);
                const bf16x8 pf = __builtin_bit_cast(bf16x8, pw);
                const unsigned vb = (unsigned)(size_t)(sk + 16384);
#pragma unroll
                for (int hb = 0; hb < 2; ++hb) {
                    bf16x4 v0[4], v1[4];
#pragma unroll
                    for (int d4 = 0; d4 < 4; ++d4) { const int dt = 4 * hb + d4;
                        v0[d4] = tr_read(vb + vrow[0] + 16u * (((unsigned)(2 * dt + (tp >> 1))) ^ vsw[0]));
                        v1[d4] = tr_read(vb + vrow[1] + 16u * (((unsigned)(2 * dt + (tp >> 1))) ^ vsw[1])); }
                    asm volatile("s_waitcnt lgkmcnt(0)" : "+v"(v0[0]), "+v"(v0[1]), "+v"(v0[2]), "+v"(v0[3]), "+v"(v1[0]), "+v"(v1[1]), "+v"(v1[2]), "+v"(v1[3]) :: "memory");
#pragma unroll
                    for (int d4 = 0; d4 < 4; ++d4) { bf16x8 vf; vf[0] = v0[d4][0]; vf[1] = v0[d4][1]; vf[2] = v0[d4][2]; vf[3] = v0[d4][3]; vf[4] = v1[d4][0]; vf[5] = v1[d4][1]; vf[6] = v1[d4][2]; vf[7] = v1[d4][3];
                        O[4 * hb + d4] = __builtin_amdgcn_mfma_f32_16x16x32_bf16(vf, pf, O[4 * hb + d4], 0, 0, 0); }
                }
            }
            ++gC;
        }
        meta_step(lds, qf, Mq, O, lsum, fr, fq, lane);
        lsum += __shfl_xor(lsum, 16); lsum += __shfl_xor(lsum, 32);
        const float inv = 1.0f / lsum;
#pragma unroll
        for (int dt = 0; dt < 8; ++dt) { const f32x4 v = O[dt] * (inv * SC_O8);
            *(unsigned*)((unsigned char*)o + qrow * D + h * HD + 16 * dt + 4 * fq) = pk4_i8(v[0], v[1], v[2], v[3]); }
    }
    VM_WAIT();
    __syncthreads();
#undef ATT_ISSUE
#undef ATT_ADV
}
}


constexpr int NPHASES = 17;
struct Args { const float* in[22]; float* out; unsigned char* ws; int ph_lo, ph_hi; };
static_assert(sizeof(Args) == 22 * 8 + 8 + 8 + 8, "Args has no padding");
enum { I_X = 0, I_META, I_ATTN_NORM, I_WQKV, I_QGAIN, I_KGAIN, I_RELBIAS, I_METABIAS, I_WO, I_CONV_NORM, I_WIN, I_CONVW, I_WOUT, I_DENSE_NORM, I_WGATE, I_WUP, I_WDOWN,
       I_MOE_NORM, I_WROUTER, I_MGATE, I_MUP, I_MDOWN };

__global__ void __launch_bounds__(NTHREADS, 2) enc_fwd(Args args) {
    extern __shared__ __attribute__((aligned(16))) unsigned char lds_raw[];
    LAS unsigned char* lds = (LAS unsigned char*)lds_raw;
    const int tid = threadIdx.x, lane = tid & 63, wave = __builtin_amdgcn_readfirstlane(tid >> 6);
    const int G = gridDim.x, bid = blockIdx.x;
    const int gw = bid * NWAVES + wave, NGW = G * NWAVES;
    unsigned char* ws = args.ws;
    unsigned* ctl = (unsigned*)(ws + WS_CTL);
    float* out = args.out;
    bf16_t* XA = (bf16_t*)(ws + WS_XA); bf16_t* BIG = (bf16_t*)(ws + WS_BIG); bf16_t* Y1 = (bf16_t*)(ws + WS_Y1);
    unsigned char* XQ = ws + WS_XQ; unsigned char* ACT8 = ws + WS_BIG;
    float* rs1 = (float*)(ws + WS_RS1); float* rs2 = (float*)(ws + WS_RS2); unsigned char* HB1 = ws + WS_XBUF;
    bf16_t* H1B = (bf16_t*)(ws + WS_H1B); bf16_t* H2B = (bf16_t*)(ws + WS_H2B); bf16_t* H3B = H1B; bf16_t* Y0 = H2B;
    float* qkv_m = (float*)(ws + MT_QKV); float* o_m = (float*)(ws + MT_O); float* h1_m = (float*)(ws + MT_H1); float* act_m = (float*)(ws + MT_GU); float* h2_m = (float*)(ws + MT_H2); float* cgu_m = (float*)(ws + MT_CGU);
    int* tok_e = (int*)(ws + MO_TOKE); float* tok_g = (float*)(ws + MO_TOKG); int* cnt = (int*)(ws + MO_CNT); int* rowinfo = (int*)(ws + MO_ROWINFO); float* rowgate = (float*)(ws + MO_ROWGATE); int* tile_e = (int*)(ws + MO_TILEE);

    if (tid < 2) ((LAS unsigned*)(lds + XBW_OFF))[tid] = 0u;
    __syncthreads();
#if MK_N_LAUNCHES == 1
    XcdBarrier bar = xcd_barrier_post(ctl + CW_BAR, (volatile LAS unsigned*)(lds + XBW_OFF));
#define GRID_BAR() xcd_barrier(bar)
#else
#define GRID_BAR() do { } while (0)
#endif
    const int lo = args.ph_lo, hi = args.ph_hi;
#define IN(k) (lo <= (k) && (k) < hi)
#define SEAM(k) do { if (IN((k) + 1)) GRID_BAR(); } while (0)


    if (IN(0)) {
        LAS float* scr = (LAS float*)(lds + wave * 16896);
        constexpr int I_A = (D / 64) * (NQKV / 64), I_B = (D / 64) * (D / 64), I_F = (D / 64) * (FF / 64), I_Dn = (FF / 64) * (D / 64);
        static_assert(I_F == I_Dn, "items");
        constexpr int NITEMS = 2 * I_A + 2 * I_B + 3 * I_F + 3 * NE * I_F;
        for (int it = gw; it < NITEMS; it += NGW) {
            int r = it;
            if (r < I_A) { p0_matrix_i8(args.in[I_WQKV], D, NQKV, ws + W_QKV8, -1, SC_W8, r, scr, lane, nullptr); continue; } r -= I_A;
            if (r < I_B) { p0_matrix_i8(args.in[I_WO], D, D, ws + W_O8, -1, SC_W8, r, scr, lane, nullptr); continue; } r -= I_B;
            if (r < I_F) { p0_matrix_i8(args.in[I_WGATE], D, FF, ws + W_GU8, 0, SC_W8, r, scr, lane, args.in[I_DENSE_NORM]); continue; } r -= I_F;
            if (r < I_F) { p0_matrix_i8(args.in[I_WUP], D, FF, ws + W_GU8, 1, SC_W8, r, scr, lane, args.in[I_DENSE_NORM]); continue; } r -= I_F;
            if (r < I_F) { const int nblk = D / 64, kb = (r / (4 * nblk)) * 4 + (r & 3), nb = (r >> 2) % nblk;
                p0_item_dn<8>(args.in[I_WDOWN], FF, D, (bf16_t*)(ws + W_DN), ws + W_DN8, SC_WDR, 64 * kb, 64 * nb, scr, lane); continue; } r -= I_F;
            if (r < I_A) {
                const int nblk = NQKV / 64, kb = (r / (4 * nblk)) * 4 + (r & 3), nb = (r >> 2) % nblk, n0 = 64 * nb; int drow0;
                if (n0 < D) drow0 = n0; else { const int part = (n0 - D) / D, zc = (n0 - D) % D; drow0 = D + (zc / 128) * 256 + part * 128 + (zc % 128); }
                p0_transpose_item_i8(args.in[I_WIN], D, NQKV, ws + W_IN, 64 * kb, n0, drow0, SC_W8, scr, lane, args.in[I_CONV_NORM]); continue; } r -= I_A;
            if (r < I_B) { const int nblk = D / 64, kb = (r / (4 * nblk)) * 4 + (r & 3), nb = (r >> 2) % nblk;
                p0_item_dn<32>(args.in[I_WOUT], D, D, nullptr, ws + W_OUT, SC_W8, 64 * kb, 64 * nb, scr, lane); continue; } r -= I_B;
            { const int which = r / (NE * I_F), rr = r % (NE * I_F), e = rr / I_F, ri = rr % I_F;
              if (which == 0) p0_matrix_i8(args.in[I_MGATE] + (size_t)e * D * FF, D, FF, ws + W_MGU + (size_t)e * NGU * D, 0, SC_W8, ri, scr, lane, nullptr);
              else if (which == 1) p0_matrix_i8(args.in[I_MUP] + (size_t)e * D * FF, D, FF, ws + W_MGU + (size_t)e * NGU * D, 1, SC_W8, ri, scr, lane, nullptr);
              else p0_matrix8(args.in[I_MDOWN] + (size_t)e * FF * D, FF, D, ws + W_MDN + (size_t)e * D * FF, -1, SC_WDN, ri, scr, lane); }
        }
        rms_rows_to_i8(args.in[I_X], args.in[I_ATTN_NORM], (unsigned char*)XA, gw, NGW, M, lane);
        SEAM(0);
    }
    if (IN(1)) {
        { pg8::Gemm g{XA, ws + W_QKV8, D}; pg8::StaticOrder S; S.init(M, NQKV, G, bid); pg8::EpiQKV E{BIG, NQKV, 1.0f / (SC_A8 * SC_W8), args.in[I_QGAIN], args.in[I_KGAIN], (LAS float*)(lds + MISC_OFF)};
          pg8::gemm_phase<pg8::EpiQKV, pg8::StaticOrder, 8>(lds, g, S, E); }
        { LAS float* rs = (LAS float*)(lds + 8192); meta_rstd(args.in[I_META], rs, wave, lane);
          FNorm A{args.in[I_META], args.in[I_ATTN_NORM], rs, D}; EStoreC<3> E{qkv_m, NQKV};
          meta_gemm_mc<1, 3>(ws + W_QKV8, D, NQKV / 3, 1.0f / SC_W8, A, CMCons<3>{}, E, gw, NGW, lane); }
        SEAM(1);
    }
    if (IN(3)) {
        att::attn_phase(lds, BIG, qkv_m, args.in[I_QGAIN], args.in[I_KGAIN], args.in[I_RELBIAS], args.in[I_METABIAS], XA, o_m, G, bid);
        SEAM(3);
    }
    if (IN(4)) {
        { pg8::Gemm g{XA, ws + W_O8, D}; pg8::StaticOrder S; S.init(M, D, G, bid); pg8::EpiResidNormB<false> E{args.in[I_X], H1B, HB1, rs1, D, (LAS float*)(lds + MISC_OFF), 1.0f / (SC_O8 * SC_W8), SC_A8};
          pg8::gemm_phase<pg8::EpiResidNormB<false>, pg8::StaticOrder, 8>(lds, g, S, E); }
        { FCvt A{o_m, D}; EResidC<1> E{args.in[I_META], h1_m, D}; meta_gemm_mc<1, 1>(ws + W_O8, D, D, 1.0f / SC_W8, A, CMCons<1>{}, E, gw, NGW, lane); }
        SEAM(4);
    }
    if (IN(6)) {
        { pg8::Gemm g{HB1, ws + W_GU8, D}; pg8::StaticOrder S; S.init(M, NGU, G, bid); pg8::EpiSwiGLU E{(unsigned char*)BIG, FF, rs1, 1.0f / (SC_A8 * SC_W8), (LAS float*)(lds + MISC_OFF)};
          pg8::gemm_phase<pg8::EpiSwiGLU, pg8::StaticOrder, 8>(lds, g, S, E); }
        { LAS float* rs = (LAS float*)(lds + 8192); meta_rstd(h1_m, rs, wave, lane);
          FNorm A{h1_m, nullptr, rs, D}; ESiluAct E{act_m}; meta_gemm_mc<1, 8>(ws + W_GU8, D, FF / 4, 1.0f / SC_W8, A, CMGateUp{}, E, gw, NGW, lane); }
        SEAM(6);
    }
    if (IN(7)) {
        { pg8::Gemm g{BIG, ws + W_DN8, FF}; pg8::StaticOrder S; S.init(M, D, G, bid); pg8::EpiResidNormB<true> E{H1B, H2B, (unsigned char*)XA, rs2, D, (LAS float*)(lds + MISC_OFF), 1.0f / (SC_ACTR * SC_WDR), SC_A8B};
          pg8::gemm_phase<pg8::EpiResidNormB<true>, pg8::StaticOrder, 8>(lds, g, S, E); }
        if (wave < 4) { FCvt A{act_m, FF}; EResidC<2> E{h1_m, h2_m, D}; meta_gemm_mc<0, 2>(ws + W_DN, FF, D / 2, 1.0f, A, CMCons<2>{}, E, bid * 4 + wave, G * 4, lane); }
        SEAM(7);
    }
    if (IN(9)) {
        { pg8::Gemm g{XA, ws + W_IN, D}; pg8::StaticOrder S; S.init(M, NQKV, G, bid); pg8::EpiWin E{BIG, 2 * D, rs2, 1.0f / (SC_A8B * SC_W8), (LAS float*)(lds + MISC_OFF)};
          pg8::gemm_phase<pg8::EpiWin, pg8::StaticOrder, 8>(lds, g, S, E); }
        { LAS float* rs = (LAS float*)(lds + 8192); meta_rstd(h2_m, rs, wave, lane);
          FNorm A{h2_m, nullptr, rs, D}; EStoreC<2> E{cgu_m, 2 * D}; meta_gemm_mc<1, 2>(ws + W_IN + (size_t)D * D, D, D, 1.0f / SC_W8, A, CMCons<2>{}, E, gw, NGW, lane); }
        SEAM(9);
    }
    if (IN(10)) {
        const int cc = tid & 255, half = tid >> 8;
        const float* cw = args.in[I_CONVW] + (size_t)cc * 8 * 3;
        float w0[8], w1[8], w2[8];
#pragma unroll
        for (int e = 0; e < 8; ++e) { w0[e] = cw[3 * e]; w1[e] = cw[3 * e + 1]; w2[e] = cw[3 * e + 2]; }
        const int RPW = M / G;
        const int m0 = bid * RPW + half * (RPW / 2), m1 = m0 + RPW / 2;
#define ldz(m_, z_) ld8bf(BIG + (size_t)(m_) * (2 * D) + D + cc * 8, z_)
        float zp[8], zc[8], zn[8];
        if ((m0 % SEQ) == 0) { const float* gp = cgu_m + (size_t)15 * (2 * D) + (cc * 8 / 128) * 256 + (cc * 8 % 128);
#pragma unroll
            for (int e = 0; e < 8; ++e) zp[e] = gp[e] * gp[128 + e]; }
        else ldz(m0 - 1, zp);
        ldz(m0, zc);
        for (int m = m0; m < m1; m += 4) {
            u32x4 zw[4], bw[4];
#pragma unroll
            for (int i = 0; i < 4; ++i) { const int mm = m + 1 + i, mc = mm < M ? mm : M - 1; zw[i] = *(const u32x4*)(BIG + (size_t)mc * (2 * D) + D + cc * 8);
                if ((mm % SEQ) == 0) zw[i] = (u32x4){0u, 0u, 0u, 0u}; }
#pragma unroll
            for (int i = 0; i < 4; ++i) bw[i] = *(const u32x4*)(BIG + (size_t)(m + i) * (2 * D) + cc * 8);
#pragma unroll
            for (int i = 0; i < 4; ++i) {
                zn[0] = bflo(zw[i].x); zn[1] = bfhi(zw[i].x); zn[2] = bflo(zw[i].y); zn[3] = bfhi(zw[i].y); zn[4] = bflo(zw[i].z); zn[5] = bfhi(zw[i].z); zn[6] = bflo(zw[i].w); zn[7] = bfhi(zw[i].w);
                const float bg[8] = {bflo(bw[i].x), bfhi(bw[i].x), bflo(bw[i].y), bfhi(bw[i].y), bflo(bw[i].z), bfhi(bw[i].z), bflo(bw[i].w), bfhi(bw[i].w)};
                float y[8];
#pragma unroll
                for (int e = 0; e < 8; ++e) y[e] = bg[e] * (zp[e] * w0[e] + zc[e] * w1[e] + zn[e] * w2[e]);
                wht_inlane8(y);
#pragma unroll
                for (int e = 0; e < 8; ++e) { const float o = __shfl_xor(y[e], 1); y[e] = (cc & 1) ? o - y[e] : y[e] + o; }
#pragma unroll
                for (int e = 0; e < 8; ++e) { const float o = __shfl_xor(y[e], 2); y[e] = ((cc & 2) ? o - y[e] : y[e] + o) * (SC_YR * 0.17677669529663687f); }
                u32x2 o; o.x = pk4_i8(y[0], y[1], y[2], y[3]); o.y = pk4_i8(y[4], y[5], y[6], y[7]);
                *(u32x2*)((unsigned char*)XA + (size_t)(m + i) * D + cc * 8) = o;
#pragma unroll
                for (int e = 0; e < 8; ++e) { zp[e] = zc[e]; zc[e] = zn[e]; }
            }
        }
#undef ldz
        SEAM(10);
    }
    if (IN(11)) {
        { pg8::Gemm g{XA, ws + W_OUT, D}; pg8::StaticOrder S; S.init(M, D, G, bid); pg8::EpiResidB E{H2B, H3B, D, 1.0f / (SC_YR * SC_W8)};
          pg8::gemm_phase<pg8::EpiResidB, pg8::StaticOrder, 8>(lds, g, S, E); }
        SEAM(11);
    }
    if (IN(12)) {
        LAS float* wr_t = (LAS float*)lds;
        LAS int* lcnt = (LAS int*)(lds + 65536);
        for (int i = tid; i < D * NE; i += NTHREADS) { const int k = i >> 3, e = i & 7; wr_t[e * D + k] = args.in[I_WROUTER][i]; }
        if (tid < 8) lcnt[tid] = 0;
        __syncthreads();
        const int RPW = M / G, RPV = RPW / NWAVES;
        u32x4 vn[4];
        { const bf16_t* xr0 = H3B + (size_t)(bid * RPW + wave * RPV) * D;
#pragma unroll
          for (int j = 0; j < 4; ++j) vn[j] = *(const u32x4*)(xr0 + 8 * (lane + 64 * j)); }
        for (int rr = 0; rr < RPV; ++rr) {
            const int m = bid * RPW + wave * RPV + rr;
            const float* gain = args.in[I_MOE_NORM];
            f32x4 v[4][2]; float s = 0.f;
#pragma unroll
            for (int j = 0; j < 4; ++j) { v[j][0] = (f32x4){bflo(vn[j].x), bfhi(vn[j].x), bflo(vn[j].y), bfhi(vn[j].y)}; v[j][1] = (f32x4){bflo(vn[j].z), bfhi(vn[j].z), bflo(vn[j].w), bfhi(vn[j].w)}; }
            if (rr + 1 < RPV) { const bf16_t* xr1 = H3B + (size_t)(m + 1) * D;
#pragma unroll
                for (int j = 0; j < 4; ++j) vn[j] = *(const u32x4*)(xr1 + 8 * (lane + 64 * j)); }
#pragma unroll
            for (int j = 0; j < 4; ++j)
                s += (v[j][0].x * v[j][0].x + v[j][0].y * v[j][0].y) + (v[j][0].z * v[j][0].z + v[j][0].w * v[j][0].w) + (v[j][1].x * v[j][1].x + v[j][1].y * v[j][1].y) + (v[j][1].z * v[j][1].z + v[j][1].w * v[j][1].w);
            const float rstd = 1.0f / sqrtf(wave_sum(s) * (1.0f / D) + RMS_EPS);
            float lg[8];
#pragma unroll
            for (int e = 0; e < 8; ++e) lg[e] = 0.f;
#pragma unroll
            for (int j = 0; j < 4; ++j) { const f32x4* gp = (const f32x4*)(gain + 8 * (lane + 64 * j)); const f32x4 a = v[j][0] * rstd * gp[0], b = v[j][1] * rstd * gp[1];
                u32x2 w; w.x = pk4_i8(a.x * SC_A8, a.y * SC_A8, a.z * SC_A8, a.w * SC_A8); w.y = pk4_i8(b.x * SC_A8, b.y * SC_A8, b.z * SC_A8, b.w * SC_A8);
                *(u32x2*)(XQ + (size_t)m * D + 8 * (lane + 64 * j)) = w;
#pragma unroll
                for (int e = 0; e < 8; ++e) { const LAS f32x4* wp = (const LAS f32x4*)(wr_t + e * D + 8 * (lane + 64 * j)); const f32x4 w0 = wp[0], w1 = wp[1];
                    lg[e] += (a.x * w0.x + a.y * w0.y) + (a.z * w0.z + a.w * w0.w) + (b.x * w1.x + b.y * w1.y) + (b.z * w1.z + b.w * w1.w); } }
#pragma unroll
            for (int e = 0; e < 8; ++e) lg[e] = wave_sum(lg[e]);
            int e0 = 0; float l0 = lg[0];
#pragma unroll
            for (int e = 1; e < 8; ++e) if (lg[e] > l0) { l0 = lg[e]; e0 = e; }
            int e1 = -1; float l1 = -3.0e38f;
#pragma unroll
            for (int e = 0; e < 8; ++e) if (e != e0 && lg[e] > l1) { l1 = lg[e]; e1 = e; }
            const float g0 = 1.0f / (1.0f + __expf(l1 - l0)), g1 = 1.0f - g0;
            if (lane == 0) { tok_e[2 * m] = e0; tok_e[2 * m + 1] = e1; tok_g[2 * m] = g0; tok_g[2 * m + 1] = g1; lds_add(&lcnt[e0], 1); lds_add(&lcnt[e1], 1); }
        }
        __syncthreads();
        if (tid < 8) cnt[bid * 8 + tid] = lcnt[tid];
        SEAM(12);
    }
    if (IN(13)) {
        LAS int* tot = (LAS int*)lds; LAS int* pre = tot + 8; LAS int* start = tot + 16; LAS int* wcnt = tot + 32;
        if (tid < 16) tot[tid] = 0;
        __syncthreads();
        if (tid < 256) { const i32x4 a = *(const i32x4*)(cnt + tid * 8), c = *(const i32x4*)(cnt + tid * 8 + 4);
            const int v[8] = {a.x, a.y, a.z, a.w, c.x, c.y, c.z, c.w};
#pragma unroll
            for (int e = 0; e < 8; ++e) { lds_add(&tot[e], v[e]); if (tid < bid) lds_add(&pre[e], v[e]); } }
        __syncthreads();
        if (tid == 0) { int s = 0; for (int e = 0; e < 8; ++e) { start[e] = s; s += (tot[e] + 255) / 256 * 256; } start[8] = s; }
        __syncthreads();
        const int RPW = M / G;
        int my_e = 0, my_tok = 0, my_k = 0; float my_g = 0.f;
        if (tid < 2 * RPW) { my_tok = bid * RPW + (tid >> 1); my_k = tid & 1; my_e = tok_e[2 * my_tok + my_k]; my_g = tok_g[2 * my_tok + my_k]; }
        int rank_in_wave = 0;
        if (tid < 2 * RPW) {
#pragma unroll
            for (int e = 0; e < 8; ++e) { const unsigned long long mk = __ballot(my_e == e); if (my_e == e) rank_in_wave = __popcll(mk & ((1ull << lane) - 1ull)); if (lane == 0) wcnt[wave * 8 + e] = __popcll(mk); }
        }
        __syncthreads();
        if (tid < 2 * RPW) { int r = start[my_e] + pre[my_e] + rank_in_wave; for (int w = 0; w < wave; ++w) r += wcnt[w * 8 + my_e];
            rowinfo[r] = my_tok | (my_k << 16); rowgate[r] = my_g; }
        if (bid == 0) {
            for (int e = 0; e < 8; ++e) { const int a = start[e] + tot[e], z = start[e + 1]; for (int r = a + tid; r < z; r += NTHREADS) { rowinfo[r] = -1; rowgate[r] = 0.f; } }
            const int nt = start[8] / 256;
            for (int t = tid; t < nt; t += NTHREADS) { int e = 0; while (e < 7 && t * 256 >= start[e + 1]) ++e; tile_e[t] = e; }
            if (tid == 0) ctl[CW_NTILES] = (unsigned)nt;
        }
        __syncthreads();
        SEAM(13);
    }
    if (IN(14)) {
        const int ntl = (int)__builtin_amdgcn_readfirstlane(ld_agent(ctl + CW_NTILES));
        LAS int* te = (LAS int*)(lds + MISC_OFF + 16384);
        for (int i = tid; i < ntl; i += NTHREADS) te[i] = tile_e[i];
        __syncthreads();
        if (ntl > 0) { pg8::Gemm g{XQ, ws + W_MGU, D}; pg8::MoeGatherOrder S{ntl, NGU / 256, G, bid, 0, te, false, rowinfo, lds + MISC_OFF}; pg8::EpiSwiGLU8 E{ACT8, FF};
            pg8::gemm_phase<pg8::EpiSwiGLU8, pg8::MoeGatherOrder, 8>(lds, g, S, E); }
        SEAM(14);
    }
    if (IN(15)) {
        const int ntl = (int)__builtin_amdgcn_readfirstlane(ld_agent(ctl + CW_NTILES));
        LAS int* te = (LAS int*)(lds + MISC_OFF + 16384);
        for (int i = tid; i < ntl; i += NTHREADS) te[i] = tile_e[i];
        __syncthreads();
        if (ntl > 0) { pg8::Gemm g{ACT8, ws + W_MDN, FF}; pg8::MoeOrder S{ntl, D / 256, G, bid, 0, te, true, nullptr, nullptr}; pg8::EpiMoeDown E{Y0, Y1, rowinfo, rowgate, 1.0f / (SC_ACT * SC_WDN)};
            pg8::gemm_phase<pg8::EpiMoeDown, pg8::MoeOrder, 0>(lds, g, S, E); }
        SEAM(15);
    }
    if (IN(16)) {
        const size_t n8 = (size_t)M * D / 8;
        for (size_t i = (size_t)bid * NTHREADS + tid; i < n8; i += (size_t)G * NTHREADS) {
            const u32x4 h = *(const u32x4*)(H3B + i * 8), w0 = *(const u32x4*)(Y0 + i * 8), w1 = *(const u32x4*)(Y1 + i * 8); f32x4* o = (f32x4*)(out + i * 8);
            f32x4 a, b;
            a.x = bflo(h.x) + (bflo(w0.x) + bflo(w1.x)); a.y = bfhi(h.x) + (bfhi(w0.x) + bfhi(w1.x)); a.z = bflo(h.y) + (bflo(w0.y) + bflo(w1.y)); a.w = bfhi(h.y) + (bfhi(w0.y) + bfhi(w1.y));
            b.x = bflo(h.z) + (bflo(w0.z) + bflo(w1.z)); b.y = bfhi(h.z) + (bfhi(w0.z) + bfhi(w1.z)); b.z = bflo(h.w) + (bflo(w0.w) + bflo(w1.w)); b.w = bfhi(h.w) + (bfhi(w0.w) + bfhi(w1.w));
            o[0] = a; o[1] = b;
        }
    }
#undef IN
#undef SEAM
}

extern "C" void kernel_launch(void* const* d_in, const int* in_sizes, int n_in, void* d_out, int out_size, void* d_ws, size_t ws_size, hipStream_t stream) {
    static int grid = 0;
    if (grid == 0) {
        if (n_in != 22 || in_sizes[0] != M * D || out_size != M * D || ws_size < WS_END) {
            fprintf(stderr, "kernel_launch: unexpected shapes (n_in %d, in0 %d, out %d, ws %zu < %zu); nothing launched\n", n_in, n_in > 0 ? in_sizes[0] : -1, out_size, ws_size, (size_t)WS_END); grid = -1; return; }
        int dev = 0, cus = 0, per_cu = 0;
        if (hipGetDevice(&dev) != hipSuccess || hipDeviceGetAttribute(&cus, hipDeviceAttributeMultiprocessorCount, dev) != hipSuccess) { grid = -1; return; }
        if (hipFuncSetAttribute((const void*)enc_fwd, hipFuncAttributeMaxDynamicSharedMemorySize, LDS_BYTES) != hipSuccess) { fprintf(stderr, "kernel_launch: hipFuncSetAttribute failed\n"); grid = -1; return; }
        if (hipOccupancyMaxActiveBlocksPerMultiprocessor(&per_cu, (const void*)enc_fwd, NTHREADS, LDS_BYTES) != hipSuccess || per_cu < 1)
            fprintf(stderr, "kernel_launch: note: occupancy query reports %d workgroups per CU\n", per_cu);
        (void)hipGetLastError();
        grid = cus;
        if (grid != 256) { fprintf(stderr, "kernel_launch: built for 256 CUs, device has %d; nothing launched\n", cus); grid = -1; return; }
    }
    if (grid < 0) return;
    if (hipMemsetAsync((char*)d_ws + WS_CTL, 0, CTL_ZERO_BYTES, stream) != hipSuccess) return;
    Args a{};
    for (int i = 0; i < 22; ++i) a.in[i] = (const float*)d_in[i];
    a.out = (float*)d_out; a.ws = (unsigned char*)d_ws;
#if MK_N_LAUNCHES == 1
    a.ph_lo = 0; a.ph_hi = NPHASES;
    hipLaunchKernelGGL(enc_fwd, dim3(grid), dim3(NTHREADS), LDS_BYTES, stream, a);
#else
    for (int p = 0; p < NPHASES; ++p) { a.ph_lo = p; a.ph_hi = p + 1; hipLaunchKernelGGL(enc_fwd, dim3(grid), dim3(NTHREADS), LDS_BYTES, stream, a);
    }
#endif
}
```

```cpp
#include <hip/hip_runtime.h>
#include <cstdio>
#include <cstdint>

#ifndef MK_N_LAUNCHES
#define MK_N_LAUNCHES 1
#endif

#define LAS __attribute__((address_space(3)))
#define GAS __attribute__((address_space(1)))
typedef unsigned short bf16_t;
typedef short bf16x8 __attribute__((ext_vector_type(8)));
typedef short bf16x4 __attribute__((ext_vector_type(4)));
typedef float f32x4 __attribute__((ext_vector_type(4)));
typedef float f32x2 __attribute__((ext_vector_type(2)));
typedef unsigned u32x4 __attribute__((ext_vector_type(4)));
typedef unsigned u32x2 __attribute__((ext_vector_type(2)));
typedef int i32x4 __attribute__((ext_vector_type(4)));
typedef int i32x8 __attribute__((ext_vector_type(8)));

constexpr int D = 2048, NB = 2, SEQ = 16384, M = NB * SEQ, NMETA = 16, NH = 16, HD = 128, GW = 64, GR = 256;
constexpr int FF = 7168, NE = 8, NQKV = 3 * D, NGU = 2 * FF;
constexpr float RMS_EPS = 1e-6f;
constexpr float LOG2E = 1.4426950408889634f;
constexpr int NWAVES = 8, NTHREADS = 512;
constexpr int MAXTILES = 264;

constexpr size_t MiB = 1u << 20;
constexpr size_t WS_CTL = 0, CTL_ZERO_BYTES = 64 * 1024;
constexpr size_t WS_META = 1 * MiB;
constexpr size_t MT_QKV = WS_META, MT_O = MT_QKV + 16 * NQKV * 4, MT_H1 = MT_O + 16 * D * 4, MT_GU = MT_H1 + 16 * D * 4, MT_H2 = MT_GU + 16 * NGU * 4,
                 MT_CGU = MT_H2 + 16 * D * 4, MT_END = MT_CGU + 16 * 2 * D * 4;
static_assert(MT_END <= 3 * MiB, "meta scratch");
constexpr size_t WS_RS1 = 5 * MiB + 512 * 1024, WS_RS2 = WS_RS1 + (size_t)M * 8 * 4;
constexpr size_t WS_MOE = 4 * MiB;
constexpr size_t MO_TOKE = WS_MOE, MO_TOKG = MO_TOKE + (size_t)M * 8, MO_CNT = MO_TOKG + (size_t)M * 8, MO_ROWINFO = MO_CNT + 256 * 8 * 4,
                 MO_ROWGATE = MO_ROWINFO + (size_t)MAXTILES * 256 * 4, MO_TILEE = MO_ROWGATE + (size_t)MAXTILES * 256 * 4, MO_END = MO_TILEE + 2048;
static_assert(MO_END <= 5 * MiB + 512 * 1024, "moe tables");
constexpr size_t WS_WB = 8 * MiB;
constexpr size_t W_QKV = WS_WB, W_O = W_QKV + (size_t)NQKV * D * 2, W_GU = W_O + (size_t)D * D * 2, W_DN = W_GU + (size_t)NGU * D * 2,
                 W_IN = W_DN + (size_t)D * FF * 2, W_OUT = W_IN + (size_t)NQKV * D * 2, W_MGU = W_OUT + (size_t)D * D * 2, W_MDN = W_MGU + (size_t)NE * NGU * D,
                 W_END = W_MDN + (size_t)NE * D * FF;
static_assert(W_END == (8 + 148 + 336) * MiB, "weights");
constexpr size_t WS_XA = W_END;
constexpr size_t WS_BIG = WS_XA + (size_t)M * D * 2;
constexpr size_t WS_XBUF = WS_BIG + (size_t)MAXTILES * 256 * FF;
constexpr size_t W_QKV8 = WS_XBUF + (size_t)MAXTILES * 256 * D;
constexpr size_t W_O8 = W_QKV8 + (size_t)NQKV * D;
constexpr size_t W_GU8 = W_O8 + (size_t)D * D;
constexpr size_t WS_H1B = W_GU8 + (size_t)NGU * D;
constexpr size_t WS_H2B = WS_H1B + (size_t)M * D * 2;
constexpr size_t W_DN8 = WS_H2B + (size_t)M * D * 2;
constexpr size_t WS_END = W_DN8 + (size_t)D * FF;
static_assert((size_t)MAXTILES * 256 * FF >= (size_t)M * FF * 2, "BIG holds the dense act too");
constexpr size_t WS_XQ = WS_XA + (size_t)M * D;
constexpr size_t WS_Y1 = WS_XA;

constexpr int CW_TMO = 0, CW_NTILES = 64, CW_BAR = 4096;

constexpr int RING_BYTES = 131072;
constexpr int MISC_OFF = RING_BYTES;
constexpr int LDS_BYTES = 163840 - 1024;
constexpr int XBW_OFF = LDS_BYTES - 64;

#define RLX_AGENT __ATOMIC_RELAXED, __HIP_MEMORY_SCOPE_AGENT
#define LDS_WAIT() asm volatile("s_waitcnt lgkmcnt(0)" ::: "memory")
#define VM_WAIT() asm volatile("s_waitcnt vmcnt(0)" ::: "memory")
typedef __bf16 bf16v2 __attribute__((ext_vector_type(2)));
__device__ __forceinline__ unsigned cvt_pk_bf16(float lo, float hi) { const f32x2 v = (f32x2){lo, hi}; return __builtin_bit_cast(unsigned, __builtin_convertvector(v, bf16v2)); }
__device__ __forceinline__ float bf2f(unsigned short b) { return __builtin_bit_cast(float, (unsigned)b << 16); }
__device__ __forceinline__ float bflo(unsigned w) { return __builtin_bit_cast(float, w << 16); }
__device__ __forceinline__ float bfhi(unsigned w) { return __builtin_bit_cast(float, w & 0xffff0000u); }
__device__ __forceinline__ float wave_sum(float v) {
#pragma unroll
    for (int o = 1; o < 64; o <<= 1) v += __shfl_xor(v, o);
    return v;
}
__device__ __forceinline__ float wave_max(float v) {
#pragma unroll
    for (int o = 1; o < 64; o <<= 1) v = fmaxf(v, __shfl_xor(v, o));
    return v;
}
__device__ __forceinline__ void ld8bf(const bf16_t* p, float (&z)[8]) { const u32x4 w = *(const u32x4*)p;
    z[0] = bflo(w.x); z[1] = bfhi(w.x); z[2] = bflo(w.y); z[3] = bfhi(w.y); z[4] = bflo(w.z); z[5] = bfhi(w.z); z[6] = bflo(w.w); z[7] = bfhi(w.w); }
__device__ __forceinline__ void lds_add(LAS int* p, int v) { __hip_atomic_fetch_add((int*)p, v, __ATOMIC_RELAXED, __HIP_MEMORY_SCOPE_WORKGROUP); }
__device__ __forceinline__ unsigned ld_agent(const unsigned* p) { return __hip_atomic_load(p, RLX_AGENT); }
__device__ __forceinline__ float ld_agent_f(const float* p) { return __builtin_bit_cast(float, __hip_atomic_load((const unsigned*)p, RLX_AGENT)); }
__device__ __forceinline__ int ld_agent_i(const int* p) { return (int)__hip_atomic_load((const unsigned*)p, RLX_AGENT); }


constexpr float SC_ACT = 8.f, SC_WDN = 64.f;
__device__ __forceinline__ float sat8(float v) { return __builtin_amdgcn_fmed3f(v, -448.f, 448.f); }
__device__ __forceinline__ unsigned pk4_fp8(float a, float b, float c, float d) { int w = 0; w = __builtin_amdgcn_cvt_pk_fp8_f32(sat8(a), sat8(b), w, false); w = __builtin_amdgcn_cvt_pk_fp8_f32(sat8(c), sat8(d), w, true); return (unsigned)w; }

constexpr float SC_A8B = 24.f;
constexpr float SC_A8 = 28.f, SC_W8 = 1536.f;
constexpr float SC_O8 = 160.f;
constexpr float SC_YR = 20.f;
constexpr float SC_ACTR = 32.f, SC_WDR = 2880.f;
__device__ __forceinline__ void wht_inlane8(float (&v)[8]) {
#pragma unroll
    for (int h = 1; h < 8; h <<= 1)
#pragma unroll
        for (int i = 0; i < 8; ++i) if ((i & h) == 0) { const float a = v[i], b = v[i + h]; v[i] = a + b; v[i + h] = a - b; }
}
__device__ __forceinline__ unsigned q8m(float v) { const float MG = 12582912.f; return __builtin_bit_cast(unsigned, __builtin_amdgcn_fmed3f(v + MG, MG - 127.f, MG + 127.f)); }
__device__ __forceinline__ unsigned pk4_i8(float a, float b, float c, float d) {
    const unsigned lo = __builtin_amdgcn_perm(q8m(b), q8m(a), 0x0c0c0400u), hi = __builtin_amdgcn_perm(q8m(d), q8m(c), 0x0c0c0400u);
    return __builtin_amdgcn_perm(hi, lo, 0x05040100u); }

namespace pg8 {
constexpr int BM = 256, BK = 64, HALF = 128, HTB = HALF * BK * 2, STAGE_BYTES = 8 * HTB, NXCD = 8;
__host__ __device__ __forceinline__ int lds_byte(int r, int c) { const int st = (r >> 4) * 2 + (c >> 5), rr = r & 15, cc = c & 31, ob = rr * 64 + cc * 2; return st * 1024 + (ob ^ (((ob >> 9) & 1) << 5)); }
__host__ __device__ __forceinline__ void stage_rc(int b, int& R, int& C) { const int st = b / 1024, sb = b % 1024, swz = sb ^ (((sb >> 9) & 1) << 5); R = (st >> 1) * 16 + swz / 64; C = (st & 1) * 32 + (swz % 64) / 2; }
__host__ __device__ __forceinline__ int perm32(int rho) { const int n = rho >> 4, i = rho & 15; return 8 * (i >> 2) + 4 * n + (i & 3); }

struct Unit { int pm, pn, pb, po, ui; };
struct Gemm { const void* A; const void* Bt; int KB; };

__device__ __forceinline__ bool tile_of(int i, int G, int c, int nM, int nN, int& pm, int& pn) {
    const int WGM = nN <= 24 ? 4 : 8;
    const int nwg = nM * nN; const long L = (long)i * G + c; if (L >= nwg) return false;
    int wgid = (int)L; { const int q = nwg / NXCD, r = nwg % NXCD, xcd = wgid % NXCD, off = wgid / NXCD; wgid = (xcd < r ? xcd * (q + 1) : r * (q + 1) + (xcd - r) * q) + off; }
    const int nig = WGM * nN, gid = wgid / nig, fm = gid * WGM, gsz = (nM - fm) < WGM ? (nM - fm) : WGM;
    pm = fm + ((wgid % nig) % gsz); pn = (wgid % nig) / gsz; return true;
}
struct StaticOrder {
    static constexpr bool GATHER = false;
    int nM, nN, G, c;
    __device__ __forceinline__ void init(int M_, int N_, int G_, int c_) { nM = M_ / BM; nN = N_ / BM; G = G_; c = c_; }
    __device__ __forceinline__ bool next(int i, Unit& u) const { int pm, pn; if (!tile_of(i, G, c, nM, nN, pm, pn)) return false; u.pm = pm; u.pn = pn; u.pb = pn; u.po = pm; return true; }
};
__device__ __forceinline__ int lds_ld_i32(unsigned addr) { int r; asm volatile("ds_read_b32 %0, %1\n\ts_waitcnt lgkmcnt(0)" : "=v"(r) : "v"(addr) : "memory"); return r; }
template <bool GA> struct MoeOrderT {
    static constexpr bool GATHER = GA;
    int nM, nN, G, c, t0; LAS const int* tile_e; bool a_local; const int* rowinfo; LAS unsigned char* gl;
    __device__ __forceinline__ bool next(int i, Unit& u) const {
        int pm, pn; if (!tile_of(i, G, c, nM, nN, pm, pn)) return false;
        const int e = __builtin_amdgcn_readfirstlane(lds_ld_i32((unsigned)(size_t)(tile_e + t0 + pm)));
        u.pn = pn; u.pb = e * nN + pn; u.pm = a_local ? pm : t0 + pm; u.po = a_local ? t0 + pm : pm; return true; }
    __device__ __forceinline__ bool row_tile(int i, int& tile) const { int pm, pn; if (!tile_of(i, G, c, nM, nN, pm, pn)) return false; tile = t0 + pm; return true; }
};
typedef MoeOrderT<false> MoeOrder;
typedef MoeOrderT<true> MoeGatherOrder;

struct EpiStoreBf16 {
    static constexpr bool PERM = true, RS_LDS = false;
    bf16_t* O; int ldc; float sc;
    __device__ __forceinline__ void operator()(const f32x4 (&acc)[2][2][4][2], const Unit& u, int wr, int wc, int fr, int fq) const {
        const int row0 = u.po * BM + wr * 64 + fr, col0 = u.pn * BM + wc * 32 + 8 * fq;
#pragma unroll
        for (int ai = 0; ai < 2; ++ai)
#pragma unroll
            for (int m = 0; m < 4; ++m) { bf16_t* rowp = O + (size_t)(row0 + ai * HALF + m * 16) * ldc + col0;
#pragma unroll
                for (int bj = 0; bj < 2; ++bj) { const f32x4 v0 = acc[ai][bj][m][0] * sc, v1 = acc[ai][bj][m][1] * sc;
                    u32x4 w; w.x = cvt_pk_bf16(v0[0], v0[1]); w.y = cvt_pk_bf16(v0[2], v0[3]); w.z = cvt_pk_bf16(v1[0], v1[1]); w.w = cvt_pk_bf16(v1[2], v1[3]);
                    *(u32x4*)(rowp + bj * HALF) = w; } }
    }
};
struct EpiQKV {
    static constexpr bool PERM = true, RS_LDS = false;
    bf16_t* O; int ldc; float sc; const float* q_gain; const float* k_gain; LAS float* P;
    __device__ __forceinline__ void operator()(const f32x4 (&acc)[2][2][4][2], const Unit& u, int wr, int wc, int fr, int fq) const {
        const int rl0 = wr * 64 + fr, row0 = u.po * BM + rl0, col0 = u.pn * BM + wc * 32 + 8 * fq;
        if (u.pn >= 16) {
#pragma unroll
            for (int ai = 0; ai < 2; ++ai)
#pragma unroll
                for (int m = 0; m < 4; ++m) { bf16_t* rowp = O + (size_t)(row0 + ai * HALF + m * 16) * ldc + col0;
#pragma unroll
                    for (int bj = 0; bj < 2; ++bj) { const f32x4 v0 = acc[ai][bj][m][0] * sc, v1 = acc[ai][bj][m][1] * sc;
                        u32x4 w; w.x = cvt_pk_bf16(v0[0], v0[1]); w.y = cvt_pk_bf16(v0[2], v0[3]); w.z = cvt_pk_bf16(v1[0], v1[1]); w.w = cvt_pk_bf16(v1[2], v1[3]);
                        *(u32x4*)(rowp + bj * HALF) = w; } }
            return;
        }
#pragma unroll
        for (int ai = 0; ai < 2; ++ai)
#pragma unroll
            for (int m = 0; m < 4; ++m)
#pragma unroll
                for (int bj = 0; bj < 2; ++bj) { const f32x4 a = acc[ai][bj][m][0], b = acc[ai][bj][m][1];
                    float ss = (a.x * a.x + a.y * a.y) + (a.z * a.z + a.w * a.w) + (b.x * b.x + b.y * b.y) + (b.z * b.z + b.w * b.w);
                    ss += __shfl_xor(ss, 16); ss += __shfl_xor(ss, 32);
                    if (fq == 0) P[((rl0 + ai * HALF + m * 16) * 2 + bj) * 4 + wc] = ss; }
        asm volatile("s_waitcnt lgkmcnt(0)" ::: "memory"); __builtin_amdgcn_s_barrier(); asm volatile("" ::: "memory");
        const bool isq = u.pn < 8; const float* gn = (isq ? q_gain : k_gain) + wc * 32 + 8 * fq; const float gs = isq ? 0.08838834764831845f * LOG2E : 1.0f;
        const f32x4 g0 = *(const f32x4*)gn * gs, g1 = *(const f32x4*)(gn + 4) * gs;
#pragma unroll
        for (int ai = 0; ai < 2; ++ai)
#pragma unroll
            for (int m = 0; m < 4; ++m) { bf16_t* rowp = O + (size_t)(row0 + ai * HALF + m * 16) * ldc + col0;
#pragma unroll
                for (int bj = 0; bj < 2; ++bj) { const f32x4 q = *(const LAS f32x4*)(P + ((rl0 + ai * HALF + m * 16) * 2 + bj) * 4);
                    const float r = __builtin_amdgcn_rsqf(((q.x + q.y) + (q.z + q.w)) * (sc * sc) * (1.0f / HD) + RMS_EPS) * sc;
                    const f32x4 v0 = acc[ai][bj][m][0] * g0 * r, v1 = acc[ai][bj][m][1] * g1 * r;
                    u32x4 w; w.x = cvt_pk_bf16(v0[0], v0[1]); w.y = cvt_pk_bf16(v0[2], v0[3]); w.z = cvt_pk_bf16(v1[0], v1[1]); w.w = cvt_pk_bf16(v1[2], v1[3]);
                    *(u32x4*)(rowp + bj * HALF) = w; } }
    }
};
template <bool BASE_BF16> struct EpiResidNormB {
    static constexpr bool PERM = true, RS_LDS = false;
    const void* base; bf16_t* ob; unsigned char* hb; float* rsp; int ldc; LAS float* P; float sc; float hsc;
    __device__ __forceinline__ void operator()(const f32x4 (&acc)[2][2][4][2], const Unit& u, int wr, int wc, int fr, int fq) const {
        const int rl0 = wr * 64 + fr, row0 = u.po * BM + rl0, col0 = u.pn * BM + wc * 32 + 8 * fq;
#pragma unroll
        for (int ai = 0; ai < 2; ++ai)
#pragma unroll
            for (int m = 0; m < 4; ++m) { const int row = row0 + ai * HALF + m * 16; const size_t off = (size_t)row * ldc + col0; float ss = 0.f;
#pragma unroll
                for (int bj = 0; bj < 2; ++bj) { f32x4 b0, b1;
                    if constexpr (BASE_BF16) { const u32x4 w = *(const u32x4*)((const bf16_t*)base + off + bj * HALF);
                        b0 = (f32x4){bflo(w.x), bfhi(w.x), bflo(w.y), bfhi(w.y)}; b1 = (f32x4){bflo(w.z), bfhi(w.z), bflo(w.w), bfhi(w.w)}; }
                    else { const f32x4* bp = (const f32x4*)((const float*)base + off + bj * HALF); b0 = bp[0]; b1 = bp[1]; }
                    const f32x4 v0 = b0 + acc[ai][bj][m][0] * sc, v1 = b1 + acc[ai][bj][m][1] * sc;
                    u32x4 w; w.x = cvt_pk_bf16(v0[0], v0[1]); w.y = cvt_pk_bf16(v0[2], v0[3]); w.z = cvt_pk_bf16(v1[0], v1[1]); w.w = cvt_pk_bf16(v1[2], v1[3]);
                    *(u32x4*)(ob + off + bj * HALF) = w;
                    u32x2 q; q.x = pk4_i8(v0[0] * hsc, v0[1] * hsc, v0[2] * hsc, v0[3] * hsc); q.y = pk4_i8(v1[0] * hsc, v1[1] * hsc, v1[2] * hsc, v1[3] * hsc);
                    *(u32x2*)(hb + off + bj * HALF) = q;
                    ss += ((v0.x * v0.x + v0.y * v0.y) + (v0.z * v0.z + v0.w * v0.w)) + ((v1.x * v1.x + v1.y * v1.y) + (v1.z * v1.z + v1.w * v1.w)); }
                ss += __shfl_xor(ss, 16); ss += __shfl_xor(ss, 32);
                if (fq == 0) P[(rl0 + ai * HALF + m * 16) * 4 + wc] = ss; }
        asm volatile("s_waitcnt lgkmcnt(0)" ::: "memory"); __builtin_amdgcn_s_barrier(); asm volatile("" ::: "memory");
        const int t = threadIdx.x;
        if (t < BM) { const LAS f32x4* pp = (const LAS f32x4*)(P + t * 4); const f32x4 q = *pp; rsp[(size_t)(u.po * BM + t) * 8 + u.pn] = (q.x + q.y) + (q.z + q.w); }
    }
};
struct EpiResidB {
    static constexpr bool PERM = true, RS_LDS = false;
    const bf16_t* base; bf16_t* ob; int ldc; float sc;
    __device__ __forceinline__ void operator()(const f32x4 (&acc)[2][2][4][2], const Unit& u, int wr, int wc, int fr, int fq) const {
        const int row0 = u.po * BM + wr * 64 + fr, col0 = u.pn * BM + wc * 32 + 8 * fq;
#pragma unroll
        for (int ai = 0; ai < 2; ++ai)
#pragma unroll
            for (int m = 0; m < 4; ++m) { const size_t off = (size_t)(row0 + ai * HALF + m * 16) * ldc + col0;
#pragma unroll
                for (int bj = 0; bj < 2; ++bj) { const u32x4 b = *(const u32x4*)(base + off + bj * HALF);
                    const f32x4 v0 = (f32x4){bflo(b.x), bfhi(b.x), bflo(b.y), bfhi(b.y)} + acc[ai][bj][m][0] * sc, v1 = (f32x4){bflo(b.z), bfhi(b.z), bflo(b.w), bfhi(b.w)} + acc[ai][bj][m][1] * sc;
                    u32x4 w; w.x = cvt_pk_bf16(v0[0], v0[1]); w.y = cvt_pk_bf16(v0[2], v0[3]); w.z = cvt_pk_bf16(v1[0], v1[1]); w.w = cvt_pk_bf16(v1[2], v1[3]);
                    *(u32x4*)(ob + off + bj * HALF) = w; } }
    }
};
__device__ __forceinline__ void rs_prefetch(const float* rs, LAS float* PR, const Unit& u, int wid, int tid) {
    __builtin_amdgcn_global_load_lds((const unsigned*)(rs + (size_t)(u.po * BM) * 8 + tid * 4), (LAS unsigned*)((LAS unsigned char*)PR + (u.ui & 1) * 8192 + wid * 1024), 16, 0, 0); }
__device__ __forceinline__ float row_rstd8(const LAS float* PR, const Unit& u, int rl) { const LAS f32x4* p = (const LAS f32x4*)(PR + (u.ui & 1) * 2048 + rl * 8); const f32x4 a = p[0], b = p[1];
    return __builtin_amdgcn_rsqf((((a.x + a.y) + (a.z + a.w)) + ((b.x + b.y) + (b.z + b.w))) * (1.0f / D) + RMS_EPS); }
__device__ __forceinline__ float silu_mul(float g, float u) { return g * u * __builtin_amdgcn_rcpf(1.0f + __builtin_amdgcn_exp2f(-g * LOG2E)); }
struct EpiSwiGLU {
    static constexpr bool PERM = true, RS_LDS = true;
    unsigned char* O; int ldc; const float* rs; float sc; LAS float* PR;
    __device__ __forceinline__ void prefetch(const Unit& u, int wid, int tid) const { rs_prefetch(rs, PR, u, wid, tid); }
    __device__ __forceinline__ void operator()(const f32x4 (&acc)[2][2][4][2], const Unit& u, int wr, int wc, int fr, int fq) const {
        const int row0 = u.po * BM + wr * 64 + fr, col0 = u.pn * HALF + wc * 32 + 8 * fq; const float qs = SC_ACTR * 0.35355339059327373f;
#pragma unroll
        for (int ai = 0; ai < 2; ++ai)
#pragma unroll
            for (int m = 0; m < 4; ++m) { const int row = row0 + ai * HALF + m * 16; unsigned char* rowp = O + (size_t)row * ldc + col0;
                const float r = row_rstd8(PR, u, wr * 64 + fr + ai * HALF + m * 16) * sc;
                const f32x4 g0 = acc[ai][0][m][0] * r, g1 = acc[ai][0][m][1] * r, u0 = acc[ai][1][m][0] * r, u1 = acc[ai][1][m][1] * r;
                float a[8] = {silu_mul(g0[0], u0[0]), silu_mul(g0[1], u0[1]), silu_mul(g0[2], u0[2]), silu_mul(g0[3], u0[3]), silu_mul(g1[0], u1[0]), silu_mul(g1[1], u1[1]), silu_mul(g1[2], u1[2]), silu_mul(g1[3], u1[3])};
                wht_inlane8(a);
                u32x2 w; w.x = pk4_i8(a[0] * qs, a[1] * qs, a[2] * qs, a[3] * qs); w.y = pk4_i8(a[4] * qs, a[5] * qs, a[6] * qs, a[7] * qs);
                *(u32x2*)rowp = w; }
    }
};
struct EpiWin {
    static constexpr bool PERM = true, RS_LDS = true;
    bf16_t* O; int ldc; const float* rs; float sc; LAS float* PR;
    __device__ __forceinline__ void prefetch(const Unit& u, int wid, int tid) const { rs_prefetch(rs, PR, u, wid, tid); }
    __device__ __forceinline__ void operator()(const f32x4 (&acc)[2][2][4][2], const Unit& u, int wr, int wc, int fr, int fq) const {
        const int row0 = u.po * BM + wr * 64 + fr;
        float rr[2][4];
#pragma unroll
        for (int ai = 0; ai < 2; ++ai)
#pragma unroll
            for (int m = 0; m < 4; ++m) rr[ai][m] = row_rstd8(PR, u, wr * 64 + fr + ai * HALF + m * 16) * sc;
        if (u.pn < 8) {
            const int col0 = u.pn * BM + wc * 32 + 8 * fq;
#pragma unroll
            for (int ai = 0; ai < 2; ++ai)
#pragma unroll
                for (int m = 0; m < 4; ++m) { bf16_t* rowp = O + (size_t)(row0 + ai * HALF + m * 16) * ldc + col0;
#pragma unroll
                    for (int bj = 0; bj < 2; ++bj) { const f32x4 v0 = acc[ai][bj][m][0] * rr[ai][m], v1 = acc[ai][bj][m][1] * rr[ai][m];
                        u32x4 w; w.x = cvt_pk_bf16(v0[0], v0[1]); w.y = cvt_pk_bf16(v0[2], v0[3]); w.z = cvt_pk_bf16(v1[0], v1[1]); w.w = cvt_pk_bf16(v1[2], v1[3]);
                        *(u32x4*)(rowp + bj * HALF) = w; } }
        } else {
            const int col0 = D + (u.pn - 8) * HALF + wc * 32 + 8 * fq;
#pragma unroll
            for (int ai = 0; ai < 2; ++ai)
#pragma unroll
                for (int m = 0; m < 4; ++m) { bf16_t* rowp = O + (size_t)(row0 + ai * HALF + m * 16) * ldc + col0;
                    const float r2 = rr[ai][m] * rr[ai][m]; const f32x4 a0 = acc[ai][0][m][0] * acc[ai][1][m][0] * r2, a1 = acc[ai][0][m][1] * acc[ai][1][m][1] * r2;
                    u32x4 w; w.x = cvt_pk_bf16(a0[0], a0[1]); w.y = cvt_pk_bf16(a0[2], a0[3]); w.z = cvt_pk_bf16(a1[0], a1[1]); w.w = cvt_pk_bf16(a1[2], a1[3]);
                    *(u32x4*)rowp = w; }
        }
    }
};
struct EpiSwiGLU8 {
    static constexpr bool PERM = true, RS_LDS = false;
    unsigned char* O; int ldc;
    __device__ __forceinline__ void operator()(const f32x4 (&acc)[2][2][4][2], const Unit& u, int wr, int wc, int fr, int fq) const {
        const int row0 = u.po * BM + wr * 64 + fr, col0 = u.pn * HALF + wc * 32 + 8 * fq; const float si = 1.0f / (SC_A8 * SC_W8);
#pragma unroll
        for (int ai = 0; ai < 2; ++ai)
#pragma unroll
            for (int m = 0; m < 4; ++m) { unsigned char* rowp = O + (size_t)(row0 + ai * HALF + m * 16) * ldc + col0;
                const f32x4 g0 = acc[ai][0][m][0] * si, g1 = acc[ai][0][m][1] * si, u0 = acc[ai][1][m][0] * (si * SC_ACT), u1 = acc[ai][1][m][1] * (si * SC_ACT);
                u32x2 w; w.x = pk4_fp8(silu_mul(g0[0], u0[0]), silu_mul(g0[1], u0[1]), silu_mul(g0[2], u0[2]), silu_mul(g0[3], u0[3]));
                w.y = pk4_fp8(silu_mul(g1[0], u1[0]), silu_mul(g1[1], u1[1]), silu_mul(g1[2], u1[2]), silu_mul(g1[3], u1[3]));
                __builtin_nontemporal_store(w, (u32x2*)rowp); }
    }
};
struct EpiMoeDown {
    static constexpr bool PERM = true, RS_LDS = false;
    bf16_t* Y0; bf16_t* Y1; const int* rowinfo; const float* rowgate; float osc;
    __device__ __forceinline__ void operator()(const f32x4 (&acc)[2][2][4][2], const Unit& u, int wr, int wc, int fr, int fq) const {
        const int row0 = u.po * BM + wr * 64 + fr, col0 = u.pn * BM + wc * 32 + 8 * fq;
#pragma unroll
        for (int ai = 0; ai < 2; ++ai)
#pragma unroll
            for (int m = 0; m < 4; ++m) { const int r = row0 + ai * HALF + m * 16; const int info = rowinfo[r]; const float g = rowgate[r] * osc;
                if (info >= 0) { const int tok = info & 0xffff; bf16_t* rowp = ((info >> 16) == 0 ? Y0 : Y1) + (size_t)tok * D + col0;
#pragma unroll
                    for (int bj = 0; bj < 2; ++bj) { const f32x4 v0 = acc[ai][bj][m][0] * g, v1 = acc[ai][bj][m][1] * g;
                        u32x4 w; w.x = cvt_pk_bf16(v0[0], v0[1]); w.y = cvt_pk_bf16(v0[2], v0[3]); w.z = cvt_pk_bf16(v1[0], v1[1]); w.w = cvt_pk_bf16(v1[2], v1[3]);
                        *(u32x4*)(rowp + bj * HALF) = w; } } }
    }
};

template <class Epi, class Sched, int FMT = -1>
__device__ __forceinline__ void gemm_phase(LAS unsigned char* lds, const Gemm g, const Sched& S, const Epi& E) {
    const int tid = threadIdx.x, wid = __builtin_amdgcn_readfirstlane(tid >> 6), lane = tid & 63, wr = wid >> 2, wc = wid & 3, fr = lane & 15, fq = lane >> 4;
    const int KB = g.KB, nt = KB / (BK * 2);
    constexpr bool GA = Sched::GATHER;
    unsigned voffA, voffB; int gR, gC2;
    { int R, C; stage_rc(tid * 16, R, C); const int Rb = Epi::PERM ? ((R & ~31) + perm32(R & 31)) : R; voffA = (unsigned)(R * KB + C * 2); voffB = (unsigned)(Rb * KB + C * 2); gR = R; gC2 = C * 2; }
    const size_t pstep = (size_t)64 * KB;
    const size_t kstep = (size_t)(BK * 2);
    const size_t hstep = (size_t)HALF * KB;
    const size_t tstep = 2 * hstep;
    const size_t hstepA = GA ? 0 : hstep;
    const unsigned ldsw = (unsigned)wid * 1024u;
    const int aoff = lds_byte(wr * 64 + fr, fq * 8), boff = lds_byte(wc * 32 + fr, fq * 8);
#define PG8_SA(b, h) (((b) * 2 + (h)) * HTB)
#define PG8_SB(b, h) ((4 + (b) * 2 + (h)) * HTB)
#define PG8_STAGE2(bufoff, gbase, v0, v1, pst) do { _Pragma("unroll") for (int _i = 0; _i < 2; ++_i) { unsigned _vo = _i ? (v1) : (v0); asm volatile("" : "+v"(_vo)); \
        const char* _gb = (const char*)(gbase) + _i * (pst); asm volatile("" : "+s"(_gb)); \
        __builtin_amdgcn_global_load_lds((const unsigned*)(_gb + _vo), (LAS unsigned*)(lds + (bufoff) + ldsw + _i * 8192), 16, 0, 0); } } while (0)
#define PG8_STAGE(bufoff, gbase, voff) PG8_STAGE2(bufoff, gbase, voff, voff, pstep)
#define PG8_STAGE_A(bufoff, gbase, h, nx) do { if constexpr (GA) PG8_STAGE2(bufoff, gbase, ((nx) ? vn[h][0] : vc[h][0]), ((nx) ? vn[h][1] : vc[h][1]), 0); else PG8_STAGE2(bufoff, gbase, voffA, voffA, pstep); } while (0)
#define PG8_GISSUE(tile, slot) __builtin_amdgcn_global_load_lds((const unsigned*)(S.rowinfo + (size_t)(tile) * 256 + lane * 4), (LAS unsigned*)(S.gl + wid * 2048 + (slot) * 1024), 16, 0, 0)
#define PG8_GREAD(dst, slot) do { _Pragma("unroll") for (int _h = 0; _h < 2; ++_h) _Pragma("unroll") for (int _i = 0; _i < 2; ++_i) { \
        const int _info = lds_ld_i32((unsigned)(size_t)(S.gl + wid * 2048 + (slot) * 1024) + (unsigned)((_h * 128 + _i * 64 + gR) * 4)); \
        dst[_h][_i] = (unsigned)((_info < 0 ? 0 : (_info & 0xffff)) * KB + gC2); } } while (0)
#define PG8_LDA(dst, b, h) do { _Pragma("unroll") for (int m = 0; m < 4; ++m) { dst[m].lo = *(const LAS i32x4*)(lds + PG8_SA(b, h) + aoff + m * 2048); dst[m].hi = *(const LAS i32x4*)(lds + PG8_SA(b, h) + aoff + m * 2048 + 1024); } } while (0)
#define PG8_LDB(dst, b, h) do { _Pragma("unroll") for (int n = 0; n < 2; ++n) { dst[n].lo = *(const LAS i32x4*)(lds + PG8_SB(b, h) + boff + n * 2048); dst[n].hi = *(const LAS i32x4*)(lds + PG8_SB(b, h) + boff + n * 2048 + 1024); } } while (0)
#define PG8_MMA(ai, bj, At, Bt) do { __builtin_amdgcn_s_setprio(1); _Pragma("unroll") for (int m = 0; m < 4; ++m) _Pragma("unroll") for (int n = 0; n < 2; ++n) { \
        if constexpr (FMT == 0) acc[ai][bj][m][n] = __builtin_amdgcn_mfma_scale_f32_16x16x128_f8f6f4(Bt[n], At[m], acc[ai][bj][m][n], 0, 0, 0, 0x7f7f7f7f, 0, 0x7f7f7f7f); \
        else if constexpr (FMT == 8) { const i32x4 _bl = Bt[n].lo, _bh = Bt[n].hi, _al = At[m].lo, _ah = At[m].hi; i32x4 _c = __builtin_bit_cast(i32x4, acc[ai][bj][m][n]); \
               _c = __builtin_amdgcn_mfma_i32_16x16x64_i8(_bl, _al, _c, 0, 0, 0); _c = __builtin_amdgcn_mfma_i32_16x16x64_i8(_bh, _ah, _c, 0, 0, 0); acc[ai][bj][m][n] = __builtin_bit_cast(f32x4, _c); } \
        else { const i32x4 _bl = Bt[n].lo, _bh = Bt[n].hi, _al = At[m].lo, _ah = At[m].hi; \
               acc[ai][bj][m][n] = __builtin_amdgcn_mfma_f32_16x16x32_bf16(__builtin_bit_cast(bf16x8, _bl), __builtin_bit_cast(bf16x8, _al), acc[ai][bj][m][n], 0, 0, 0); \
               acc[ai][bj][m][n] = __builtin_amdgcn_mfma_f32_16x16x32_bf16(__builtin_bit_cast(bf16x8, _bh), __builtin_bit_cast(bf16x8, _ah), acc[ai][bj][m][n], 0, 0, 0); } } __builtin_amdgcn_s_setprio(0); } while (0)
#define PG8_WAIT_V(n) asm volatile("s_waitcnt vmcnt(" #n ")" ::: "memory")
#define PG8_WAIT_L(n) asm volatile("s_waitcnt lgkmcnt(" #n ")" ::: "memory")
#define PG8_BAR __builtin_amdgcn_s_barrier()
#define PG8_SCHED __builtin_amdgcn_sched_barrier(0)
    Unit cur, nxt; int ui = 0;
    if (!S.next(0, cur)) return;
    cur.ui = 0;
    if constexpr (Epi::RS_LDS) E.prefetch(cur, wid, tid);
    f32x4 acc[2][2][4][2];
#pragma unroll
    for (int a = 0; a < 2; ++a)
#pragma unroll
        for (int b = 0; b < 2; ++b)
#pragma unroll
            for (int m = 0; m < 4; ++m)
#pragma unroll
                for (int n = 0; n < 2; ++n) acc[a][b][m][n] = (f32x4){0.f, 0.f, 0.f, 0.f};
    i32x8 At[4], B0[2], B1[2];
    unsigned vc[2][2], vn[2][2];
    if constexpr (GA) { int t1; PG8_GISSUE(cur.pm, 0); if (S.row_tile(1, t1)) PG8_GISSUE(t1, 1); asm volatile("s_waitcnt vmcnt(0)" ::: "memory"); PG8_GREAD(vc, 0);
#pragma unroll
        for (int h = 0; h < 2; ++h) { vn[h][0] = vc[h][0]; vn[h][1] = vc[h][1]; } }
    const char* cA = GA ? (const char*)g.A : (const char*)g.A + (size_t)cur.pm * tstep; const char* cB = (const char*)g.Bt + (size_t)cur.pb * tstep;
    PG8_STAGE(PG8_SB(0, 0), cB, voffB); PG8_STAGE(PG8_SB(0, 1), cB + hstep, voffB); PG8_STAGE_A(PG8_SA(0, 0), cA, 0, false); PG8_STAGE_A(PG8_SA(0, 1), cA + hstepA, 1, false);
    if (wr == 1) PG8_BAR;
    PG8_WAIT_V(2); PG8_BAR;
    PG8_STAGE(PG8_SB(1, 0), cB + kstep, voffB); PG8_STAGE_A(PG8_SA(1, 0), cA + kstep, 0, false); PG8_STAGE(PG8_SB(1, 1), cB + hstep + kstep, voffB);
    PG8_WAIT_V(6); PG8_BAR;
    for (;;) {
        const bool has_next = S.next(ui + 1, nxt); nxt.ui = ui + 1;
        if constexpr (GA) { if (has_next) PG8_GREAD(vn, (ui + 1) & 1); int t2; if (S.row_tile(ui + 2, t2)) PG8_GISSUE(t2, ui & 1); }
        const char* nA = GA ? cA : (has_next ? (const char*)g.A + (size_t)nxt.pm * tstep : cA); const char* nB = has_next ? (const char*)g.Bt + (size_t)nxt.pb * tstep : cB;
        for (int t = 0; t < nt; t += 2) {
            const bool last = (t == nt - 2);
            const char* a1 = cA + (size_t)(t + 1) * kstep;
            const char* a2 = last ? nA : cA + (size_t)(t + 2) * kstep; const char* b2 = last ? nB : cB + (size_t)(t + 2) * kstep;
            const char* a3 = a2 + kstep; const char* b3 = b2 + kstep;
            PG8_LDB(B0, 0, 0); PG8_LDB(B1, 0, 1); PG8_SCHED; PG8_LDA(At, 0, 0); PG8_STAGE_A(PG8_SA(1, 1), a1 + hstepA, 1, false);
            PG8_WAIT_V(8); PG8_WAIT_L(0); PG8_BAR; PG8_MMA(0, 0, At, B0); PG8_MMA(0, 1, At, B1); PG8_BAR; PG8_SCHED;
            PG8_LDA(At, 0, 1); PG8_STAGE(PG8_SB(0, 0), b2, voffB); PG8_STAGE(PG8_SB(0, 1), b2 + hstep, voffB); PG8_STAGE_A(PG8_SA(0, 0), a2, 0, last);
            PG8_WAIT_V(8); PG8_WAIT_L(0); PG8_BAR; PG8_MMA(1, 0, At, B0); PG8_MMA(1, 1, At, B1); PG8_BAR; PG8_SCHED;
            PG8_LDB(B0, 1, 0); PG8_LDB(B1, 1, 1); PG8_SCHED; PG8_LDA(At, 1, 0); PG8_STAGE_A(PG8_SA(0, 1), a2 + hstepA, 1, last);
            PG8_WAIT_V(8); PG8_WAIT_L(0); PG8_BAR; PG8_MMA(0, 0, At, B0); PG8_MMA(0, 1, At, B1); PG8_BAR; PG8_SCHED;
            PG8_LDA(At, 1, 1); PG8_STAGE(PG8_SB(1, 0), b3, voffB); PG8_STAGE(PG8_SB(1, 1), b3 + hstep, voffB); PG8_STAGE_A(PG8_SA(1, 0), a3, 0, last);
            PG8_WAIT_V(8); PG8_WAIT_L(0); PG8_BAR; PG8_MMA(1, 0, At, B0); PG8_MMA(1, 1, At, B1); PG8_BAR; PG8_SCHED;
        }
        if (wr == 0) PG8_BAR;
        if constexpr (FMT == 8) {
#pragma unroll
            for (int a = 0; a < 2; ++a)
#pragma unroll
                for (int b = 0; b < 2; ++b)
#pragma unroll
                    for (int m = 0; m < 4; ++m)
#pragma unroll
                        for (int n = 0; n < 2; ++n) acc[a][b][m][n] = __builtin_convertvector(__builtin_bit_cast(i32x4, acc[a][b][m][n]), f32x4); }
        E(acc, cur, wr, wc, fr, fq);
        if (!has_next) break;
        if constexpr (Epi::RS_LDS) E.prefetch(nxt, wid, tid);
#pragma unroll
        for (int a = 0; a < 2; ++a)
#pragma unroll
            for (int b = 0; b < 2; ++b)
#pragma unroll
                for (int m = 0; m < 4; ++m)
#pragma unroll
                    for (int n = 0; n < 2; ++n) acc[a][b][m][n] = (f32x4){0.f, 0.f, 0.f, 0.f};
        cur = nxt; cA = nA; cB = nB; ++ui;
        if constexpr (GA) {
#pragma unroll
            for (int h = 0; h < 2; ++h) { vc[h][0] = vn[h][0]; vc[h][1] = vn[h][1]; } }
        if (wr == 1) PG8_BAR;
    }
    PG8_WAIT_V(0);
    PG8_BAR;
#undef PG8_SA
#undef PG8_SB
#undef PG8_STAGE
#undef PG8_STAGE2
#undef PG8_STAGE_A
#undef PG8_GISSUE
#undef PG8_GREAD
#undef PG8_LDA
#undef PG8_LDB
#undef PG8_MMA
#undef PG8_WAIT_V
#undef PG8_WAIT_L
#undef PG8_BAR
#undef PG8_SCHED
}
}

#define XB_TMO      128
#define XB_XCNT(j)  (256  + 64 * (j))
#define XB_XSUB(j)  (1280 + 64 * (j))
#define XB_XGEN(j)  (2304 + 64 * (j))
#define XB_TOP      3328
#define XB_TOPGEN   3392
#define XCD_BAR_WORDS 3456
#define XB_SPIN_CAP (1u << 20)
__device__ __forceinline__ unsigned xb_ld(unsigned* p)              { return __hip_atomic_load(p, __ATOMIC_RELAXED, __HIP_MEMORY_SCOPE_AGENT); }
__device__ __forceinline__ unsigned xb_add(unsigned* p, unsigned v) { return __hip_atomic_fetch_add(p, v, __ATOMIC_RELAXED, __HIP_MEMORY_SCOPE_AGENT); }
__device__ __forceinline__ unsigned xb_xcc_id() { return (unsigned)__builtin_amdgcn_s_getreg((3 << 11) | 20) & 0xFu; }
#define XB_SPIN(cond, bar) do { unsigned _sp = 0; while (cond) { __builtin_amdgcn_s_sleep(1); \
    if ((++_sp & 255u) == 0u) { if (xb_ld(&(bar)[XB_TMO])) break; if (_sp > XB_SPIN_CAP) { atomicAdd(&(bar)[XB_TMO], 1u); break; } } } } while (0)
struct XcdBarrier { unsigned* bar; unsigned x; volatile LAS unsigned* st; };
__device__ __forceinline__ XcdBarrier xcd_barrier_post(unsigned* bar, volatile LAS unsigned* st) {
    XcdBarrier b; b.bar = bar; b.x = xb_xcc_id(); b.st = st;
    if (threadIdx.x == 0) (void)xb_add(&bar[XB_XCNT(b.x)], 1u);
    return b;
}
__device__ __forceinline__ void xcd_barrier_complete(unsigned* bar, unsigned x, unsigned& nloc, unsigned& nx) {
    const unsigned G = gridDim.x * gridDim.y * gridDim.z;
    unsigned sum, cnt, mine, sp = 0u;
    for (;;) {
        sum = 0u; cnt = 0u; mine = 0u;
#pragma unroll
        for (unsigned j = 0; j < 16; ++j) { const unsigned c = xb_ld(&bar[XB_XCNT(j)]); sum += c; cnt += (c > 0u) ? 1u : 0u; mine = (j == x) ? c : mine; }
        if (sum == G) break;
        __builtin_amdgcn_s_sleep(1);
        if ((++sp & 255u) == 0u) { if (xb_ld(&bar[XB_TMO])) break; if (sp > XB_SPIN_CAP) { atomicAdd(&bar[XB_TMO], 1u); break; } }
    }
    nloc = mine > 0u ? mine : 1u; nx = cnt > 0u ? cnt : 1u;
}
__device__ __forceinline__ void xcd_barrier(const XcdBarrier& b) {
    asm volatile("s_waitcnt vmcnt(0)" ::: "memory");
    __syncthreads();
    if (threadIdx.x == 0) {
        unsigned* bar = b.bar;
        __builtin_amdgcn_s_waitcnt(0);
        unsigned nloc = b.st[0], nx = b.st[1];
        if (nloc == 0u) { xcd_barrier_complete(bar, b.x, nloc, nx); b.st[0] = nloc; b.st[1] = nx; }
        const unsigned old = xb_add(&bar[XB_XSUB(b.x)], 1u);
        const unsigned gen = old / nloc;
        if (old + 1u == (gen + 1u) * nloc) {
            __builtin_amdgcn_fence(__ATOMIC_RELEASE, "agent");
            asm volatile("s_waitcnt vmcnt(0)" ::: "memory");
            const unsigned og = xb_add(&bar[XB_TOP], 1u);
            const unsigned tg = og / nx;
            if (og + 1u == (tg + 1u) * nx) xb_add(&bar[XB_TOPGEN], 1u);
            else XB_SPIN(xb_ld(&bar[XB_TOPGEN]) == tg, bar);
            __builtin_amdgcn_fence(__ATOMIC_ACQUIRE, "agent");
            xb_add(&bar[XB_XGEN(b.x)], 1u);
            asm volatile("s_waitcnt vmcnt(0)" ::: "memory");
        } else {
            XB_SPIN(xb_ld(&bar[XB_XGEN(b.x)]) == gen, bar);
            __builtin_amdgcn_fence(__ATOMIC_ACQUIRE, "agent");
            asm volatile("s_waitcnt vmcnt(0)" ::: "memory");
        }
    }
    __syncthreads();
}

constexpr int P0S = 65;
__device__ __forceinline__ void p0_load_tile(const float* W, int N, int k0, int n0, LAS float* scr, int lane, const float* kgain = nullptr) {
    f32x4 v[16];
#pragma unroll
    for (int i = 0; i < 16; ++i) v[i] = *(const f32x4*)(W + (size_t)(k0 + 4 * i + (lane >> 4)) * N + n0 + 4 * (lane & 15));
    if (kgain) {
#pragma unroll
        for (int i = 0; i < 16; ++i) v[i] = v[i] * kgain[k0 + 4 * i + (lane >> 4)]; }
#pragma unroll
    for (int i = 0; i < 16; ++i) { LAS float* d = scr + (4 * i + (lane >> 4)) * P0S + 4 * (lane & 15); d[0] = v[i].x; d[1] = v[i].y; d[2] = v[i].z; d[3] = v[i].w; }
    LDS_WAIT(); asm volatile("" ::: "memory");
}
__device__ __forceinline__ void p0_transpose_item(const float* W, int K, int N, bf16_t* WT, int k0, int n0, int drow0, LAS float* scr, int lane, const float* kgain = nullptr) {
    p0_load_tile(W, N, k0, n0, scr, lane, kgain);
    const int c = lane & 7;
#pragma unroll
    for (int j = 0; j < 8; ++j) { const int n = (lane >> 3) + 8 * j; const LAS float* s = scr + (8 * c) * P0S + n;
        u32x4 o; o.x = cvt_pk_bf16(s[0 * P0S], s[1 * P0S]); o.y = cvt_pk_bf16(s[2 * P0S], s[3 * P0S]); o.z = cvt_pk_bf16(s[4 * P0S], s[5 * P0S]); o.w = cvt_pk_bf16(s[6 * P0S], s[7 * P0S]);
        *(u32x4*)(WT + (size_t)(drow0 + n) * K + k0 + 8 * c) = o; }
    LDS_WAIT(); asm volatile("" ::: "memory");
}
template <int BLK>
__device__ __forceinline__ void p0_item_dn(const float* W, int K, int N, bf16_t* WT  , unsigned char* WT8, float wsc, int k0, int n0, LAS float* scr, int lane) {
    p0_load_tile(W, N, k0, n0, scr, lane, nullptr);
    if (WT) { const int c = lane & 7;
#pragma unroll
      for (int j = 0; j < 8; ++j) { const int n = (lane >> 3) + 8 * j; const LAS float* s = scr + (8 * c) * P0S + n;
          u32x4 o; o.x = cvt_pk_bf16(s[0 * P0S], s[1 * P0S]); o.y = cvt_pk_bf16(s[2 * P0S], s[3 * P0S]); o.z = cvt_pk_bf16(s[4 * P0S], s[5 * P0S]); o.w = cvt_pk_bf16(s[6 * P0S], s[7 * P0S]);
          *(u32x4*)(WT + (size_t)(n0 + n) * K + k0 + 8 * c) = o; } }
    { const int c = lane & 3; const float sc = wsc * (BLK == 32 ? 0.17677669529663687f : 0.35355339059327373f);
#pragma unroll
      for (int j = 0; j < 4; ++j) { const int n = (lane >> 2) + 16 * j; const LAS float* s = scr + (16 * c) * P0S + n;
          float f[16];
#pragma unroll
          for (int e = 0; e < 16; ++e) f[e] = s[e * P0S];
#pragma unroll
          for (int h = 1; h < (BLK == 32 ? 16 : 8); h <<= 1)
#pragma unroll
              for (int i = 0; i < 16; ++i) if ((i & h) == 0) { const float a = f[i], b = f[i + h]; f[i] = a + b; f[i + h] = a - b; }
#pragma unroll
          for (int e = 0; e < 16; ++e) { if constexpr (BLK == 32) { const float o = __shfl_xor(f[e], 1); f[e] = ((c & 1) ? o - f[e] : f[e] + o) * sc; } else f[e] *= sc; }
          u32x4 o; o.x = pk4_i8(f[0], f[1], f[2], f[3]); o.y = pk4_i8(f[4], f[5], f[6], f[7]); o.z = pk4_i8(f[8], f[9], f[10], f[11]); o.w = pk4_i8(f[12], f[13], f[14], f[15]);
          *(u32x4*)(WT8 + (size_t)(n0 + n) * K + k0 + 16 * c) = o; } }
    LDS_WAIT(); asm volatile("" ::: "memory");
}
__device__ __forceinline__ void p0_matrix(const float* W, int K, int N, bf16_t* WT, int ilv_half  , int r, LAS float* scr, int lane, const float* kgain = nullptr) {
    const int nblk = N / 64, kb = (r / (4 * nblk)) * 4 + (r & 3), nb = (r >> 2) % nblk, n0 = 64 * nb;
    const int drow0 = ilv_half < 0 ? n0 : (n0 / 128) * 256 + ilv_half * 128 + (n0 % 128);
    p0_transpose_item(W, K, N, WT, 64 * kb, n0, drow0, scr, lane, kgain);
}
__device__ __forceinline__ void p0_transpose_item8(const float* W, int K, int N, unsigned char* WT, int k0, int n0, int drow0, float sc, LAS float* scr, int lane) {
    p0_load_tile(W, N, k0, n0, scr, lane);
    const int c = lane & 3;
#pragma unroll
    for (int j = 0; j < 4; ++j) { const int n = (lane >> 2) + 16 * j; const LAS float* s = scr + (16 * c) * P0S + n;
        u32x4 o; o.x = pk4_fp8(s[0 * P0S] * sc, s[1 * P0S] * sc, s[2 * P0S] * sc, s[3 * P0S] * sc); o.y = pk4_fp8(s[4 * P0S] * sc, s[5 * P0S] * sc, s[6 * P0S] * sc, s[7 * P0S] * sc);
        o.z = pk4_fp8(s[8 * P0S] * sc, s[9 * P0S] * sc, s[10 * P0S] * sc, s[11 * P0S] * sc); o.w = pk4_fp8(s[12 * P0S] * sc, s[13 * P0S] * sc, s[14 * P0S] * sc, s[15 * P0S] * sc);
        *(u32x4*)(WT + (size_t)(drow0 + n) * K + k0 + 16 * c) = o; }
    LDS_WAIT(); asm volatile("" ::: "memory");
}
__device__ __forceinline__ void p0_matrix8(const float* W, int K, int N, unsigned char* WT, int ilv_half, float sc, int r, LAS float* scr, int lane) {
    const int nblk = N / 64, kb = (r / (4 * nblk)) * 4 + (r & 3), nb = (r >> 2) % nblk, n0 = 64 * nb;
    const int drow0 = ilv_half < 0 ? n0 : (n0 / 128) * 256 + ilv_half * 128 + (n0 % 128);
    p0_transpose_item8(W, K, N, WT, 64 * kb, n0, drow0, sc, scr, lane);
}

__device__ __forceinline__ void p0_transpose_item_i8(const float* W, int K, int N, unsigned char* WT, int k0, int n0, int drow0, float sc, LAS float* scr, int lane, const float* kgain) {
    p0_load_tile(W, N, k0, n0, scr, lane, kgain);
    const int c = lane & 3;
#pragma unroll
    for (int j = 0; j < 4; ++j) { const int n = (lane >> 2) + 16 * j; const LAS float* s = scr + (16 * c) * P0S + n;
        u32x4 o; o.x = pk4_i8(s[0 * P0S] * sc, s[1 * P0S] * sc, s[2 * P0S] * sc, s[3 * P0S] * sc); o.y = pk4_i8(s[4 * P0S] * sc, s[5 * P0S] * sc, s[6 * P0S] * sc, s[7 * P0S] * sc);
        o.z = pk4_i8(s[8 * P0S] * sc, s[9 * P0S] * sc, s[10 * P0S] * sc, s[11 * P0S] * sc); o.w = pk4_i8(s[12 * P0S] * sc, s[13 * P0S] * sc, s[14 * P0S] * sc, s[15 * P0S] * sc);
        *(u32x4*)(WT + (size_t)(drow0 + n) * K + k0 + 16 * c) = o; }
    LDS_WAIT(); asm volatile("" ::: "memory");
}
__device__ __forceinline__ void p0_matrix_i8(const float* W, int K, int N, unsigned char* WT, int ilv_half, float sc, int r, LAS float* scr, int lane, const float* kgain) {
    const int nblk = N / 64, kb = (r / (4 * nblk)) * 4 + (r & 3), nb = (r >> 2) % nblk, n0 = 64 * nb;
    const int drow0 = ilv_half < 0 ? n0 : (n0 / 128) * 256 + ilv_half * 128 + (n0 % 128);
    p0_transpose_item_i8(W, K, N, WT, 64 * kb, n0, drow0, sc, scr, lane, kgain);
}

__device__ __forceinline__ void rms_rows_to_bf16(const float* x, const float* gain, bf16_t* o, int m0, int step, int m1, int lane) {
    f32x4 g[4][2];
#pragma unroll
    for (int j = 0; j < 4; ++j) { const f32x4* gp = (const f32x4*)(gain + 8 * (lane + 64 * j)); g[j][0] = gp[0]; g[j][1] = gp[1]; }
    for (int m = m0; m < m1; m += step) {
        const float* xrow = x + (size_t)m * D; bf16_t* orow = o + (size_t)m * D;
        f32x4 v[4][2]; float s = 0.f;
#pragma unroll
        for (int j = 0; j < 4; ++j) { const f32x4* p = (const f32x4*)(xrow + 8 * (lane + 64 * j)); v[j][0] = p[0]; v[j][1] = p[1]; }
#pragma unroll
        for (int j = 0; j < 4; ++j)
            s += (v[j][0].x * v[j][0].x + v[j][0].y * v[j][0].y) + (v[j][0].z * v[j][0].z + v[j][0].w * v[j][0].w) + (v[j][1].x * v[j][1].x + v[j][1].y * v[j][1].y) + (v[j][1].z * v[j][1].z + v[j][1].w * v[j][1].w);
        const float rstd = 1.0f / sqrtf(wave_sum(s) * (1.0f / D) + RMS_EPS);
#pragma unroll
        for (int j = 0; j < 4; ++j) { const f32x4 a = v[j][0] * rstd * g[j][0], b = v[j][1] * rstd * g[j][1];
            u32x4 w; w.x = cvt_pk_bf16(a.x, a.y); w.y = cvt_pk_bf16(a.z, a.w); w.z = cvt_pk_bf16(b.x, b.y); w.w = cvt_pk_bf16(b.z, b.w);
            *(u32x4*)(orow + 8 * (lane + 64 * j)) = w; }
    }
}

__device__ __forceinline__ void rms_rows_to_i8(const float* x, const float* gain, unsigned char* o, int m0, int step, int m1, int lane) {
    f32x4 g[4][2];
#pragma unroll
    for (int j = 0; j < 4; ++j) { const f32x4* gp = (const f32x4*)(gain + 8 * (lane + 64 * j)); g[j][0] = gp[0] * SC_A8; g[j][1] = gp[1] * SC_A8; }
    for (int m = m0; m < m1; m += step) {
        const float* xrow = x + (size_t)m * D; unsigned char* orow = o + (size_t)m * D;
        f32x4 v[4][2]; float s = 0.f;
#pragma unroll
        for (int j = 0; j < 4; ++j) { const f32x4* p = (const f32x4*)(xrow + 8 * (lane + 64 * j)); v[j][0] = p[0]; v[j][1] = p[1]; }
#pragma unroll
        for (int j = 0; j < 4; ++j)
            s += (v[j][0].x * v[j][0].x + v[j][0].y * v[j][0].y) + (v[j][0].z * v[j][0].z + v[j][0].w * v[j][0].w) + (v[j][1].x * v[j][1].x + v[j][1].y * v[j][1].y) + (v[j][1].z * v[j][1].z + v[j][1].w * v[j][1].w);
        const float rstd = 1.0f / sqrtf(wave_sum(s) * (1.0f / D) + RMS_EPS);
#pragma unroll
        for (int j = 0; j < 4; ++j) { const f32x4 a = v[j][0] * rstd * g[j][0], b = v[j][1] * rstd * g[j][1];
            u32x2 w; w.x = pk4_i8(a.x, a.y, a.z, a.w); w.y = pk4_i8(b.x, b.y, b.z, b.w); *(u32x2*)(orow + 8 * (lane + 64 * j)) = w; }
    }
}


__device__ __forceinline__ void meta_rstd(const float* src, LAS float* rs, int wave, int lane) {
#pragma unroll
    for (int rr = 0; rr < 2; ++rr) { const int row = 2 * wave + rr; float s = 0.f;
#pragma unroll
        for (int j = 0; j < 8; ++j) { const f32x4 v = *(const f32x4*)(src + (size_t)row * D + 4 * (lane + 64 * j)); s += (v.x * v.x + v.y * v.y) + (v.z * v.z + v.w * v.w); }
        s = wave_sum(s); if (lane == 0) rs[row] = 1.0f / sqrtf(s * (1.0f / D) + RMS_EPS); }
    __syncthreads();
}

struct FNorm { const float* src; const float* gain; const LAS float* rstd; int K;
    __device__ __forceinline__ void operator()(int row, int k, float (&a)[8]) const { const f32x4* p = (const f32x4*)(src + (size_t)row * K + k); const float r = rstd[row]; f32x4 x = p[0] * r, y = p[1] * r;
        if (gain) { const f32x4* gp = (const f32x4*)(gain + k); x = x * gp[0]; y = y * gp[1]; } a[0] = x.x; a[1] = x.y; a[2] = x.z; a[3] = x.w; a[4] = y.x; a[5] = y.y; a[6] = y.z; a[7] = y.w; } };
struct FCvt { const float* src; int K;
    __device__ __forceinline__ void operator()(int row, int k, float (&a)[8]) const { const f32x4* p = (const f32x4*)(src + (size_t)row * K + k); const f32x4 x = p[0], y = p[1];
        a[0] = x.x; a[1] = x.y; a[2] = x.z; a[3] = x.w; a[4] = y.x; a[5] = y.y; a[6] = y.z; a[7] = y.w; } };
template <int WF, int C, class AL, class CM, class EP>
__device__ __forceinline__ void meta_gemm_mc(const void* Btv, int K, int ngroups, float wsc, const AL& A, const CM& colmap, const EP& E, int gw, int NGW, int lane) {
    for (int g = gw; g < ngroups; g += NGW) {
#pragma unroll 1
        for (int rb = 0; rb < 16; rb += 4) {
            float acc[4][C];
#pragma unroll
            for (int r = 0; r < 4; ++r)
#pragma unroll
                for (int c = 0; c < C; ++c) acc[r][c] = 0.f;
#pragma unroll 1
            for (int k = lane * 8; k < K; k += 512) {
                float a[4][8];
#pragma unroll
                for (int r = 0; r < 4; ++r) A(rb + r, k, a[r]);
#pragma unroll
                for (int c = 0; c < C; ++c) { const int n = colmap(g, c); float wf[8];
                    if constexpr (WF == 0) { const u32x4 w = *(const u32x4*)((const bf16_t*)Btv + (size_t)n * K + k);
                        wf[0] = bflo(w.x); wf[1] = bfhi(w.x); wf[2] = bflo(w.y); wf[3] = bfhi(w.y); wf[4] = bflo(w.z); wf[5] = bfhi(w.z); wf[6] = bflo(w.w); wf[7] = bfhi(w.w); }
                    else { const u32x2 w = *(const u32x2*)((const unsigned char*)Btv + (size_t)n * K + k);
                        if constexpr (WF == 1) {
#pragma unroll
                            for (int e = 0; e < 4; ++e) { wf[e] = (float)((int)(w.x << (24 - 8 * e)) >> 24); wf[4 + e] = (float)((int)(w.y << (24 - 8 * e)) >> 24); } }
                        else { wf[0] = __builtin_amdgcn_cvt_f32_fp8((int)w.x, 0); wf[1] = __builtin_amdgcn_cvt_f32_fp8((int)w.x, 1); wf[2] = __builtin_amdgcn_cvt_f32_fp8((int)w.x, 2); wf[3] = __builtin_amdgcn_cvt_f32_fp8((int)w.x, 3);
                               wf[4] = __builtin_amdgcn_cvt_f32_fp8((int)w.y, 0); wf[5] = __builtin_amdgcn_cvt_f32_fp8((int)w.y, 1); wf[6] = __builtin_amdgcn_cvt_f32_fp8((int)w.y, 2); wf[7] = __builtin_amdgcn_cvt_f32_fp8((int)w.y, 3); } }
#pragma unroll
                    for (int r = 0; r < 4; ++r)
#pragma unroll
                        for (int e = 0; e < 8; ++e) acc[r][c] += a[r][e] * wf[e]; }
            }
#pragma unroll
            for (int r = 0; r < 4; ++r)
#pragma unroll
                for (int c = 0; c < C; ++c) acc[r][c] = wave_sum(acc[r][c]) * wsc;
            E(rb, g, acc, lane);
        }
    }
}
template <int C> struct CMCons { __device__ __forceinline__ int operator()(int g, int c) const { return g * C + c; } };
struct CMGateUp { __device__ __forceinline__ int operator()(int g, int c) const { const int ch = 4 * g + (c & 3); return (ch >> 7) * 256 + (ch & 127) + (c >> 2) * 128; } };
template <int C> struct EStoreC { float* out; int ldc;
    __device__ __forceinline__ void operator()(int rb, int g, const float (&v)[4][C], int lane) const {
#pragma unroll
        for (int r = 0; r < 4; ++r)
#pragma unroll
            for (int c = 0; c < C; ++c) if (lane == r * C + c) out[(size_t)(rb + r) * ldc + g * C + c] = v[r][c]; } };
template <int C> struct EResidC { const float* base; float* out; int ldc;
    __device__ __forceinline__ void operator()(int rb, int g, const float (&v)[4][C], int lane) const {
#pragma unroll
        for (int r = 0; r < 4; ++r)
#pragma unroll
            for (int c = 0; c < C; ++c) if (lane == r * C + c) { const size_t o = (size_t)(rb + r) * ldc + g * C + c; out[o] = base[o] + v[r][c]; } } };
struct ESiluAct { float* act;
    __device__ __forceinline__ void operator()(int rb, int g, const float (&v)[4][8], int lane) const {
#pragma unroll
        for (int r = 0; r < 4; ++r)
#pragma unroll
            for (int c = 0; c < 4; ++c) if (lane == r * 4 + c) act[(size_t)(rb + r) * FF + 4 * g + c] = pg8::silu_mul(v[r][c], v[r][c + 4]); } };

namespace att {
constexpr int NSLOT = 3, SLOT = 32768, OFF_KM = 98304, OFF_VM = OFF_KM + 4096, OFF_QM = OFF_VM + 4096, OFF_BIAS = OFF_QM + 4096, OFF_MB = OFF_BIAS + 4096, OFF_SC = OFF_MB + 256;
constexpr int BIAS_SLACK = 256;
__device__ __forceinline__ int swzK(int key) { return ((key >> 3) & 3) * 4 + (key & 3); }
__device__ __forceinline__ int gswV(int row) { return ((row & 3) << 2) | ((row >> 2) & 3); }
__device__ __forceinline__ int r0_of(int r) { const int a = r - 4; return a < 0 ? 0 : (a > GR - 8 ? GR - 8 : a); }
__device__ __forceinline__ bf16x4 tr_read(unsigned addr) { bf16x4 r; asm volatile("ds_read_b64_tr_b16 %0, %1" : "=v"(r) : "v"(addr)); return r; }

__device__ __forceinline__ void meta_step(LAS unsigned char* lds, const bf16x8 (&qf)[4], float Mq, f32x4 (&O)[8], float& lsum, int fr, int fq, int lane) {
    f32x4 s = (f32x4){0.f, 0.f, 0.f, 0.f};
#pragma unroll
    for (int ks = 0; ks < 4; ++ks) { const bf16x8 kf = *(const LAS bf16x8*)(lds + OFF_KM + fr * 256 + (((4 * ks + fq) ^ fr) << 4)); s = __builtin_amdgcn_mfma_f32_16x16x32_bf16(kf, qf[ks], s, 0, 0, 0); }
    const LAS float* mb = (const LAS float*)(lds + OFF_MB);
    float p[4];
#pragma unroll
    for (int i = 0; i < 4; ++i) { p[i] = __builtin_amdgcn_exp2f(s[i] + mb[4 * fq + i] - Mq); lsum += p[i]; }
    u32x4 pw; pw.x = cvt_pk_bf16(p[0], p[1]); pw.y = cvt_pk_bf16(p[2], p[3]); pw.z = 0u; pw.w = 0u;
    const bf16x8 pf = __builtin_bit_cast(bf16x8, pw);
    const int g = lane >> 4, q = (lane & 15) >> 2, pp = lane & 3, row = 4 * g + q;
    const unsigned vbase = (unsigned)(size_t)(lds + OFF_VM) + 256u * row + 8u * (pp & 1);
    bf16x4 v[8];
#pragma unroll
    for (int dt = 0; dt < 8; ++dt) v[dt] = tr_read(vbase + 16u * ((unsigned)(2 * dt + (pp >> 1)) ^ (unsigned)gswV(row)));
    asm volatile("s_waitcnt lgkmcnt(0)" : "+v"(v[0]), "+v"(v[1]), "+v"(v[2]), "+v"(v[3]), "+v"(v[4]), "+v"(v[5]), "+v"(v[6]), "+v"(v[7]) :: "memory");
#pragma unroll
    for (int dt = 0; dt < 8; ++dt) { bf16x8 vf; vf[0] = v[dt][0]; vf[1] = v[dt][1]; vf[2] = v[dt][2]; vf[3] = v[dt][3]; vf[4] = v[dt][0]; vf[5] = v[dt][1]; vf[6] = v[dt][2]; vf[7] = v[dt][3];
        O[dt] = __builtin_amdgcn_mfma_f32_16x16x32_bf16(vf, pf, O[dt], 0, 0, 0); }
}

__device__ __forceinline__ void attn_phase(LAS unsigned char* lds, const bf16_t* qkv, const float* qkv_m, const float* q_gain, const float* k_gain, const float* rel_bias,
                                           const float* meta_bias, bf16_t* o, float* o_m, int G, int bid) {
    const int tid = threadIdx.x, wid = __builtin_amdgcn_readfirstlane(tid >> 6), lane = tid & 63, fr = lane & 15, fq = lane >> 4;
    const int UPW = (NB * NH * (GR / 2)) / G;
    const int u0 = bid * UPW, bh = u0 / (GR / 2), b = bh / NH, h = bh % NH;
    const float QSCALE = 0.08838834764831845f * LOG2E;
    if (tid < 256) { const int m = tid >> 4, ch = tid & 15;
        { const f32x4* p = (const f32x4*)(qkv_m + (size_t)m * NQKV + D + h * HD + ch * 8); const f32x4 a = p[0], c = p[1];
          float ss = (a.x * a.x + a.y * a.y) + (a.z * a.z + a.w * a.w) + (c.x * c.x + c.y * c.y) + (c.z * c.z + c.w * c.w);
          ss += __shfl_xor(ss, 1); ss += __shfl_xor(ss, 2); ss += __shfl_xor(ss, 4); ss += __shfl_xor(ss, 8);
          const float r = 1.0f / sqrtf(ss * (1.0f / HD) + RMS_EPS); const f32x4* gp = (const f32x4*)(k_gain + ch * 8); const f32x4 x = a * gp[0] * r, y = c * gp[1] * r;
          u32x4 w; w.x = cvt_pk_bf16(x.x, x.y); w.y = cvt_pk_bf16(x.z, x.w); w.z = cvt_pk_bf16(y.x, y.y); w.w = cvt_pk_bf16(y.z, y.w);
          *(LAS u32x4*)(lds + OFF_KM + m * 256 + ((ch ^ m) << 4)) = w; }
        { const f32x4* p = (const f32x4*)(qkv_m + (size_t)m * NQKV + 2 * D + h * HD + ch * 8); const f32x4 a = p[0], c = p[1];
          u32x4 w; w.x = cvt_pk_bf16(a.x, a.y); w.y = cvt_pk_bf16(a.z, a.w); w.z = cvt_pk_bf16(c.x, c.y); w.w = cvt_pk_bf16(c.z, c.w);
          *(LAS u32x4*)(lds + OFF_VM + m * 256 + ((ch ^ gswV(m)) << 4)) = w; }
        { const f32x4* p = (const f32x4*)(qkv_m + (size_t)m * NQKV + h * HD + ch * 8); const f32x4 a = p[0], c = p[1];
          float ss = (a.x * a.x + a.y * a.y) + (a.z * a.z + a.w * a.w) + (c.x * c.x + c.y * c.y) + (c.z * c.z + c.w * c.w);
          ss += __shfl_xor(ss, 1); ss += __shfl_xor(ss, 2); ss += __shfl_xor(ss, 4); ss += __shfl_xor(ss, 8);
          const float r = QSCALE / sqrtf(ss * (1.0f / HD) + RMS_EPS); const f32x4* gp = (const f32x4*)(q_gain + ch * 8); const f32x4 x = a * gp[0] * r, y = c * gp[1] * r;
          u32x4 w; w.x = cvt_pk_bf16(x.x, x.y); w.y = cvt_pk_bf16(x.z, x.w); w.z = cvt_pk_bf16(y.x, y.y); w.w = cvt_pk_bf16(y.z, y.w);
          *(LAS u32x4*)(lds + OFF_QM + m * 256 + (ch << 4)) = w; }
    }
    { LAS float* bt = (LAS float*)(lds + OFF_BIAS); for (int i = tid; i < 1024; i += NTHREADS) { const int j = i - BIAS_SLACK; bt[i] = (j >= 0 && j < 15 * 31) ? rel_bias[h * 465 + j] * LOG2E : 0.f; }
      if (tid < 16) ((LAS float*)(lds + OFF_MB))[tid] = meta_bias[h * 16 + tid] * LOG2E; }
    __syncthreads();
    float maxbias, KB;
    { const LAS float* bt = (const LAS float*)(lds + OFF_BIAS) + BIAS_SLACK; float mx = -1e30f;
      for (int i = lane; i < 465; i += 64) mx = fmaxf(mx, bt[i]);
      if (lane < 16) mx = fmaxf(mx, ((const LAS float*)(lds + OFF_MB))[lane]);
      maxbias = wave_max(mx);
      KB = wave_max(fmaxf(fabsf(k_gain[lane]), fabsf(k_gain[lane + 64]))) * 11.313708498984761f * 1.01f; }
    const int j = wid & 3, cq = 16 * j + fr, kc0 = (16 * j - 8) < 0 ? 0 : ((16 * j - 8) > 32 ? 32 : (16 * j - 8));
    const int c0 = (cq - 8) < 0 ? 0 : ((cq - 8) > GW - 16 ? GW - 16 : (cq - 8)), dlo = c0 - cq;
    const int cb = kc0 + 8 * fq - cq + 15;
    unsigned vmask = 0u;
#pragma unroll
    for (int t = 0; t < 2; ++t)
#pragma unroll
        for (int i = 0; i < 4; ++i) { const int dc = kc0 + 8 * fq + 4 * t + i - cq; if (dc >= dlo && dc <= dlo + 15) vmask |= 1u << (4 * t + i); }
    unsigned koff[2];
#pragma unroll
    for (int t = 0; t < 2; ++t) { const int key = kc0 + 8 * (fr >> 2) + (fr & 3) + 4 * t; koff[t] = (unsigned)(key * 256) | ((unsigned)swzK(key) << 16); }
    const int tg = lane >> 4, tq = (lane & 15) >> 2, tp = lane & 3;
    unsigned vrow[2], vsw[2];
#pragma unroll
    for (int t = 0; t < 2; ++t) { const int row = kc0 + 8 * tg + 4 * t + tq; vrow[t] = (unsigned)(row * 256 + 8 * (tp & 1)); vsw[t] = (unsigned)gswV(row); }
    unsigned dK[2], dV[2];
#pragma unroll
    for (int ii = 0; ii < 2; ++ii) { const int p = tid + 512 * ii, key = p >> 4, sc = p & 15; dK[ii] = (unsigned)(key * (NQKV * 2) + ((sc ^ swzK(key)) << 4)); dV[ii] = (unsigned)(key * (NQKV * 2) + ((sc ^ gswV(key)) << 4)); }
    const char* kbase = (const char*)qkv + ((size_t)b * SEQ * NQKV + D + h * HD) * 2;
    const unsigned ldsw = (unsigned)wid * 1024u;
#define ATT_ISSUE(krow, slot) do { const char* _s = kbase + (size_t)(krow) * (GW * NQKV * 2); _Pragma("unroll") for (int _i = 0; _i < 2; ++_i) { \
        __builtin_amdgcn_global_load_lds((const unsigned*)(_s + dK[_i]), (LAS unsigned*)(lds + (slot) * SLOT + ldsw + _i * 8192), 16, 0, 0); \
        __builtin_amdgcn_global_load_lds((const unsigned*)(_s + D * 2 + dV[_i]), (LAS unsigned*)(lds + (slot) * SLOT + 16384 + ldsw + _i * 8192), 16, 0, 0); } } while (0)

    if (b == 0 && (bid % (G / (NB * NH))) == 0 && wid == 0) {
        bf16x8 qf[4]; float ssq = 0.f;
#pragma unroll
        for (int ks = 0; ks < 4; ++ks) { qf[ks] = *(const LAS bf16x8*)(lds + OFF_QM + fr * 256 + ((4 * ks + fq) << 4));
#pragma unroll
            for (int e = 0; e < 8; ++e) { const float f = bf2f((unsigned short)qf[ks][e]); ssq += f * f; } }
        ssq += __shfl_xor(ssq, 16); ssq += __shfl_xor(ssq, 32);
        const float Mq = sqrtf(ssq) * KB + maxbias;
        f32x4 O[8]; float lsum = 0.f;
#pragma unroll
        for (int dt = 0; dt < 8; ++dt) O[dt] = (f32x4){0.f, 0.f, 0.f, 0.f};
        meta_step(lds, qf, Mq, O, lsum, fr, fq, lane);
        lsum += __shfl_xor(lsum, 16); lsum += __shfl_xor(lsum, 32);
        const float inv = 1.0f / lsum;
#pragma unroll
        for (int dt = 0; dt < 8; ++dt) *(f32x4*)(o_m + (size_t)fr * D + h * HD + 16 * dt + 4 * fq) = O[dt] * inv;
    }

    int iu = 0, irp = (u0 % (GR / 2)), ilo = r0_of(2 * irp), ihi = r0_of(2 * irp + 1) + 7, ii_ = ilo, gI = 0;
#define ATT_ADV() do { if (++ii_ > ihi) { ++iu; ++irp; if (iu < UPW) { ilo = r0_of(2 * irp); ihi = r0_of(2 * irp + 1) + 7; ii_ = ilo; } } } while (0)
    for (int d = 0; d < 2; ++d) if (iu < UPW) { ATT_ISSUE(ii_, gI % NSLOT); ATT_ADV(); ++gI; }
    int gC = 0;
    for (int ku = 0; ku < UPW; ++ku) {
        const int rp = (u0 % (GR / 2)) + ku, qr = 2 * rp + (wid >> 2), r0w = r0_of(qr), lo = r0_of(2 * rp), hi = r0_of(2 * rp + 1) + 7;
        const size_t qrow = (size_t)b * SEQ + (size_t)qr * GW + cq;
        bf16x8 qf[4]; float ssq = 0.f;
#pragma unroll
        for (int ks = 0; ks < 4; ++ks) { qf[ks] = *(const bf16x8*)(qkv + qrow * NQKV + h * HD + 32 * ks + 8 * fq);
#pragma unroll
            for (int e = 0; e < 8; ++e) { const float f = bf2f((unsigned short)qf[ks][e]); ssq += f * f; } }
        ssq += __shfl_xor(ssq, 16); ssq += __shfl_xor(ssq, 32);
        const float Mq = sqrtf(ssq) * KB + maxbias;
        f32x4 O[8]; float lsum = 0.f;
#pragma unroll
        for (int dt = 0; dt < 8; ++dt) O[dt] = (f32x4){0.f, 0.f, 0.f, 0.f};
        for (int i = lo; i <= hi; ++i) {
            if (gI > gC + 1) asm volatile("s_waitcnt vmcnt(4)" ::: "memory"); else asm volatile("s_waitcnt vmcnt(0)" ::: "memory");
            __builtin_amdgcn_s_barrier();
            if (iu < UPW) { ATT_ISSUE(ii_, gI % NSLOT); ATT_ADV(); ++gI; }
            if (i >= r0w && i <= r0w + 7) {
                const int slot = gC % NSLOT; const int dr = i - qr;
                LAS unsigned char* sk = lds + slot * SLOT;
                f32x4 s[2];
#pragma unroll
                for (int t = 0; t < 2; ++t) { s[t] = (f32x4){0.f, 0.f, 0.f, 0.f};
#pragma unroll
                    for (int ks = 0; ks < 4; ++ks) { const bf16x8 kf = *(const LAS bf16x8*)(sk + (koff[t] & 0xffffu) + ((((unsigned)(4 * ks + fq)) ^ (koff[t] >> 16)) << 4));
                        s[t] = __builtin_amdgcn_mfma_f32_16x16x32_bf16(kf, qf[ks], s[t], 0, 0, 0); } }
                const LAS float* bt = (const LAS float*)(lds + OFF_BIAS) + BIAS_SLACK + (dr + 7) * 31 + cb;
                float p[8];
#pragma unroll
                for (int t = 0; t < 2; ++t)
#pragma unroll
                    for (int e = 0; e < 4; ++e) { const float v = __builtin_amdgcn_exp2f(s[t][e] + bt[4 * t + e] - Mq); p[4 * t + e] = ((vmask >> (4 * t + e)) & 1u) ? v : 0.f; lsum += p[4 * t + e]; }
                u32x4 pw; pw.x = cvt_pk_bf16(p[0], p[1]); pw.y = cvt_pk_bf16(p[2], p[3]); pw.z = cvt_pk_bf16(p[4], p[5]); pw.w = cvt_pk_bf16(p[6], p[7]);
                const bf16x8 pf = __builtin_bit_cast(bf16x8, pw);
                const unsigned vb = (unsigned)(size_t)(sk + 16384);
#pragma unroll
                for (int hb = 0; hb < 2; ++hb) {
                    bf16x4 v0[4], v1[4];
#pragma unroll
                    for (int d4 = 0; d4 < 4; ++d4) { const int dt = 4 * hb + d4;
                        v0[d4] = tr_read(vb + vrow[0] + 16u * (((unsigned)(2 * dt + (tp >> 1))) ^ vsw[0]));
                        v1[d4] = tr_read(vb + vrow[1] + 16u * (((unsigned)(2 * dt + (tp >> 1))) ^ vsw[1])); }
                    asm volatile("s_waitcnt lgkmcnt(0)" : "+v"(v0[0]), "+v"(v0[1]), "+v"(v0[2]), "+v"(v0[3]), "+v"(v1[0]), "+v"(v1[1]), "+v"(v1[2]), "+v"(v1[3]) :: "memory");
#pragma unroll
                    for (int d4 = 0; d4 < 4; ++d4) { bf16x8 vf; vf[0] = v0[d4][0]; vf[1] = v0[d4][1]; vf[2] = v0[d4][2]; vf[3] = v0[d4][3]; vf[4] = v1[d4][0]; vf[5] = v1[d4][1]; vf[6] = v1[d4][2]; vf[7] = v1[d4][3];
                        O[4 * hb + d4] = __builtin_amdgcn_mfma_f32_16x16x32_bf16(vf, pf, O[4 * hb + d4], 0, 0, 0); }
                }
            }
            ++gC;
        }
        meta_step(lds, qf, Mq, O, lsum, fr, fq, lane);
        lsum += __shfl_xor(lsum, 16); lsum += __shfl_xor(lsum, 32);
        const float inv = 1.0f / lsum;
#pragma unroll
        for (int dt = 0; dt < 8; ++dt) { const f32x4 v = O[dt] * (inv * SC_O8);
            *(unsigned*)((unsigned char*)o + qrow * D + h * HD + 16 * dt + 4 * fq) = pk4_i8(v[0], v[1], v[2], v[3]); }
    }
    VM_WAIT();
    __syncthreads();
#undef ATT_ISSUE
#undef ATT_ADV
}
}


constexpr int NPHASES = 17;
struct Args { const float* in[22]; float* out; unsigned char* ws; int ph_lo, ph_hi; };
static_assert(sizeof(Args) == 22 * 8 + 8 + 8 + 8, "Args has no padding");
enum { I_X = 0, I_META, I_ATTN_NORM, I_WQKV, I_QGAIN, I_KGAIN, I_RELBIAS, I_METABIAS, I_WO, I_CONV_NORM, I_WIN, I_CONVW, I_WOUT, I_DENSE_NORM, I_WGATE, I_WUP, I_WDOWN,
       I_MOE_NORM, I_WROUTER, I_MGATE, I_MUP, I_MDOWN };

__global__ void __launch_bounds__(NTHREADS, 2) enc_fwd(Args args) {
    extern __shared__ __attribute__((aligned(16))) unsigned char lds_raw[];
    LAS unsigned char* lds = (LAS unsigned char*)lds_raw;
    const int tid = threadIdx.x, lane = tid & 63, wave = __builtin_amdgcn_readfirstlane(tid >> 6);
    const int G = gridDim.x, bid = blockIdx.x;
    const int gw = bid * NWAVES + wave, NGW = G * NWAVES;
    unsigned char* ws = args.ws;
    unsigned* ctl = (unsigned*)(ws + WS_CTL);
    float* out = args.out;
    bf16_t* XA = (bf16_t*)(ws + WS_XA); bf16_t* BIG = (bf16_t*)(ws + WS_BIG); bf16_t* Y1 = (bf16_t*)(ws + WS_Y1);
    unsigned char* XQ = ws + WS_XQ; unsigned char* ACT8 = ws + WS_BIG;
    float* rs1 = (float*)(ws + WS_RS1); float* rs2 = (float*)(ws + WS_RS2); unsigned char* HB1 = ws + WS_XBUF;
    bf16_t* H1B = (bf16_t*)(ws + WS_H1B); bf16_t* H2B = (bf16_t*)(ws + WS_H2B); bf16_t* H3B = H1B; bf16_t* Y0 = H2B;
    float* qkv_m = (float*)(ws + MT_QKV); float* o_m = (float*)(ws + MT_O); float* h1_m = (float*)(ws + MT_H1); float* act_m = (float*)(ws + MT_GU); float* h2_m = (float*)(ws + MT_H2); float* cgu_m = (float*)(ws + MT_CGU);
    int* tok_e = (int*)(ws + MO_TOKE); float* tok_g = (float*)(ws + MO_TOKG); int* cnt = (int*)(ws + MO_CNT); int* rowinfo = (int*)(ws + MO_ROWINFO); float* rowgate = (float*)(ws + MO_ROWGATE); int* tile_e = (int*)(ws + MO_TILEE);

    if (tid < 2) ((LAS unsigned*)(lds + XBW_OFF))[tid] = 0u;
    __syncthreads();
#if MK_N_LAUNCHES == 1
    XcdBarrier bar = xcd_barrier_post(ctl + CW_BAR, (volatile LAS unsigned*)(lds + XBW_OFF));
#define GRID_BAR() xcd_barrier(bar)
#else
#define GRID_BAR() do { } while (0)
#endif
    const int lo = args.ph_lo, hi = args.ph_hi;
#define IN(k) (lo <= (k) && (k) < hi)
#define SEAM(k) do { if (IN((k) + 1)) GRID_BAR(); } while (0)


    if (IN(0)) {
        LAS float* scr = (LAS float*)(lds + wave * 16896);
        constexpr int I_A = (D / 64) * (NQKV / 64), I_B = (D / 64) * (D / 64), I_F = (D / 64) * (FF / 64), I_Dn = (FF / 64) * (D / 64);
        static_assert(I_F == I_Dn, "items");
        constexpr int NITEMS = 2 * I_A + 2 * I_B + 3 * I_F + 3 * NE * I_F;
        for (int it = gw; it < NITEMS; it += NGW) {
            int r = it;
            if (r < I_A) { p0_matrix_i8(args.in[I_WQKV], D, NQKV, ws + W_QKV8, -1, SC_W8, r, scr, lane, nullptr); continue; } r -= I_A;
            if (r < I_B) { p0_matrix_i8(args.in[I_WO], D, D, ws + W_O8, -1, SC_W8, r, scr, lane, nullptr); continue; } r -= I_B;
            if (r < I_F) { p0_matrix_i8(args.in[I_WGATE], D, FF, ws + W_GU8, 0, SC_W8, r, scr, lane, args.in[I_DENSE_NORM]); continue; } r -= I_F;
            if (r < I_F) { p0_matrix_i8(args.in[I_WUP], D, FF, ws + W_GU8, 1, SC_W8, r, scr, lane, args.in[I_DENSE_NORM]); continue; } r -= I_F;
            if (r < I_F) { const int nblk = D / 64, kb = (r / (4 * nblk)) * 4 + (r & 3), nb = (r >> 2) % nblk;
                p0_item_dn<8>(args.in[I_WDOWN], FF, D, (bf16_t*)(ws + W_DN), ws + W_DN8, SC_WDR, 64 * kb, 64 * nb, scr, lane); continue; } r -= I_F;
            if (r < I_A) {
                const int nblk = NQKV / 64, kb = (r / (4 * nblk)) * 4 + (r & 3), nb = (r >> 2) % nblk, n0 = 64 * nb; int drow0;
                if (n0 < D) drow0 = n0; else { const int part = (n0 - D) / D, zc = (n0 - D) % D; drow0 = D + (zc / 128) * 256 + part * 128 + (zc % 128); }
                p0_transpose_item_i8(args.in[I_WIN], D, NQKV, ws + W_IN, 64 * kb, n0, drow0, SC_W8, scr, lane, args.in[I_CONV_NORM]); continue; } r -= I_A;
            if (r < I_B) { const int nblk = D / 64, kb = (r / (4 * nblk)) * 4 + (r & 3), nb = (r >> 2) % nblk;
                p0_item_dn<32>(args.in[I_WOUT], D, D, nullptr, ws + W_OUT, SC_W8, 64 * kb, 64 * nb, scr, lane); continue; } r -= I_B;
            { const int which = r / (NE * I_F), rr = r % (NE * I_F), e = rr / I_F, ri = rr % I_F;
              if (which == 0) p0_matrix_i8(args.in[I_MGATE] + (size_t)e * D * FF, D, FF, ws + W_MGU + (size_t)e * NGU * D, 0, SC_W8, ri, scr, lane, nullptr);
              else if (which == 1) p0_matrix_i8(args.in[I_MUP] + (size_t)e * D * FF, D, FF, ws + W_MGU + (size_t)e * NGU * D, 1, SC_W8, ri, scr, lane, nullptr);
              else p0_matrix8(args.in[I_MDOWN] + (size_t)e * FF * D, FF, D, ws + W_MDN + (size_t)e * D * FF, -1, SC_WDN, ri, scr, lane); }
        }
        rms_rows_to_i8(args.in[I_X], args.in[I_ATTN_NORM], (unsigned char*)XA, gw, NGW, M, lane);
        SEAM(0);
    }
    if (IN(1)) {
        { pg8::Gemm g{XA, ws + W_QKV8, D}; pg8::StaticOrder S; S.init(M, NQKV, G, bid); pg8::EpiQKV E{BIG, NQKV, 1.0f / (SC_A8 * SC_W8), args.in[I_QGAIN], args.in[I_KGAIN], (LAS float*)(lds + MISC_OFF)};
          pg8::gemm_phase<pg8::EpiQKV, pg8::StaticOrder, 8>(lds, g, S, E); }
        { LAS float* rs = (LAS float*)(lds + 8192); meta_rstd(args.in[I_META], rs, wave, lane);
          FNorm A{args.in[I_META], args.in[I_ATTN_NORM], rs, D}; EStoreC<3> E{qkv_m, NQKV};
          meta_gemm_mc<1, 3>(ws + W_QKV8, D, NQKV / 3, 1.0f / SC_W8, A, CMCons<3>{}, E, gw, NGW, lane); }
        SEAM(1);
    }
    if (IN(3)) {
        att::attn_phase(lds, BIG, qkv_m, args.in[I_QGAIN], args.in[I_KGAIN], args.in[I_RELBIAS], args.in[I_METABIAS], XA, o_m, G, bid);
        SEAM(3);
    }
    if (IN(4)) {
        { pg8::Gemm g{XA, ws + W_O8, D}; pg8::StaticOrder S; S.init(M, D, G, bid); pg8::EpiResidNormB<false> E{args.in[I_X], H1B, HB1, rs1, D, (LAS float*)(lds + MISC_OFF), 1.0f / (SC_O8 * SC_W8), SC_A8};
          pg8::gemm_phase<pg8::EpiResidNormB<false>, pg8::StaticOrder, 8>(lds, g, S, E); }
        { FCvt A{o_m, D}; EResidC<1> E{args.in[I_META], h1_m, D}; meta_gemm_mc<1, 1>(ws + W_O8, D, D, 1.0f / SC_W8, A, CMCons<1>{}, E, gw, NGW, lane); }
        SEAM(4);
    }
    if (IN(6)) {
        { pg8::Gemm g{HB1, ws + W_GU8, D}; pg8::StaticOrder S; S.init(M, NGU, G, bid); pg8::EpiSwiGLU E{(unsigned char*)BIG, FF, rs1, 1.0f / (SC_A8 * SC_W8), (LAS float*)(lds + MISC_OFF)};
          pg8::gemm_phase<pg8::EpiSwiGLU, pg8::StaticOrder, 8>(lds, g, S, E); }
        { LAS float* rs = (LAS float*)(lds + 8192); meta_rstd(h1_m, rs, wave, lane);
          FNorm A{h1_m, nullptr, rs, D}; ESiluAct E{act_m}; meta_gemm_mc<1, 8>(ws + W_GU8, D, FF / 4, 1.0f / SC_W8, A, CMGateUp{}, E, gw, NGW, lane); }
        SEAM(6);
    }
    if (IN(7)) {
        { pg8::Gemm g{BIG, ws + W_DN8, FF}; pg8::StaticOrder S; S.init(M, D, G, bid); pg8::EpiResidNormB<true> E{H1B, H2B, (unsigned char*)XA, rs2, D, (LAS float*)(lds + MISC_OFF), 1.0f / (SC_ACTR * SC_WDR), SC_A8B};
          pg8::gemm_phase<pg8::EpiResidNormB<true>, pg8::StaticOrder, 8>(lds, g, S, E); }
        if (wave < 4) { FCvt A{act_m, FF}; EResidC<2> E{h1_m, h2_m, D}; meta_gemm_mc<0, 2>(ws + W_DN, FF, D / 2, 1.0f, A, CMCons<2>{}, E, bid * 4 + wave, G * 4, lane); }
        SEAM(7);
    }
    if (IN(9)) {
        { pg8::Gemm g{XA, ws + W_IN, D}; pg8::StaticOrder S; S.init(M, NQKV, G, bid); pg8::EpiWin E{BIG, 2 * D, rs2, 1.0f / (SC_A8B * SC_W8), (LAS float*)(lds + MISC_OFF)};
          pg8::gemm_phase<pg8::EpiWin, pg8::StaticOrder, 8>(lds, g, S, E); }
        { LAS float* rs = (LAS float*)(lds + 8192); meta_rstd(h2_m, rs, wave, lane);
          FNorm A{h2_m, nullptr, rs, D}; EStoreC<2> E{cgu_m, 2 * D}; meta_gemm_mc<1, 2>(ws + W_IN + (size_t)D * D, D, D, 1.0f / SC_W8, A, CMCons<2>{}, E, gw, NGW, lane); }
        SEAM(9);
    }
    if (IN(10)) {
        const int cc = tid & 255, half = tid >> 8;
        const float* cw = args.in[I_CONVW] + (size_t)cc * 8 * 3;
        float w0[8], w1[8], w2[8];
#pragma unroll
        for (int e = 0; e < 8; ++e) { w0[e] = cw[3 * e]; w1[e] = cw[3 * e + 1]; w2[e] = cw[3 * e + 2]; }
        const int RPW = M / G;
        const int m0 = bid * RPW + half * (RPW / 2), m1 = m0 + RPW / 2;
#define ldz(m_, z_) ld8bf(BIG + (size_t)(m_) * (2 * D) + D + cc * 8, z_)
        float zp[8], zc[8], zn[8];
        if ((m0 % SEQ) == 0) { const float* gp = cgu_m + (size_t)15 * (2 * D) + (cc * 8 / 128) * 256 + (cc * 8 % 128);
#pragma unroll
            for (int e = 0; e < 8; ++e) zp[e] = gp[e] * gp[128 + e]; }
        else ldz(m0 - 1, zp);
        ldz(m0, zc);
        for (int m = m0; m < m1; m += 4) {
            u32x4 zw[4], bw[4];
#pragma unroll
            for (int i = 0; i < 4; ++i) { const int mm = m + 1 + i, mc = mm < M ? mm : M - 1; zw[i] = *(const u32x4*)(BIG + (size_t)mc * (2 * D) + D + cc * 8);
                if ((mm % SEQ) == 0) zw[i] = (u32x4){0u, 0u, 0u, 0u}; }
#pragma unroll
            for (int i = 0; i < 4; ++i) bw[i] = *(const u32x4*)(BIG + (size_t)(m + i) * (2 * D) + cc * 8);
#pragma unroll
            for (int i = 0; i < 4; ++i) {
                zn[0] = bflo(zw[i].x); zn[1] = bfhi(zw[i].x); zn[2] = bflo(zw[i].y); zn[3] = bfhi(zw[i].y); zn[4] = bflo(zw[i].z); zn[5] = bfhi(zw[i].z); zn[6] = bflo(zw[i].w); zn[7] = bfhi(zw[i].w);
                const float bg[8] = {bflo(bw[i].x), bfhi(bw[i].x), bflo(bw[i].y), bfhi(bw[i].y), bflo(bw[i].z), bfhi(bw[i].z), bflo(bw[i].w), bfhi(bw[i].w)};
                float y[8];
#pragma unroll
                for (int e = 0; e < 8; ++e) y[e] = bg[e] * (zp[e] * w0[e] + zc[e] * w1[e] + zn[e] * w2[e]);
                wht_inlane8(y);
#pragma unroll
                for (int e = 0; e < 8; ++e) { const float o = __shfl_xor(y[e], 1); y[e] = (cc & 1) ? o - y[e] : y[e] + o; }
#pragma unroll
                for (int e = 0; e < 8; ++e) { const float o = __shfl_xor(y[e], 2); y[e] = ((cc & 2) ? o - y[e] : y[e] + o) * (SC_YR * 0.17677669529663687f); }
                u32x2 o; o.x = pk4_i8(y[0], y[1], y[2], y[3]); o.y = pk4_i8(y[4], y[5], y[6], y[7]);
                *(u32x2*)((unsigned char*)XA + (size_t)(m + i) * D + cc * 8) = o;
#pragma unroll
                for (int e = 0; e < 8; ++e) { zp[e] = zc[e]; zc[e] = zn[e]; }
            }
        }
#undef ldz
        SEAM(10);
    }
    if (IN(11)) {
        { pg8::Gemm g{XA, ws + W_OUT, D}; pg8::StaticOrder S; S.init(M, D, G, bid); pg8::EpiResidB E{H2B, H3B, D, 1.0f / (SC_YR * SC_W8)};
          pg8::gemm_phase<pg8::EpiResidB, pg8::StaticOrder, 8>(lds, g, S, E); }
        SEAM(11);
    }
    if (IN(12)) {
        LAS float* wr_t = (LAS float*)lds;
        LAS int* lcnt = (LAS int*)(lds + 65536);
        for (int i = tid; i < D * NE; i += NTHREADS) { const int k = i >> 3, e = i & 7; wr_t[e * D + k] = args.in[I_WROUTER][i]; }
        if (tid < 8) lcnt[tid] = 0;
        __syncthreads();
        const int RPW = M / G, RPV = RPW / NWAVES;
        u32x4 vn[4];
        { const bf16_t* xr0 = H3B + (size_t)(bid * RPW + wave * RPV) * D;
#pragma unroll
          for (int j = 0; j < 4; ++j) vn[j] = *(const u32x4*)(xr0 + 8 * (lane + 64 * j)); }
        for (int rr = 0; rr < RPV; ++rr) {
            const int m = bid * RPW + wave * RPV + rr;
            const float* gain = args.in[I_MOE_NORM];
            f32x4 v[4][2]; float s = 0.f;
#pragma unroll
            for (int j = 0; j < 4; ++j) { v[j][0] = (f32x4){bflo(vn[j].x), bfhi(vn[j].x), bflo(vn[j].y), bfhi(vn[j].y)}; v[j][1] = (f32x4){bflo(vn[j].z), bfhi(vn[j].z), bflo(vn[j].w), bfhi(vn[j].w)}; }
            if (rr + 1 < RPV) { const bf16_t* xr1 = H3B + (size_t)(m + 1) * D;
#pragma unroll
                for (int j = 0; j < 4; ++j) vn[j] = *(const u32x4*)(xr1 + 8 * (lane + 64 * j)); }
#pragma unroll
            for (int j = 0; j < 4; ++j)
                s += (v[j][0].x * v[j][0].x + v[j][0].y * v[j][0].y) + (v[j][0].z * v[j][0].z + v[j][0].w * v[j][0].w) + (v[j][1].x * v[j][1].x + v[j][1].y * v[j][1].y) + (v[j][1].z * v[j][1].z + v[j][1].w * v[j][1].w);
            const float rstd = 1.0f / sqrtf(wave_sum(s) * (1.0f / D) + RMS_EPS);
            float lg[8];
#pragma unroll
            for (int e = 0; e < 8; ++e) lg[e] = 0.f;
#pragma unroll
            for (int j = 0; j < 4; ++j) { const f32x4* gp = (const f32x4*)(gain + 8 * (lane + 64 * j)); const f32x4 a = v[j][0] * rstd * gp[0], b = v[j][1] * rstd * gp[1];
                u32x2 w; w.x = pk4_i8(a.x * SC_A8, a.y * SC_A8, a.z * SC_A8, a.w * SC_A8); w.y = pk4_i8(b.x * SC_A8, b.y * SC_A8, b.z * SC_A8, b.w * SC_A8);
                *(u32x2*)(XQ + (size_t)m * D + 8 * (lane + 64 * j)) = w;
#pragma unroll
                for (int e = 0; e < 8; ++e) { const LAS f32x4* wp = (const LAS f32x4*)(wr_t + e * D + 8 * (lane + 64 * j)); const f32x4 w0 = wp[0], w1 = wp[1];
                    lg[e] += (a.x * w0.x + a.y * w0.y) + (a.z * w0.z + a.w * w0.w) + (b.x * w1.x + b.y * w1.y) + (b.z * w1.z + b.w * w1.w); } }
#pragma unroll
            for (int e = 0; e < 8; ++e) lg[e] = wave_sum(lg[e]);
            int e0 = 0; float l0 = lg[0];
#pragma unroll
            for (int e = 1; e < 8; ++e) if (lg[e] > l0) { l0 = lg[e]; e0 = e; }
            int e1 = -1; float l1 = -3.0e38f;
#pragma unroll
            for (int e = 0; e < 8; ++e) if (e != e0 && lg[e] > l1) { l1 = lg[e]; e1 = e; }
            const float g0 = 1.0f / (1.0f + __expf(l1 - l0)), g1 = 1.0f - g0;
            if (lane == 0) { tok_e[2 * m] = e0; tok_e[2 * m + 1] = e1; tok_g[2 * m] = g0; tok_g[2 * m + 1] = g1; lds_add(&lcnt[e0], 1); lds_add(&lcnt[e1], 1); }
        }
        __syncthreads();
        if (tid < 8) cnt[bid * 8 + tid] = lcnt[tid];
        SEAM(12);
    }
    if (IN(13)) {
        LAS int* tot = (LAS int*)lds; LAS int* pre = tot + 8; LAS int* start = tot + 16; LAS int* wcnt = tot + 32;
        if (tid < 16) tot[tid] = 0;
        __syncthreads();
        if (tid < 256) { const i32x4 a = *(const i32x4*)(cnt + tid * 8), c = *(const i32x4*)(cnt + tid * 8 + 4);
            const int v[8] = {a.x, a.y, a.z, a.w, c.x, c.y, c.z, c.w};
#pragma unroll
            for (int e = 0; e < 8; ++e) { lds_add(&tot[e], v[e]); if (tid < bid) lds_add(&pre[e], v[e]); } }
        __syncthreads();
        if (tid == 0) { int s = 0; for (int e = 0; e < 8; ++e) { start[e] = s; s += (tot[e] + 255) / 256 * 256; } start[8] = s; }
        __syncthreads();
        const int RPW = M / G;
        int my_e = 0, my_tok = 0, my_k = 0; float my_g = 0.f;
        if (tid < 2 * RPW) { my_tok = bid * RPW + (tid >> 1); my_k = tid & 1; my_e = tok_e[2 * my_tok + my_k]; my_g = tok_g[2 * my_tok + my_k]; }
        int rank_in_wave = 0;
        if (tid < 2 * RPW) {
#pragma unroll
            for (int e = 0; e < 8; ++e) { const unsigned long long mk = __ballot(my_e == e); if (my_e == e) rank_in_wave = __popcll(mk & ((1ull << lane) - 1ull)); if (lane == 0) wcnt[wave * 8 + e] = __popcll(mk); }
        }
        __syncthreads();
        if (tid < 2 * RPW) { int r = start[my_e] + pre[my_e] + rank_in_wave; for (int w = 0; w < wave; ++w) r += wcnt[w * 8 + my_e];
            rowinfo[r] = my_tok | (my_k << 16); rowgate[r] = my_g; }
        if (bid == 0) {
            for (int e = 0; e < 8; ++e) { const int a = start[e] + tot[e], z = start[e + 1]; for (int r = a + tid; r < z; r += NTHREADS) { rowinfo[r] = -1; rowgate[r] = 0.f; } }
            const int nt = start[8] / 256;
            for (int t = tid; t < nt; t += NTHREADS) { int e = 0; while (e < 7 && t * 256 >= start[e + 1]) ++e; tile_e[t] = e; }
            if (tid == 0) ctl[CW_NTILES] = (unsigned)nt;
        }
        __syncthreads();
        SEAM(13);
    }
    if (IN(14)) {
        const int ntl = (int)__builtin_amdgcn_readfirstlane(ld_agent(ctl + CW_NTILES));
        LAS int* te = (LAS int*)(lds + MISC_OFF + 16384);
        for (int i = tid; i < ntl; i += NTHREADS) te[i] = tile_e[i];
        __syncthreads();
        if (ntl > 0) { pg8::Gemm g{XQ, ws + W_MGU, D}; pg8::MoeGatherOrder S{ntl, NGU / 256, G, bid, 0, te, false, rowinfo, lds + MISC_OFF}; pg8::EpiSwiGLU8 E{ACT8, FF};
            pg8::gemm_phase<pg8::EpiSwiGLU8, pg8::MoeGatherOrder, 8>(lds, g, S, E); }
        SEAM(14);
    }
    if (IN(15)) {
        const int ntl = (int)__builtin_amdgcn_readfirstlane(ld_agent(ctl + CW_NTILES));
        LAS int* te = (LAS int*)(lds + MISC_OFF + 16384);
        for (int i = tid; i < ntl; i += NTHREADS) te[i] = tile_e[i];
        __syncthreads();
        if (ntl > 0) { pg8::Gemm g{ACT8, ws + W_MDN, FF}; pg8::MoeOrder S{ntl, D / 256, G, bid, 0, te, true, nullptr, nullptr}; pg8::EpiMoeDown E{Y0, Y1, rowinfo, rowgate, 1.0f / (SC_ACT * SC_WDN)};
            pg8::gemm_phase<pg8::EpiMoeDown, pg8::MoeOrder, 0>(lds, g, S, E); }
        SEAM(15);
    }
    if (IN(16)) {
        const size_t n8 = (size_t)M * D / 8;
        for (size_t i = (size_t)bid * NTHREADS + tid; i < n8; i += (size_t)G * NTHREADS) {
            const u32x4 h = *(const u32x4*)(H3B + i * 8), w0 = *(const u32x4*)(Y0 + i * 8), w1 = *(const u32x4*)(Y1 + i * 8); f32x4* o = (f32x4*)(out + i * 8);
            f32x4 a, b;
            a.x = bflo(h.x) + (bflo(w0.x) + bflo(w1.x)); a.y = bfhi(h.x) + (bfhi(w0.x) + bfhi(w1.x)); a.z = bflo(h.y) + (bflo(w0.y) + bflo(w1.y)); a.w = bfhi(h.y) + (bfhi(w0.y) + bfhi(w1.y));
            b.x = bflo(h.z) + (bflo(w0.z) + bflo(w1.z)); b.y = bfhi(h.z) + (bfhi(w0.z) + bfhi(w1.z)); b.z = bflo(h.w) + (bflo(w0.w) + bflo(w1.w)); b.w = bfhi(h.w) + (bfhi(w0.w) + bfhi(w1.w));
            o[0] = a; o[1] = b;
        }
    }
#undef IN
#undef SEAM
}

extern "C" void kernel_launch(void* const* d_in, const int* in_sizes, int n_in, void* d_out, int out_size, void* d_ws, size_t ws_size, hipStream_t stream) {
    static int grid = 0;
    if (grid == 0) {
        if (n_in != 22 || in_sizes[0] != M * D || out_size != M * D || ws_size < WS_END) {
            fprintf(stderr, "kernel_launch: unexpected shapes (n_in %d, in0 %d, out %d, ws %zu < %zu); nothing launched\n", n_in, n_in > 0 ? in_sizes[0] : -1, out_size, ws_size, (size_t)WS_END); grid = -1; return; }
        int dev = 0, cus = 0, per_cu = 0;
        if (hipGetDevice(&dev) != hipSuccess || hipDeviceGetAttribute(&cus, hipDeviceAttributeMultiprocessorCount, dev) != hipSuccess) { grid = -1; return; }
        if (hipFuncSetAttribute((const void*)enc_fwd, hipFuncAttributeMaxDynamicSharedMemorySize, LDS_BYTES) != hipSuccess) { fprintf(stderr, "kernel_launch: hipFuncSetAttribute failed\n"); grid = -1; return; }
        if (hipOccupancyMaxActiveBlocksPerMultiprocessor(&per_cu, (const void*)enc_fwd, NTHREADS, LDS_BYTES) != hipSuccess || per_cu < 1)
            fprintf(stderr, "kernel_launch: note: occupancy query reports %d workgroups per CU\n", per_cu);
        (void)hipGetLastError();
        grid = cus;
        if (grid != 256) { fprintf(stderr, "kernel_launch: built for 256 CUs, device has %d; nothing launched\n", cus); grid = -1; return; }
    }
    if (grid < 0) return;
    if (hipMemsetAsync((char*)d_ws + WS_CTL, 0, CTL_ZERO_BYTES, stream) != hipSuccess) return;
    Args a{};
    for (int i = 0; i < 22; ++i) a.in[i] = (const float*)d_in[i];
    a.out = (float*)d_out; a.ws = (unsigned char*)d_ws;
#if MK_N_LAUNCHES == 1
    a.ph_lo = 0; a.ph_hi = NPHASES;
    hipLaunchKernelGGL(enc_fwd, dim3(grid), dim3(NTHREADS), LDS_BYTES, stream, a);
#else
    for (int p = 0; p < NPHASES; ++p) { a.ph_lo = p; a.ph_hi = p + 1; hipLaunchKernelGGL(enc_fwd, dim3(grid), dim3(NTHREADS), LDS_BYTES, stream, a);
    }
#endif
}
```

```cpp
#include <hip/hip_runtime.h>
#include <cstdio>
#include <cstdint>

#ifndef MK_N_LAUNCHES
#define MK_N_LAUNCHES 1
#endif

#define LAS __attribute__((address_space(3)))
#define GAS __attribute__((address_space(1)))
typedef unsigned short bf16_t;
typedef short bf16x8 __attribute__((ext_vector_type(8)));
typedef short bf16x4 __attribute__((ext_vector_type(4)));
typedef float f32x4 __attribute__((ext_vector_type(4)));
typedef float f32x2 __attribute__((ext_vector_type(2)));
typedef unsigned u32x4 __attribute__((ext_vector_type(4)));
typedef unsigned u32x2 __attribute__((ext_vector_type(2)));
typedef int i32x4 __attribute__((ext_vector_type(4)));
typedef int i32x8 __attribute__((ext_vector_type(8)));

constexpr int D = 2048, NB = 2, SEQ = 16384, M = NB * SEQ, NMETA = 16, NH = 16, HD = 128, GW = 64, GR = 256;
constexpr int FF = 7168, NE = 8, NQKV = 3 * D, NGU = 2 * FF;
constexpr float RMS_EPS = 1e-6f;
constexpr float LOG2E = 1.4426950408889634f;
constexpr int NWAVES = 8, NTHREADS = 512;
constexpr int MAXTILES = 264;

constexpr size_t MiB = 1u << 20;
constexpr size_t WS_CTL = 0, CTL_ZERO_BYTES = 64 * 1024;
constexpr size_t WS_META = 1 * MiB;
constexpr size_t MT_QKV = WS_META, MT_O = MT_QKV + 16 * NQKV * 4, MT_H1 = MT_O + 16 * D * 4, MT_GU = MT_H1 + 16 * D * 4, MT_H2 = MT_GU + 16 * NGU * 4,
                 MT_CGU = MT_H2 + 16 * D * 4, MT_END = MT_CGU + 16 * 2 * D * 4;
static_assert(MT_END <= 3 * MiB, "meta scratch");
constexpr size_t WS_RS1 = 5 * MiB + 512 * 1024, WS_RS2 = WS_RS1 + (size_t)M * 8 * 4;
constexpr size_t WS_MOE = 4 * MiB;
constexpr size_t MO_TOKE = WS_MOE, MO_TOKG = MO_TOKE + (size_t)M * 8, MO_CNT = MO_TOKG + (size_t)M * 8, MO_ROWINFO = MO_CNT + 256 * 8 * 4,
                 MO_ROWGATE = MO_ROWINFO + (size_t)MAXTILES * 256 * 4, MO_TILEE = MO_ROWGATE + (size_t)MAXTILES * 256 * 4, MO_END = MO_TILEE + 2048;
static_assert(MO_END <= 5 * MiB + 512 * 1024, "moe tables");
constexpr size_t WS_WB = 8 * MiB;
constexpr size_t W_QKV = WS_WB, W_O = W_QKV + (size_t)NQKV * D * 2, W_GU = W_O + (size_t)D * D * 2, W_DN = W_GU + (size_t)NGU * D * 2,
                 W_IN = W_DN + (size_t)D * FF * 2, W_OUT = W_IN + (size_t)NQKV * D * 2, W_MGU = W_OUT + (size_t)D * D * 2, W_MDN = W_MGU + (size_t)NE * NGU * D,
                 W_END = W_MDN + (size_t)NE * D * FF;
static_assert(W_END == (8 + 148 + 336) * MiB, "weights");
constexpr size_t WS_XA = W_END;
constexpr size_t WS_BIG = WS_XA + (size_t)M * D * 2;
constexpr size_t WS_XBUF = WS_BIG + (size_t)MAXTILES * 256 * FF;
constexpr size_t W_QKV8 = WS_XBUF + (size_t)MAXTILES * 256 * D;
constexpr size_t W_O8 = W_QKV8 + (size_t)NQKV * D;
constexpr size_t W_GU8 = W_O8 + (size_t)D * D;
constexpr size_t WS_H1B = W_GU8 + (size_t)NGU * D;
constexpr size_t WS_H2B = WS_H1B + (size_t)M * D * 2;
constexpr size_t W_DN8 = WS_H2B + (size_t)M * D * 2;
constexpr size_t WS_END = W_DN8 + (size_t)D * FF;
static_assert((size_t)MAXTILES * 256 * FF >= (size_t)M * FF * 2, "BIG holds the dense act too");
constexpr size_t WS_XQ = WS_XA + (size_t)M * D;
constexpr size_t WS_Y1 = WS_XA;

constexpr int CW_TMO = 0, CW_NTILES = 64, CW_BAR = 4096;

constexpr int RING_BYTES = 131072;
constexpr int MISC_OFF = RING_BYTES;
constexpr int LDS_BYTES = 163840 - 1024;
constexpr int XBW_OFF = LDS_BYTES - 64;

#define RLX_AGENT __ATOMIC_RELAXED, __HIP_MEMORY_SCOPE_AGENT
#define LDS_WAIT() asm volatile("s_waitcnt lgkmcnt(0)" ::: "memory")
#define VM_WAIT() asm volatile("s_waitcnt vmcnt(0)" ::: "memory")
typedef __bf16 bf16v2 __attribute__((ext_vector_type(2)));
__device__ __forceinline__ unsigned cvt_pk_bf16(float lo, float hi) { const f32x2 v = (f32x2){lo, hi}; return __builtin_bit_cast(unsigned, __builtin_convertvector(v, bf16v2)); }
__device__ __forceinline__ float bf2f(unsigned short b) { return __builtin_bit_cast(float, (unsigned)b << 16); }
__device__ __forceinline__ float bflo(unsigned w) { return __builtin_bit_cast(float, w << 16); }
__device__ __forceinline__ float bfhi(unsigned w) { return __builtin_bit_cast(float, w & 0xffff0000u); }
__device__ __forceinline__ float wave_sum(float v) {
#pragma unroll
    for (int o = 1; o < 64; o <<= 1) v += __shfl_xor(v, o);
    return v;
}
__device__ __forceinline__ float wave_max(float v) {
#pragma unroll
    for (int o = 1; o < 64; o <<= 1) v = fmaxf(v, __shfl_xor(v, o));
    return v;
}
__device__ __forceinline__ void ld8bf(const bf16_t* p, float (&z)[8]) { const u32x4 w = *(const u32x4*)p;
    z[0] = bflo(w.x); z[1] = bfhi(w.x); z[2] = bflo(w.y); z[3] = bfhi(w.y); z[4] = bflo(w.z); z[5] = bfhi(w.z); z[6] = bflo(w.w); z[7] = bfhi(w.w); }
__device__ __forceinline__ void lds_add(LAS int* p, int v) { __hip_atomic_fetch_add((int*)p, v, __ATOMIC_RELAXED, __HIP_MEMORY_SCOPE_WORKGROUP); }
__device__ __forceinline__ unsigned ld_agent(const unsigned* p) { return __hip_atomic_load(p, RLX_AGENT); }
__device__ __forceinline__ float ld_agent_f(const float* p) { return __builtin_bit_cast(float, __hip_atomic_load((const unsigned*)p, RLX_AGENT)); }
__device__ __forceinline__ int ld_agent_i(const int* p) { return (int)__hip_atomic_load((const unsigned*)p, RLX_AGENT); }


constexpr float SC_ACT = 8.f, SC_WDN = 64.f;
__device__ __forceinline__ float sat8(float v) { return __builtin_amdgcn_fmed3f(v, -448.f, 448.f); }
__device__ __forceinline__ unsigned pk4_fp8(float a, float b, float c, float d) { int w = 0; w = __builtin_amdgcn_cvt_pk_fp8_f32(sat8(a), sat8(b), w, false); w = __builtin_amdgcn_cvt_pk_fp8_f32(sat8(c), sat8(d), w, true); return (unsigned)w; }

constexpr float SC_A8B = 24.f;
constexpr float SC_A8 = 28.f, SC_W8 = 1536.f;
constexpr float SC_O8 = 160.f;
constexpr float SC_YR = 20.f;
constexpr float SC_ACTR = 32.f, SC_WDR = 2880.f;
__device__ __forceinline__ void wht_inlane8(float (&v)[8]) {
#pragma unroll
    for (int h = 1; h < 8; h <<= 1)
#pragma unroll
        for (int i = 0; i < 8; ++i) if ((i & h) == 0) { const float a = v[i], b = v[i + h]; v[i] = a + b; v[i + h] = a - b; }
}
__device__ __forceinline__ unsigned q8m(float v) { const float MG = 12582912.f; return __builtin_bit_cast(unsigned, __builtin_amdgcn_fmed3f(v + MG, MG - 127.f, MG + 127.f)); }
__device__ __forceinline__ unsigned pk4_i8(float a, float b, float c, float d) {
    const unsigned lo = __builtin_amdgcn_perm(q8m(b), q8m(a), 0x0c0c0400u), hi = __builtin_amdgcn_perm(q8m(d), q8m(c), 0x0c0c0400u);
    return __builtin_amdgcn_perm(hi, lo, 0x05040100u); }

namespace pg8 {
constexpr int BM = 256, BK = 64, HALF = 128, HTB = HALF * BK * 2, STAGE_BYTES = 8 * HTB, NXCD = 8;
__host__ __device__ __forceinline__ int lds_byte(int r, int c) { const int st = (r >> 4) * 2 + (c >> 5), rr = r & 15, cc = c & 31, ob = rr * 64 + cc * 2; return st * 1024 + (ob ^ (((ob >> 9) & 1) << 5)); }
__host__ __device__ __forceinline__ void stage_rc(int b, int& R, int& C) { const int st = b / 1024, sb = b % 1024, swz = sb ^ (((sb >> 9) & 1) << 5); R = (st >> 1) * 16 + swz / 64; C = (st & 1) * 32 + (swz % 64) / 2; }
__host__ __device__ __forceinline__ int perm32(int rho) { const int n = rho >> 4, i = rho & 15; return 8 * (i >> 2) + 4 * n + (i & 3); }

struct Unit { int pm, pn, pb, po, ui; };
struct Gemm { const void* A; const void* Bt; int KB; };

__device__ __forceinline__ bool tile_of(int i, int G, int c, int nM, int nN, int& pm, int& pn) {
    const int WGM = nN <= 24 ? 4 : 8;
    const int nwg = nM * nN; const long L = (long)i * G + c; if (L >= nwg) return false;
    int wgid = (int)L; { const int q = nwg / NXCD, r = nwg % NXCD, xcd = wgid % NXCD, off = wgid / NXCD; wgid = (xcd < r ? xcd * (q + 1) : r * (q + 1) + (xcd - r) * q) + off; }
    const int nig = WGM * nN, gid = wgid / nig, fm = gid * WGM, gsz = (nM - fm) < WGM ? (nM - fm) : WGM;
    pm = fm + ((wgid % nig) % gsz); pn = (wgid % nig) / gsz; return true;
}
struct StaticOrder {
    static constexpr bool GATHER = false;
    int nM, nN, G, c;
    __device__ __forceinline__ void init(int M_, int N_, int G_, int c_) { nM = M_ / BM; nN = N_ / BM; G = G_; c = c_; }
    __device__ __forceinline__ bool next(int i, Unit& u) const { int pm, pn; if (!tile_of(i, G, c, nM, nN, pm, pn)) return false; u.pm = pm; u.pn = pn; u.pb = pn; u.po = pm; return true; }
};
__device__ __forceinline__ int lds_ld_i32(unsigned addr) { int r; asm volatile("ds_read_b32 %0, %1\n\ts_waitcnt lgkmcnt(0)" : "=v"(r) : "v"(addr) : "memory"); return r; }
template <bool GA> struct MoeOrderT {
    static constexpr bool GATHER = GA;
    int nM, nN, G, c, t0; LAS const int* tile_e; bool a_local; const int* rowinfo; LAS unsigned char* gl;
    __device__ __forceinline__ bool next(int i, Unit& u) const {
        int pm, pn; if (!tile_of(i, G, c, nM, nN, pm, pn)) return false;
        const int e = __builtin_amdgcn_readfirstlane(lds_ld_i32((unsigned)(size_t)(tile_e + t0 + pm)));
        u.pn = pn; u.pb = e * nN + pn; u.pm = a_local ? pm : t0 + pm; u.po = a_local ? t0 + pm : pm; return true; }
    __device__ __forceinline__ bool row_tile(int i, int& tile) const { int pm, pn; if (!tile_of(i, G, c, nM, nN, pm, pn)) return false; tile = t0 + pm; return true; }
};
typedef MoeOrderT<false> MoeOrder;
typedef MoeOrderT<true> MoeGatherOrder;

struct EpiStoreBf16 {
    static constexpr bool PERM = true, RS_LDS = false;
    bf16_t* O; int ldc; float sc;
    __device__ __forceinline__ void operator()(const f32x4 (&acc)[2][2][4][2], const Unit& u, int wr, int wc, int fr, int fq) const {
        const int row0 = u.po * BM + wr * 64 + fr, col0 = u.pn * BM + wc * 32 + 8 * fq;
#pragma unroll
        for (int ai = 0; ai < 2; ++ai)
#pragma unroll
            for (int m = 0; m < 4; ++m) { bf16_t* rowp = O + (size_t)(row0 + ai * HALF + m * 16) * ldc + col0;
#pragma unroll
                for (int bj = 0; bj < 2; ++bj) { const f32x4 v0 = acc[ai][bj][m][0] * sc, v1 = acc[ai][bj][m][1] * sc;
                    u32x4 w; w.x = cvt_pk_bf16(v0[0], v0[1]); w.y = cvt_pk_bf16(v0[2], v0[3]); w.z = cvt_pk_bf16(v1[0], v1[1]); w.w = cvt_pk_bf16(v1[2], v1[3]);
                    *(u32x4*)(rowp + bj * HALF) = w; } }
    }
};
struct EpiQKV {
    static constexpr bool PERM = true, RS_LDS = false;
    bf16_t* O; int ldc; float sc; const float* q_gain; const float* k_gain; LAS float* P;
    __device__ __forceinline__ void operator()(const f32x4 (&acc)[2][2][4][2], const Unit& u, int wr, int wc, int fr, int fq) const {
        const int rl0 = wr * 64 + fr, row0 = u.po * BM + rl0, col0 = u.pn * BM + wc * 32 + 8 * fq;
        if (u.pn >= 16) {
#pragma unroll
            for (int ai = 0; ai < 2; ++ai)
#pragma unroll
                for (int m = 0; m < 4; ++m) { bf16_t* rowp = O + (size_t)(row0 + ai * HALF + m * 16) * ldc + col0;
#pragma unroll
                    for (int bj = 0; bj < 2; ++bj) { const f32x4 v0 = acc[ai][bj][m][0] * sc, v1 = acc[ai][bj][m][1] * sc;
                        u32x4 w; w.x = cvt_pk_bf16(v0[0], v0[1]); w.y = cvt_pk_bf16(v0[2], v0[3]); w.z = cvt_pk_bf16(v1[0], v1[1]); w.w = cvt_pk_bf16(v1[2], v1[3]);
                        *(u32x4*)(rowp + bj * HALF) = w; } }
            return;
        }
#pragma unroll
        for (int ai = 0; ai < 2; ++ai)
#pragma unroll
            for (int m = 0; m < 4; ++m)
#pragma unroll
                for (int bj = 0; bj < 2; ++bj) { const f32x4 a = acc[ai][bj][m][0], b = acc[ai][bj][m][1];
                    float ss = (a.x * a.x + a.y * a.y) + (a.z * a.z + a.w * a.w) + (b.x * b.x + b.y * b.y) + (b.z * b.z + b.w * b.w);
                    ss += __shfl_xor(ss, 16); ss += __shfl_xor(ss, 32);
                    if (fq == 0) P[((rl0 + ai * HALF + m * 16) * 2 + bj) * 4 + wc] = ss; }
        asm volatile("s_waitcnt lgkmcnt(0)" ::: "memory"); __builtin_amdgcn_s_barrier(); asm volatile("" ::: "memory");
        const bool isq = u.pn < 8; const float* gn = (isq ? q_gain : k_gain) + wc * 32 + 8 * fq; const float gs = isq ? 0.08838834764831845f * LOG2E : 1.0f;
        const f32x4 g0 = *(const f32x4*)gn * gs, g1 = *(const f32x4*)(gn + 4) * gs;
#pragma unroll
        for (int ai = 0; ai < 2; ++ai)
#pragma unroll
            for (int m = 0; m < 4; ++m) { bf16_t* rowp = O + (size_t)(row0 + ai * HALF + m * 16) * ldc + col0;
#pragma unroll
                for (int bj = 0; bj < 2; ++bj) { const f32x4 q = *(const LAS f32x4*)(P + ((rl0 + ai * HALF + m * 16) * 2 + bj) * 4);
                    const float r = __builtin_amdgcn_rsqf(((q.x + q.y) + (q.z + q.w)) * (sc * sc) * (1.0f / HD) + RMS_EPS) * sc;
                    const f32x4 v0 = acc[ai][bj][m][0] * g0 * r, v1 = acc[ai][bj][m][1] * g1 * r;
                    u32x4 w; w.x = cvt_pk_bf16(v0[0], v0[1]); w.y = cvt_pk_bf16(v0[2], v0[3]); w.z = cvt_pk_bf16(v1[0], v1[1]); w.w = cvt_pk_bf16(v1[2], v1[3]);
                    *(u32x4*)(rowp + bj * HALF) = w; } }
    }
};
template <bool BASE_BF16> struct EpiResidNormB {
    static constexpr bool PERM = true, RS_LDS = false;
    const void* base; bf16_t* ob; unsigned char* hb; float* rsp; int ldc; LAS float* P; float sc; float hsc;
    __device__ __forceinline__ void operator()(const f32x4 (&acc)[2][2][4][2], const Unit& u, int wr, int wc, int fr, int fq) const {
        const int rl0 = wr * 64 + fr, row0 = u.po * BM + rl0, col0 = u.pn * BM + wc * 32 + 8 * fq;
#pragma unroll
        for (int ai = 0; ai < 2; ++ai)
#pragma unroll
            for (int m = 0; m < 4; ++m) { const int row = row0 + ai * HALF + m * 16; const size_t off = (size_t)row * ldc + col0; float ss = 0.f;
#pragma unroll
                for (int bj = 0; bj < 2; ++bj) { f32x4 b0, b1;
                    if constexpr (BASE_BF16) { const u32x4 w = *(const u32x4*)((const bf16_t*)base + off + bj * HALF);
                        b0 = (f32x4){bflo(w.x), bfhi(w.x), bflo(w.y), bfhi(w.y)}; b1 = (f32x4){bflo(w.z), bfhi(w.z), bflo(w.w), bfhi(w.w)}; }
                    else { const f32x4* bp = (const f32x4*)((const float*)base + off + bj * HALF); b0 = bp[0]; b1 = bp[1]; }
                    const f32x4 v0 = b0 + acc[ai][bj][m][0] * sc, v1 = b1 + acc[ai][bj][m][1] * sc;
                    u32x4 w; w.x = cvt_pk_bf16(v0[0], v0[1]); w.y = cvt_pk_bf16(v0[2], v0[3]); w.z = cvt_pk_bf16(v1[0], v1[1]); w.w = cvt_pk_bf16(v1[2], v1[3]);
                    *(u32x4*)(ob + off + bj * HALF) = w;
                    u32x2 q; q.x = pk4_i8(v0[0] * hsc, v0[1] * hsc, v0[2] * hsc, v0[3] * hsc); q.y = pk4_i8(v1[0] * hsc, v1[1] * hsc, v1[2] * hsc, v1[3] * hsc);
                    *(u32x2*)(hb + off + bj * HALF) = q;
                    ss += ((v0.x * v0.x + v0.y * v0.y) + (v0.z * v0.z + v0.w * v0.w)) + ((v1.x * v1.x + v1.y * v1.y) + (v1.z * v1.z + v1.w * v1.w)); }
                ss += __shfl_xor(ss, 16); ss += __shfl_xor(ss, 32);
                if (fq == 0) P[(rl0 + ai * HALF + m * 16) * 4 + wc] = ss; }
        asm volatile("s_waitcnt lgkmcnt(0)" ::: "memory"); __builtin_amdgcn_s_barrier(); asm volatile("" ::: "memory");
        const int t = threadIdx.x;
        if (t < BM) { const LAS f32x4* pp = (const LAS f32x4*)(P + t * 4); const f32x4 q = *pp; rsp[(size_t)(u.po * BM + t) * 8 + u.pn] = (q.x + q.y) + (q.z + q.w); }
    }
};
struct EpiResidB {
    static constexpr bool PERM = true, RS_LDS = false;
    const bf16_t* base; bf16_t* ob; int ldc; float sc;
    __device__ __forceinline__ void operator()(const f32x4 (&acc)[2][2][4][2], const Unit& u, int wr, int wc, int fr, int fq) const {
        const int row0 = u.po * BM + wr * 64 + fr, col0 = u.pn * BM + wc * 32 + 8 * fq;
#pragma unroll
        for (int ai = 0; ai < 2; ++ai)
#pragma unroll
            for (int m = 0; m < 4; ++m) { const size_t off = (size_t)(row0 + ai * HALF + m * 16) * ldc + col0;
#pragma unroll
                for (int bj = 0; bj < 2; ++bj) { const u32x4 b = *(const u32x4*)(base + off + bj * HALF);
                    const f32x4 v0 = (f32x4){bflo(b.x), bfhi(b.x), bflo(b.y), bfhi(b.y)} + acc[ai][bj][m][0] * sc, v1 = (f32x4){bflo(b.z), bfhi(b.z), bflo(b.w), bfhi(b.w)} + acc[ai][bj][m][1] * sc;
                    u32x4 w; w.x = cvt_pk_bf16(v0[0], v0[1]); w.y = cvt_pk_bf16(v0[2], v0[3]); w.z = cvt_pk_bf16(v1[0], v1[1]); w.w = cvt_pk_bf16(v1[2], v1[3]);
                    *(u32x4*)(ob + off + bj * HALF) = w; } }
    }
};
__device__ __forceinline__ void rs_prefetch(const float* rs, LAS float* PR, const Unit& u, int wid, int tid) {
    __builtin_amdgcn_global_load_lds((const unsigned*)(rs + (size_t)(u.po * BM) * 8 + tid * 4), (LAS unsigned*)((LAS unsigned char*)PR + (u.ui & 1) * 8192 + wid * 1024), 16, 0, 0); }
__device__ __forceinline__ float row_rstd8(const LAS float* PR, const Unit& u, int rl) { const LAS f32x4* p = (const LAS f32x4*)(PR + (u.ui & 1) * 2048 + rl * 8); const f32x4 a = p[0], b = p[1];
    return __builtin_amdgcn_rsqf((((a.x + a.y) + (a.z + a.w)) + ((b.x + b.y) + (b.z + b.w))) * (1.0f / D) + RMS_EPS); }
__device__ __forceinline__ float silu_mul(float g, float u) { return g * u * __builtin_amdgcn_rcpf(1.0f + __builtin_amdgcn_exp2f(-g * LOG2E)); }
__device__ __forceinline__ f32x4 silu_mul4(f32x4 g, f32x4 u) {
    const f32x2 ga = (f32x2){g.x, g.y}, gb = (f32x2){g.z, g.w}, ua = (f32x2){u.x, u.y}, ub = (f32x2){u.z, u.w};
    const f32x2 ta = ga * (-LOG2E), tb = gb * (-LOG2E);
    f32x2 ea, eb; ea.x = __builtin_amdgcn_exp2f(ta.x); ea.y = __builtin_amdgcn_exp2f(ta.y); eb.x = __builtin_amdgcn_exp2f(tb.x); eb.y = __builtin_amdgcn_exp2f(tb.y);
    const f32x2 da = ea + 1.0f, db = eb + 1.0f;
    f32x2 ra, rb; ra.x = __builtin_amdgcn_rcpf(da.x); ra.y = __builtin_amdgcn_rcpf(da.y); rb.x = __builtin_amdgcn_rcpf(db.x); rb.y = __builtin_amdgcn_rcpf(db.y);
    const f32x2 oa = (ga * ua) * ra, ob = (gb * ub) * rb;
    return (f32x4){oa.x, oa.y, ob.x, ob.y}; }
struct EpiSwiGLU {
    static constexpr bool PERM = true, RS_LDS = true;
    unsigned char* O; int ldc; const float* rs; float sc; LAS float* PR;
    __device__ __forceinline__ void prefetch(const Unit& u, int wid, int tid) const { rs_prefetch(rs, PR, u, wid, tid); }
    __device__ __forceinline__ void operator()(const f32x4 (&acc)[2][2][4][2], const Unit& u, int wr, int wc, int fr, int fq) const {
        const int row0 = u.po * BM + wr * 64 + fr, col0 = u.pn * HALF + wc * 32 + 8 * fq; const float qs = SC_ACTR * 0.35355339059327373f;
#pragma unroll
        for (int ai = 0; ai < 2; ++ai)
#pragma unroll
            for (int m = 0; m < 4; ++m) { const int row = row0 + ai * HALF + m * 16; unsigned char* rowp = O + (size_t)row * ldc + col0;
                const float r = row_rstd8(PR, u, wr * 64 + fr + ai * HALF + m * 16) * sc;
                const f32x4 g0 = acc[ai][0][m][0] * r, g1 = acc[ai][0][m][1] * r, u0 = acc[ai][1][m][0] * r, u1 = acc[ai][1][m][1] * r;
                const f32x4 s0 = silu_mul4(g0, u0), s1 = silu_mul4(g1, u1);
                float a[8] = {s0[0], s0[1], s0[2], s0[3], s1[0], s1[1], s1[2], s1[3]};
                wht_inlane8(a);
                u32x2 w; w.x = pk4_i8(a[0] * qs, a[1] * qs, a[2] * qs, a[3] * qs); w.y = pk4_i8(a[4] * qs, a[5] * qs, a[6] * qs, a[7] * qs);
                *(u32x2*)rowp = w; }
    }
};
struct EpiWin {
    static constexpr bool PERM = true, RS_LDS = true;
    bf16_t* O; int ldc; const float* rs; float sc; LAS float* PR;
    __device__ __forceinline__ void prefetch(const Unit& u, int wid, int tid) const { rs_prefetch(rs, PR, u, wid, tid); }
    __device__ __forceinline__ void operator()(const f32x4 (&acc)[2][2][4][2], const Unit& u, int wr, int wc, int fr, int fq) const {
        const int row0 = u.po * BM + wr * 64 + fr;
        float rr[2][4];
#pragma unroll
        for (int ai = 0; ai < 2; ++ai)
#pragma unroll
            for (int m = 0; m < 4; ++m) rr[ai][m] = row_rstd8(PR, u, wr * 64 + fr + ai * HALF + m * 16) * sc;
        if (u.pn < 8) {
            const int col0 = u.pn * BM + wc * 32 + 8 * fq;
#pragma unroll
            for (int ai = 0; ai < 2; ++ai)
#pragma unroll
                for (int m = 0; m < 4; ++m) { bf16_t* rowp = O + (size_t)(row0 + ai * HALF + m * 16) * ldc + col0;
#pragma unroll
                    for (int bj = 0; bj < 2; ++bj) { const f32x4 v0 = acc[ai][bj][m][0] * rr[ai][m], v1 = acc[ai][bj][m][1] * rr[ai][m];
                        u32x4 w; w.x = cvt_pk_bf16(v0[0], v0[1]); w.y = cvt_pk_bf16(v0[2], v0[3]); w.z = cvt_pk_bf16(v1[0], v1[1]); w.w = cvt_pk_bf16(v1[2], v1[3]);
                        *(u32x4*)(rowp + bj * HALF) = w; } }
        } else {
            const int col0 = D + (u.pn - 8) * HALF + wc * 32 + 8 * fq;
#pragma unroll
            for (int ai = 0; ai < 2; ++ai)
#pragma unroll
                for (int m = 0; m < 4; ++m) { bf16_t* rowp = O + (size_t)(row0 + ai * HALF + m * 16) * ldc + col0;
                    const float r2 = rr[ai][m] * rr[ai][m]; const f32x4 a0 = acc[ai][0][m][0] * acc[ai][1][m][0] * r2, a1 = acc[ai][0][m][1] * acc[ai][1][m][1] * r2;
                    u32x4 w; w.x = cvt_pk_bf16(a0[0], a0[1]); w.y = cvt_pk_bf16(a0[2], a0[3]); w.z = cvt_pk_bf16(a1[0], a1[1]); w.w = cvt_pk_bf16(a1[2], a1[3]);
                    *(u32x4*)rowp = w; }
        }
    }
};
struct EpiSwiGLU8 {
    static constexpr bool PERM = true, RS_LDS = false;
    unsigned char* O; int ldc;
    __device__ __forceinline__ void operator()(const f32x4 (&acc)[2][2][4][2], const Unit& u, int wr, int wc, int fr, int fq) const {
        const int row0 = u.po * BM + wr * 64 + fr, col0 = u.pn * HALF + wc * 32 + 8 * fq; const float si = 1.0f / (SC_A8 * SC_W8);
#pragma unroll
        for (int ai = 0; ai < 2; ++ai)
#pragma unroll
            for (int m = 0; m < 4; ++m) { unsigned char* rowp = O + (size_t)(row0 + ai * HALF + m * 16) * ldc + col0;
                const f32x4 g0 = acc[ai][0][m][0] * si, g1 = acc[ai][0][m][1] * si, u0 = acc[ai][1][m][0] * (si * SC_ACT), u1 = acc[ai][1][m][1] * (si * SC_ACT);
                const f32x4 s0 = silu_mul4(g0, u0), s1 = silu_mul4(g1, u1);
                u32x2 w; w.x = pk4_fp8(s0[0], s0[1], s0[2], s0[3]); w.y = pk4_fp8(s1[0], s1[1], s1[2], s1[3]);
                __builtin_nontemporal_store(w, (u32x2*)rowp); }
    }
};
struct EpiMoeDown {
    static constexpr bool PERM = true, RS_LDS = false;
    bf16_t* Y0; bf16_t* Y1; const int* rowinfo; const float* rowgate; float osc;
    __device__ __forceinline__ void operator()(const f32x4 (&acc)[2][2][4][2], const Unit& u, int wr, int wc, int fr, int fq) const {
        const int row0 = u.po * BM + wr * 64 + fr, col0 = u.pn * BM + wc * 32 + 8 * fq;
#pragma unroll
        for (int ai = 0; ai < 2; ++ai)
#pragma unroll
            for (int m = 0; m < 4; ++m) { const int r = row0 + ai * HALF + m * 16; const int info = rowinfo[r]; const float g = rowgate[r] * osc;
                if (info >= 0) { const int tok = info & 0xffff; bf16_t* rowp = ((info >> 16) == 0 ? Y0 : Y1) + (size_t)tok * D + col0;
#pragma unroll
                    for (int bj = 0; bj < 2; ++bj) { const f32x4 v0 = acc[ai][bj][m][0] * g, v1 = acc[ai][bj][m][1] * g;
                        u32x4 w; w.x = cvt_pk_bf16(v0[0], v0[1]); w.y = cvt_pk_bf16(v0[2], v0[3]); w.z = cvt_pk_bf16(v1[0], v1[1]); w.w = cvt_pk_bf16(v1[2], v1[3]);
                        *(u32x4*)(rowp + bj * HALF) = w; } } }
    }
};

template <class Epi, class Sched, int FMT = -1>
__device__ __forceinline__ void gemm_phase(LAS unsigned char* lds, const Gemm g, const Sched& S, const Epi& E) {
    const int tid = threadIdx.x, wid = __builtin_amdgcn_readfirstlane(tid >> 6), lane = tid & 63, wr = wid >> 2, wc = wid & 3, fr = lane & 15, fq = lane >> 4;
    const int KB = g.KB, nt = KB / (BK * 2);
    constexpr bool GA = Sched::GATHER;
    unsigned voffA, voffB; int gR, gC2;
    { int R, C; stage_rc(tid * 16, R, C); const int Rb = Epi::PERM ? ((R & ~31) + perm32(R & 31)) : R; voffA = (unsigned)(R * KB + C * 2); voffB = (unsigned)(Rb * KB + C * 2); gR = R; gC2 = C * 2; }
    const size_t pstep = (size_t)64 * KB;
    const size_t kstep = (size_t)(BK * 2);
    const size_t hstep = (size_t)HALF * KB;
    const size_t tstep = 2 * hstep;
    const size_t hstepA = GA ? 0 : hstep;
    const unsigned ldsw = (unsigned)wid * 1024u;
    const int aoff = lds_byte(wr * 64 + fr, fq * 8), boff = lds_byte(wc * 32 + fr, fq * 8);
#define PG8_SA(b, h) (((b) * 2 + (h)) * HTB)
#define PG8_SB(b, h) ((4 + (b) * 2 + (h)) * HTB)
#define PG8_STAGE2(bufoff, gbase, v0, v1, pst) do { _Pragma("unroll") for (int _i = 0; _i < 2; ++_i) { unsigned _vo = _i ? (v1) : (v0); asm volatile("" : "+v"(_vo)); \
        const char* _gb = (const char*)(gbase) + _i * (pst); asm volatile("" : "+s"(_gb)); \
        __builtin_amdgcn_global_load_lds((const unsigned*)(_gb + _vo), (LAS unsigned*)(lds + (bufoff) + ldsw + _i * 8192), 16, 0, 0); } } while (0)
#define PG8_STAGE(bufoff, gbase, voff) PG8_STAGE2(bufoff, gbase, voff, voff, pstep)
#define PG8_STAGE_A(bufoff, gbase, h, nx) do { if constexpr (GA) PG8_STAGE2(bufoff, gbase, ((nx) ? vn[h][0] : vc[h][0]), ((nx) ? vn[h][1] : vc[h][1]), 0); else PG8_STAGE2(bufoff, gbase, voffA, voffA, pstep); } while (0)
#define PG8_GISSUE(tile, slot) __builtin_amdgcn_global_load_lds((const unsigned*)(S.rowinfo + (size_t)(tile) * 256 + lane * 4), (LAS unsigned*)(S.gl + wid * 2048 + (slot) * 1024), 16, 0, 0)
#define PG8_GREAD(dst, slot) do { _Pragma("unroll") for (int _h = 0; _h < 2; ++_h) _Pragma("unroll") for (int _i = 0; _i < 2; ++_i) { \
        const int _info = lds_ld_i32((unsigned)(size_t)(S.gl + wid * 2048 + (slot) * 1024) + (unsigned)((_h * 128 + _i * 64 + gR) * 4)); \
        dst[_h][_i] = (unsigned)((_info < 0 ? 0 : (_info & 0xffff)) * KB + gC2); } } while (0)
#define PG8_LDA(dst, b, h) do { _Pragma("unroll") for (int m = 0; m < 4; ++m) { dst[m].lo = *(const LAS i32x4*)(lds + PG8_SA(b, h) + aoff + m * 2048); dst[m].hi = *(const LAS i32x4*)(lds + PG8_SA(b, h) + aoff + m * 2048 + 1024); } } while (0)
#define PG8_LDB(dst, b, h) do { _Pragma("unroll") for (int n = 0; n < 2; ++n) { dst[n].lo = *(const LAS i32x4*)(lds + PG8_SB(b, h) + boff + n * 2048); dst[n].hi = *(const LAS i32x4*)(lds + PG8_SB(b, h) + boff + n * 2048 + 1024); } } while (0)
#define PG8_MMA(ai, bj, At, Bt) do { __builtin_amdgcn_s_setprio(1); _Pragma("unroll") for (int m = 0; m < 4; ++m) _Pragma("unroll") for (int n = 0; n < 2; ++n) { \
        if constexpr (FMT == 0) acc[ai][bj][m][n] = __builtin_amdgcn_mfma_scale_f32_16x16x128_f8f6f4(Bt[n], At[m], acc[ai][bj][m][n], 0, 0, 0, 0x7f7f7f7f, 0, 0x7f7f7f7f); \
        else if constexpr (FMT == 8) { const i32x4 _bl = Bt[n].lo, _bh = Bt[n].hi, _al = At[m].lo, _ah = At[m].hi; i32x4 _c = __builtin_bit_cast(i32x4, acc[ai][bj][m][n]); \
               _c = __builtin_amdgcn_mfma_i32_16x16x64_i8(_bl, _al, _c, 0, 0, 0); _c = __builtin_amdgcn_mfma_i32_16x16x64_i8(_bh, _ah, _c, 0, 0, 0); acc[ai][bj][m][n] = __builtin_bit_cast(f32x4, _c); } \
        else { const i32x4 _bl = Bt[n].lo, _bh = Bt[n].hi, _al = At[m].lo, _ah = At[m].hi; \
               acc[ai][bj][m][n] = __builtin_amdgcn_mfma_f32_16x16x32_bf16(__builtin_bit_cast(bf16x8, _bl), __builtin_bit_cast(bf16x8, _al), acc[ai][bj][m][n], 0, 0, 0); \
               acc[ai][bj][m][n] = __builtin_amdgcn_mfma_f32_16x16x32_bf16(__builtin_bit_cast(bf16x8, _bh), __builtin_bit_cast(bf16x8, _ah), acc[ai][bj][m][n], 0, 0, 0); } } __builtin_amdgcn_s_setprio(0); } while (0)
#define PG8_WAIT_V(n) asm volatile("s_waitcnt vmcnt(" #n ")" ::: "memory")
#define PG8_WAIT_L(n) asm volatile("s_waitcnt lgkmcnt(" #n ")" ::: "memory")
#define PG8_BAR __builtin_amdgcn_s_barrier()
#define PG8_SCHED __builtin_amdgcn_sched_barrier(0)
    Unit cur, nxt; int ui = 0;
    if (!S.next(0, cur)) return;
    cur.ui = 0;
    if constexpr (Epi::RS_LDS) E.prefetch(cur, wid, tid);
    f32x4 acc[2][2][4][2];
#pragma unroll
    for (int a = 0; a < 2; ++a)
#pragma unroll
        for (int b = 0; b < 2; ++b)
#pragma unroll
            for (int m = 0; m < 4; ++m)
#pragma unroll
                for (int n = 0; n < 2; ++n) { typedef unsigned long long u64x2_t __attribute__((ext_vector_type(2))); u64x2_t z_; asm volatile("v_mov_b64 %0, 0" : "=v"(z_.x)); asm volatile("v_mov_b64 %0, 0" : "=v"(z_.y)); acc[a][b][m][n] = __builtin_bit_cast(f32x4, z_); }
    i32x8 At[4], B0[2], B1[2];
    unsigned vc[2][2], vn[2][2];
    if constexpr (GA) { int t1; PG8_GISSUE(cur.pm, 0); if (S.row_tile(1, t1)) PG8_GISSUE(t1, 1); asm volatile("s_waitcnt vmcnt(0)" ::: "memory"); PG8_GREAD(vc, 0);
#pragma unroll
        for (int h = 0; h < 2; ++h) { vn[h][0] = vc[h][0]; vn[h][1] = vc[h][1]; } }
    const char* cA = GA ? (const char*)g.A : (const char*)g.A + (size_t)cur.pm * tstep; const char* cB = (const char*)g.Bt + (size_t)cur.pb * tstep;
    PG8_STAGE(PG8_SB(0, 0), cB, voffB); PG8_STAGE(PG8_SB(0, 1), cB + hstep, voffB); PG8_STAGE_A(PG8_SA(0, 0), cA, 0, false); PG8_STAGE_A(PG8_SA(0, 1), cA + hstepA, 1, false);
    if (wr == 1) PG8_BAR;
    PG8_WAIT_V(2); PG8_BAR;
    PG8_STAGE(PG8_SB(1, 0), cB + kstep, voffB); PG8_STAGE_A(PG8_SA(1, 0), cA + kstep, 0, false); PG8_STAGE(PG8_SB(1, 1), cB + hstep + kstep, voffB);
    PG8_WAIT_V(6); PG8_BAR;
    for (;;) {
        const bool has_next = S.next(ui + 1, nxt); nxt.ui = ui + 1;
        if constexpr (GA) { if (has_next) PG8_GREAD(vn, (ui + 1) & 1); int t2; if (S.row_tile(ui + 2, t2)) PG8_GISSUE(t2, ui & 1); }
        const char* nA = GA ? cA : (has_next ? (const char*)g.A + (size_t)nxt.pm * tstep : cA); const char* nB = has_next ? (const char*)g.Bt + (size_t)nxt.pb * tstep : cB;
        for (int t = 0; t < nt; t += 2) {
            const bool last = (t == nt - 2);
            const char* a1 = cA + (size_t)(t + 1) * kstep;
            const char* a2 = last ? nA : cA + (size_t)(t + 2) * kstep; const char* b2 = last ? nB : cB + (size_t)(t + 2) * kstep;
            const char* a3 = a2 + kstep; const char* b3 = b2 + kstep;
            PG8_LDB(B0, 0, 0); PG8_LDB(B1, 0, 1); PG8_SCHED; PG8_LDA(At, 0, 0); PG8_STAGE_A(PG8_SA(1, 1), a1 + hstepA, 1, false);
            PG8_WAIT_V(8); PG8_WAIT_L(0); PG8_BAR; PG8_MMA(0, 0, At, B0); PG8_MMA(0, 1, At, B1); PG8_BAR; PG8_SCHED;
            PG8_LDA(At, 0, 1); PG8_STAGE(PG8_SB(0, 0), b2, voffB); PG8_STAGE(PG8_SB(0, 1), b2 + hstep, voffB); PG8_STAGE_A(PG8_SA(0, 0), a2, 0, last);
            PG8_WAIT_V(8); PG8_WAIT_L(0); PG8_BAR; PG8_MMA(1, 0, At, B0); PG8_MMA(1, 1, At, B1); PG8_BAR; PG8_SCHED;
            PG8_LDB(B0, 1, 0); PG8_LDB(B1, 1, 1); PG8_SCHED; PG8_LDA(At, 1, 0); PG8_STAGE_A(PG8_SA(0, 1), a2 + hstepA, 1, last);
            PG8_WAIT_V(8); PG8_WAIT_L(0); PG8_BAR; PG8_MMA(0, 0, At, B0); PG8_MMA(0, 1, At, B1); PG8_BAR; PG8_SCHED;
            PG8_LDA(At, 1, 1); PG8_STAGE(PG8_SB(1, 0), b3, voffB); PG8_STAGE(PG8_SB(1, 1), b3 + hstep, voffB); PG8_STAGE_A(PG8_SA(1, 0), a3, 0, last);
            PG8_WAIT_V(8); PG8_WAIT_L(0); PG8_BAR; PG8_MMA(1, 0, At, B0); PG8_MMA(1, 1, At, B1); PG8_BAR; PG8_SCHED;
        }
        if (wr == 0) PG8_BAR;
        if constexpr (FMT == 8) {
#pragma unroll
            for (int a = 0; a < 2; ++a)
#pragma unroll
                for (int b = 0; b < 2; ++b)
#pragma unroll
                    for (int m = 0; m < 4; ++m)
#pragma unroll
                        for (int n = 0; n < 2; ++n) acc[a][b][m][n] = __builtin_convertvector(__builtin_bit_cast(i32x4, acc[a][b][m][n]), f32x4); }
        E(acc, cur, wr, wc, fr, fq);
        if (!has_next) break;
        if constexpr (Epi::RS_LDS) E.prefetch(nxt, wid, tid);
#pragma unroll
        for (int a = 0; a < 2; ++a)
#pragma unroll
            for (int b = 0; b < 2; ++b)
#pragma unroll
                for (int m = 0; m < 4; ++m)
#pragma unroll
                    for (int n = 0; n < 2; ++n) { typedef unsigned long long u64x2_t __attribute__((ext_vector_type(2))); u64x2_t z_; asm volatile("v_mov_b64 %0, 0" : "=v"(z_.x)); asm volatile("v_mov_b64 %0, 0" : "=v"(z_.y)); acc[a][b][m][n] = __builtin_bit_cast(f32x4, z_); }
        cur = nxt; cA = nA; cB = nB; ++ui;
        if constexpr (GA) {
#pragma unroll
            for (int h = 0; h < 2; ++h) { vc[h][0] = vn[h][0]; vc[h][1] = vn[h][1]; } }
        if (wr == 1) PG8_BAR;
    }
    PG8_WAIT_V(0);
    PG8_BAR;
#undef PG8_SA
#undef PG8_SB
#undef PG8_STAGE
#undef PG8_STAGE2
#undef PG8_STAGE_A
#undef PG8_GISSUE
#undef PG8_GREAD
#undef PG8_LDA
#undef PG8_LDB
#undef PG8_MMA
#undef PG8_WAIT_V
#undef PG8_WAIT_L
#undef PG8_BAR
#undef PG8_SCHED
}
}

#define XB_TMO      128
#define XB_XCNT(j)  (256  + 64 * (j))
#define XB_XSUB(j)  (1280 + 64 * (j))
#define XB_XGEN(j)  (2304 + 64 * (j))
#define XB_TOP      3328
#define XB_TOPGEN   3392
#define XCD_BAR_WORDS 3456
#define XB_SPIN_CAP (1u << 20)
__device__ __forceinline__ unsigned xb_ld(unsigned* p)              { return __hip_atomic_load(p, __ATOMIC_RELAXED, __HIP_MEMORY_SCOPE_AGENT); }
__device__ __forceinline__ unsigned xb_add(unsigned* p, unsigned v) { return __hip_atomic_fetch_add(p, v, __ATOMIC_RELAXED, __HIP_MEMORY_SCOPE_AGENT); }
__device__ __forceinline__ unsigned xb_xcc_id() { return (unsigned)__builtin_amdgcn_s_getreg((3 << 11) | 20) & 0xFu; }
#define XB_SPIN(cond, bar) do { unsigned _sp = 0; while (cond) { __builtin_amdgcn_s_sleep(1); \
    if ((++_sp & 255u) == 0u) { if (xb_ld(&(bar)[XB_TMO])) break; if (_sp > XB_SPIN_CAP) { atomicAdd(&(bar)[XB_TMO], 1u); break; } } } } while (0)
struct XcdBarrier { unsigned* bar; unsigned x; volatile LAS unsigned* st; };
__device__ __forceinline__ XcdBarrier xcd_barrier_post(unsigned* bar, volatile LAS unsigned* st) {
    XcdBarrier b; b.bar = bar; b.x = xb_xcc_id(); b.st = st;
    if (threadIdx.x == 0) (void)xb_add(&bar[XB_XCNT(b.x)], 1u);
    return b;
}
__device__ __forceinline__ void xcd_barrier_complete(unsigned* bar, unsigned x, unsigned& nloc, unsigned& nx) {
    const unsigned G = gridDim.x * gridDim.y * gridDim.z;
    unsigned sum, cnt, mine, sp = 0u;
    for (;;) {
        sum = 0u; cnt = 0u; mine = 0u;
#pragma unroll
        for (unsigned j = 0; j < 16; ++j) { const unsigned c = xb_ld(&bar[XB_XCNT(j)]); sum += c; cnt += (c > 0u) ? 1u : 0u; mine = (j == x) ? c : mine; }
        if (sum == G) break;
        __builtin_amdgcn_s_sleep(1);
        if ((++sp & 255u) == 0u) { if (xb_ld(&bar[XB_TMO])) break; if (sp > XB_SPIN_CAP) { atomicAdd(&bar[XB_TMO], 1u); break; } }
    }
    nloc = mine > 0u ? mine : 1u; nx = cnt > 0u ? cnt : 1u;
}
__device__ __forceinline__ void xcd_barrier(const XcdBarrier& b) {
    asm volatile("s_waitcnt vmcnt(0)" ::: "memory");
    __syncthreads();
    if (threadIdx.x == 0) {
        unsigned* bar = b.bar;
        __builtin_amdgcn_s_waitcnt(0);
        unsigned nloc = b.st[0], nx = b.st[1];
        if (nloc == 0u) { xcd_barrier_complete(bar, b.x, nloc, nx); b.st[0] = nloc; b.st[1] = nx; }
        const unsigned old = xb_add(&bar[XB_XSUB(b.x)], 1u);
        const unsigned gen = old / nloc;
        if (old + 1u == (gen + 1u) * nloc) {
            __builtin_amdgcn_fence(__ATOMIC_RELEASE, "agent");
            asm volatile("s_waitcnt vmcnt(0)" ::: "memory");
            const unsigned og = xb_add(&bar[XB_TOP], 1u);
            const unsigned tg = og / nx;
            if (og + 1u == (tg + 1u) * nx) xb_add(&bar[XB_TOPGEN], 1u);
            else XB_SPIN(xb_ld(&bar[XB_TOPGEN]) == tg, bar);
            __builtin_amdgcn_fence(__ATOMIC_ACQUIRE, "agent");
            xb_add(&bar[XB_XGEN(b.x)], 1u);
            asm volatile("s_waitcnt vmcnt(0)" ::: "memory");
        } else {
            XB_SPIN(xb_ld(&bar[XB_XGEN(b.x)]) == gen, bar);
            __builtin_amdgcn_fence(__ATOMIC_ACQUIRE, "agent");
            asm volatile("s_waitcnt vmcnt(0)" ::: "memory");
        }
    }
    __syncthreads();
}

constexpr int P0S = 65;
__device__ __forceinline__ void p0_load_tile(const float* W, int N, int k0, int n0, LAS float* scr, int lane, const float* kgain = nullptr) {
    f32x4 v[16];
#pragma unroll
    for (int i = 0; i < 16; ++i) v[i] = *(const f32x4*)(W + (size_t)(k0 + 4 * i + (lane >> 4)) * N + n0 + 4 * (lane & 15));
    if (kgain) {
#pragma unroll
        for (int i = 0; i < 16; ++i) v[i] = v[i] * kgain[k0 + 4 * i + (lane >> 4)]; }
#pragma unroll
    for (int i = 0; i < 16; ++i) { LAS float* d = scr + (4 * i + (lane >> 4)) * P0S + 4 * (lane & 15); d[0] = v[i].x; d[1] = v[i].y; d[2] = v[i].z; d[3] = v[i].w; }
    LDS_WAIT(); asm volatile("" ::: "memory");
}
__device__ __forceinline__ void p0_transpose_item(const float* W, int K, int N, bf16_t* WT, int k0, int n0, int drow0, LAS float* scr, int lane, const float* kgain = nullptr) {
    p0_load_tile(W, N, k0, n0, scr, lane, kgain);
    const int c = lane & 7;
#pragma unroll
    for (int j = 0; j < 8; ++j) { const int n = (lane >> 3) + 8 * j; const LAS float* s = scr + (8 * c) * P0S + n;
        u32x4 o; o.x = cvt_pk_bf16(s[0 * P0S], s[1 * P0S]); o.y = cvt_pk_bf16(s[2 * P0S], s[3 * P0S]); o.z = cvt_pk_bf16(s[4 * P0S], s[5 * P0S]); o.w = cvt_pk_bf16(s[6 * P0S], s[7 * P0S]);
        *(u32x4*)(WT + (size_t)(drow0 + n) * K + k0 + 8 * c) = o; }
    LDS_WAIT(); asm volatile("" ::: "memory");
}
template <int BLK>
__device__ __forceinline__ void p0_item_dn(const float* W, int K, int N, bf16_t* WT  , unsigned char* WT8, float wsc, int k0, int n0, LAS float* scr, int lane) {
    p0_load_tile(W, N, k0, n0, scr, lane, nullptr);
    if (WT) { const int c = lane & 7;
#pragma unroll
      for (int j = 0; j < 8; ++j) { const int n = (lane >> 3) + 8 * j; const LAS float* s = scr + (8 * c) * P0S + n;
          u32x4 o; o.x = cvt_pk_bf16(s[0 * P0S], s[1 * P0S]); o.y = cvt_pk_bf16(s[2 * P0S], s[3 * P0S]); o.z = cvt_pk_bf16(s[4 * P0S], s[5 * P0S]); o.w = cvt_pk_bf16(s[6 * P0S], s[7 * P0S]);
          *(u32x4*)(WT + (size_t)(n0 + n) * K + k0 + 8 * c) = o; } }
    { const int c = lane & 3; const float sc = wsc * (BLK == 32 ? 0.17677669529663687f : 0.35355339059327373f);
#pragma unroll
      for (int j = 0; j < 4; ++j) { const int n = (lane >> 2) + 16 * j; const LAS float* s = scr + (16 * c) * P0S + n;
          float f[16];
#pragma unroll
          for (int e = 0; e < 16; ++e) f[e] = s[e * P0S];
#pragma unroll
          for (int h = 1; h < (BLK == 32 ? 16 : 8); h <<= 1)
#pragma unroll
              for (int i = 0; i < 16; ++i) if ((i & h) == 0) { const float a = f[i], b = f[i + h]; f[i] = a + b; f[i + h] = a - b; }
#pragma unroll
          for (int e = 0; e < 16; ++e) { if constexpr (BLK == 32) { const float o = __shfl_xor(f[e], 1); f[e] = ((c & 1) ? o - f[e] : f[e] + o) * sc; } else f[e] *= sc; }
          u32x4 o; o.x = pk4_i8(f[0], f[1], f[2], f[3]); o.y = pk4_i8(f[4], f[5], f[6], f[7]); o.z = pk4_i8(f[8], f[9], f[10], f[11]); o.w = pk4_i8(f[12], f[13], f[14], f[15]);
          *(u32x4*)(WT8 + (size_t)(n0 + n) * K + k0 + 16 * c) = o; } }
    LDS_WAIT(); asm volatile("" ::: "memory");
}
__device__ __forceinline__ void p0_matrix(const float* W, int K, int N, bf16_t* WT, int ilv_half  , int r, LAS float* scr, int lane, const float* kgain = nullptr) {
    const int nblk = N / 64, kb = (r / (4 * nblk)) * 4 + (r & 3), nb = (r >> 2) % nblk, n0 = 64 * nb;
    const int drow0 = ilv_half < 0 ? n0 : (n0 / 128) * 256 + ilv_half * 128 + (n0 % 128);
    p0_transpose_item(W, K, N, WT, 64 * kb, n0, drow0, scr, lane, kgain);
}
__device__ __forceinline__ void p0_transpose_item8(const float* W, int K, int N, unsigned char* WT, int k0, int n0, int drow0, float sc, LAS float* scr, int lane) {
    p0_load_tile(W, N, k0, n0, scr, lane);
    const int c = lane & 3;
#pragma unroll
    for (int j = 0; j < 4; ++j) { const int n = (lane >> 2) + 16 * j; const LAS float* s = scr + (16 * c) * P0S + n;
        u32x4 o; o.x = pk4_fp8(s[0 * P0S] * sc, s[1 * P0S] * sc, s[2 * P0S] * sc, s[3 * P0S] * sc); o.y = pk4_fp8(s[4 * P0S] * sc, s[5 * P0S] * sc, s[6 * P0S] * sc, s[7 * P0S] * sc);
        o.z = pk4_fp8(s[8 * P0S] * sc, s[9 * P0S] * sc, s[10 * P0S] * sc, s[11 * P0S] * sc); o.w = pk4_fp8(s[12 * P0S] * sc, s[13 * P0S] * sc, s[14 * P0S] * sc, s[15 * P0S] * sc);
        *(u32x4*)(WT + (size_t)(drow0 + n) * K + k0 + 16 * c) = o; }
    LDS_WAIT(); asm volatile("" ::: "memory");
}
__device__ __forceinline__ void p0_matrix8(const float* W, int K, int N, unsigned char* WT, int ilv_half, float sc, int r, LAS float* scr, int lane) {
    const int nblk = N / 64, kb = (r / (4 * nblk)) * 4 + (r & 3), nb = (r >> 2) % nblk, n0 = 64 * nb;
    const int drow0 = ilv_half < 0 ? n0 : (n0 / 128) * 256 + ilv_half * 128 + (n0 % 128);
    p0_transpose_item8(W, K, N, WT, 64 * kb, n0, drow0, sc, scr, lane);
}

__device__ __forceinline__ void p0_transpose_item_i8(const float* W, int K, int N, unsigned char* WT, int k0, int n0, int drow0, float sc, LAS float* scr, int lane, const float* kgain) {
    p0_load_tile(W, N, k0, n0, scr, lane, kgain);
    const int c = lane & 3;
#pragma unroll
    for (int j = 0; j < 4; ++j) { const int n = (lane >> 2) + 16 * j; const LAS float* s = scr + (16 * c) * P0S + n;
        u32x4 o; o.x = pk4_i8(s[0 * P0S] * sc, s[1 * P0S] * sc, s[2 * P0S] * sc, s[3 * P0S] * sc); o.y = pk4_i8(s[4 * P0S] * sc, s[5 * P0S] * sc, s[6 * P0S] * sc, s[7 * P0S] * sc);
        o.z = pk4_i8(s[8 * P0S] * sc, s[9 * P0S] * sc, s[10 * P0S] * sc, s[11 * P0S] * sc); o.w = pk4_i8(s[12 * P0S] * sc, s[13 * P0S] * sc, s[14 * P0S] * sc, s[15 * P0S] * sc);
        *(u32x4*)(WT + (size_t)(drow0 + n) * K + k0 + 16 * c) = o; }
    LDS_WAIT(); asm volatile("" ::: "memory");
}
__device__ __forceinline__ void p0_matrix_i8(const float* W, int K, int N, unsigned char* WT, int ilv_half, float sc, int r, LAS float* scr, int lane, const float* kgain) {
    const int nblk = N / 64, kb = (r / (4 * nblk)) * 4 + (r & 3), nb = (r >> 2) % nblk, n0 = 64 * nb;
    const int drow0 = ilv_half < 0 ? n0 : (n0 / 128) * 256 + ilv_half * 128 + (n0 % 128);
    p0_transpose_item_i8(W, K, N, WT, 64 * kb, n0, drow0, sc, scr, lane, kgain);
}

__device__ __forceinline__ void rms_rows_to_bf16(const float* x, const float* gain, bf16_t* o, int m0, int step, int m1, int lane) {
    f32x4 g[4][2];
#pragma unroll
    for (int j = 0; j < 4; ++j) { const f32x4* gp = (const f32x4*)(gain + 8 * (lane + 64 * j)); g[j][0] = gp[0]; g[j][1] = gp[1]; }
    for (int m = m0; m < m1; m += step) {
        const float* xrow = x + (size_t)m * D; bf16_t* orow = o + (size_t)m * D;
        f32x4 v[4][2]; float s = 0.f;
#pragma unroll
        for (int j = 0; j < 4; ++j) { const f32x4* p = (const f32x4*)(xrow + 8 * (lane + 64 * j)); v[j][0] = p[0]; v[j][1] = p[1]; }
#pragma unroll
        for (int j = 0; j < 4; ++j)
            s += (v[j][0].x * v[j][0].x + v[j][0].y * v[j][0].y) + (v[j][0].z * v[j][0].z + v[j][0].w * v[j][0].w) + (v[j][1].x * v[j][1].x + v[j][1].y * v[j][1].y) + (v[j][1].z * v[j][1].z + v[j][1].w * v[j][1].w);
        const float rstd = 1.0f / sqrtf(wave_sum(s) * (1.0f / D) + RMS_EPS);
#pragma unroll
        for (int j = 0; j < 4; ++j) { const f32x4 a = v[j][0] * rstd * g[j][0], b = v[j][1] * rstd * g[j][1];
            u32x4 w; w.x = cvt_pk_bf16(a.x, a.y); w.y = cvt_pk_bf16(a.z, a.w); w.z = cvt_pk_bf16(b.x, b.y); w.w = cvt_pk_bf16(b.z, b.w);
            *(u32x4*)(orow + 8 * (lane + 64 * j)) = w; }
    }
}

__device__ __forceinline__ void rms_rows_to_i8(const float* x, const float* gain, unsigned char* o, int m0, int step, int m1, int lane) {
    f32x4 g[4][2];
#pragma unroll
    for (int j = 0; j < 4; ++j) { const f32x4* gp = (const f32x4*)(gain + 8 * (lane + 64 * j)); g[j][0] = gp[0] * SC_A8; g[j][1] = gp[1] * SC_A8; }
    for (int m = m0; m < m1; m += step) {
        const float* xrow = x + (size_t)m * D; unsigned char* orow = o + (size_t)m * D;
        f32x4 v[4][2]; float s = 0.f;
#pragma unroll
        for (int j = 0; j < 4; ++j) { const f32x4* p = (const f32x4*)(xrow + 8 * (lane + 64 * j)); v[j][0] = p[0]; v[j][1] = p[1]; }
#pragma unroll
        for (int j = 0; j < 4; ++j)
            s += (v[j][0].x * v[j][0].x + v[j][0].y * v[j][0].y) + (v[j][0].z * v[j][0].z + v[j][0].w * v[j][0].w) + (v[j][1].x * v[j][1].x + v[j][1].y * v[j][1].y) + (v[j][1].z * v[j][1].z + v[j][1].w * v[j][1].w);
        const float rstd = 1.0f / sqrtf(wave_sum(s) * (1.0f / D) + RMS_EPS);
#pragma unroll
        for (int j = 0; j < 4; ++j) { const f32x4 a = v[j][0] * rstd * g[j][0], b = v[j][1] * rstd * g[j][1];
            u32x2 w; w.x = pk4_i8(a.x, a.y, a.z, a.w); w.y = pk4_i8(b.x, b.y, b.z, b.w); *(u32x2*)(orow + 8 * (lane + 64 * j)) = w; }
    }
}


__device__ __forceinline__ void meta_rstd(const float* src, LAS float* rs, int wave, int lane) {
#pragma unroll
    for (int rr = 0; rr < 2; ++rr) { const int row = 2 * wave + rr; float s = 0.f;
#pragma unroll
        for (int j = 0; j < 8; ++j) { const f32x4 v = *(const f32x4*)(src + (size_t)row * D + 4 * (lane + 64 * j)); s += (v.x * v.x + v.y * v.y) + (v.z * v.z + v.w * v.w); }
        s = wave_sum(s); if (lane == 0) rs[row] = 1.0f / sqrtf(s * (1.0f / D) + RMS_EPS); }
    __syncthreads();
}

struct FNorm { const float* src; const float* gain; const LAS float* rstd; int K;
    __device__ __forceinline__ void operator()(int row, int k, float (&a)[8]) const { const f32x4* p = (const f32x4*)(src + (size_t)row * K + k); const float r = rstd[row]; f32x4 x = p[0] * r, y = p[1] * r;
        if (gain) { const f32x4* gp = (const f32x4*)(gain + k); x = x * gp[0]; y = y * gp[1]; } a[0] = x.x; a[1] = x.y; a[2] = x.z; a[3] = x.w; a[4] = y.x; a[5] = y.y; a[6] = y.z; a[7] = y.w; } };
struct FCvt { const float* src; int K;
    __device__ __forceinline__ void operator()(int row, int k, float (&a)[8]) const { const f32x4* p = (const f32x4*)(src + (size_t)row * K + k); const f32x4 x = p[0], y = p[1];
        a[0] = x.x; a[1] = x.y; a[2] = x.z; a[3] = x.w; a[4] = y.x; a[5] = y.y; a[6] = y.z; a[7] = y.w; } };
template <int WF, int C, class AL, class CM, class EP>
__device__ __forceinline__ void meta_gemm_mc(const void* Btv, int K, int ngroups, float wsc, const AL& A, const CM& colmap, const EP& E, int gw, int NGW, int lane) {
    for (int g = gw; g < ngroups; g += NGW) {
#pragma unroll 1
        for (int rb = 0; rb < 16; rb += 4) {
            float acc[4][C];
#pragma unroll
            for (int r = 0; r < 4; ++r)
#pragma unroll
                for (int c = 0; c < C; ++c) acc[r][c] = 0.f;
#pragma unroll 1
            for (int k = lane * 8; k < K; k += 512) {
                float a[4][8];
#pragma unroll
                for (int r = 0; r < 4; ++r) A(rb + r, k, a[r]);
#pragma unroll
                for (int c = 0; c < C; ++c) { const int n = colmap(g, c); float wf[8];
                    if constexpr (WF == 0) { const u32x4 w = *(const u32x4*)((const bf16_t*)Btv + (size_t)n * K + k);
                        wf[0] = bflo(w.x); wf[1] = bfhi(w.x); wf[2] = bflo(w.y); wf[3] = bfhi(w.y); wf[4] = bflo(w.z); wf[5] = bfhi(w.z); wf[6] = bflo(w.w); wf[7] = bfhi(w.w); }
                    else { const u32x2 w = *(const u32x2*)((const unsigned char*)Btv + (size_t)n * K + k);
                        if constexpr (WF == 1) {
#pragma unroll
                            for (int e = 0; e < 4; ++e) { wf[e] = (float)((int)(w.x << (24 - 8 * e)) >> 24); wf[4 + e] = (float)((int)(w.y << (24 - 8 * e)) >> 24); } }
                        else { wf[0] = __builtin_amdgcn_cvt_f32_fp8((int)w.x, 0); wf[1] = __builtin_amdgcn_cvt_f32_fp8((int)w.x, 1); wf[2] = __builtin_amdgcn_cvt_f32_fp8((int)w.x, 2); wf[3] = __builtin_amdgcn_cvt_f32_fp8((int)w.x, 3);
                               wf[4] = __builtin_amdgcn_cvt_f32_fp8((int)w.y, 0); wf[5] = __builtin_amdgcn_cvt_f32_fp8((int)w.y, 1); wf[6] = __builtin_amdgcn_cvt_f32_fp8((int)w.y, 2); wf[7] = __builtin_amdgcn_cvt_f32_fp8((int)w.y, 3); } }
#pragma unroll
                    for (int r = 0; r < 4; ++r)
#pragma unroll
                        for (int e = 0; e < 8; ++e) acc[r][c] += a[r][e] * wf[e]; }
            }
#pragma unroll
            for (int r = 0; r < 4; ++r)
#pragma unroll
                for (int c = 0; c < C; ++c) acc[r][c] = wave_sum(acc[r][c]) * wsc;
            E(rb, g, acc, lane);
        }
    }
}
template <int C> struct CMCons { __device__ __forceinline__ int operator()(int g, int c) const { return g * C + c; } };
struct CMGateUp { __device__ __forceinline__ int operator()(int g, int c) const { const int ch = 4 * g + (c & 3); return (ch >> 7) * 256 + (ch & 127) + (c >> 2) * 128; } };
template <int C> struct EStoreC { float* out; int ldc;
    __device__ __forceinline__ void operator()(int rb, int g, const float (&v)[4][C], int lane) const {
#pragma unroll
        for (int r = 0; r < 4; ++r)
#pragma unroll
            for (int c = 0; c < C; ++c) if (lane == r * C + c) out[(size_t)(rb + r) * ldc + g * C + c] = v[r][c]; } };
template <int C> struct EResidC { const float* base; float* out; int ldc;
    __device__ __forceinline__ void operator()(int rb, int g, const float (&v)[4][C], int lane) const {
#pragma unroll
        for (int r = 0; r < 4; ++r)
#pragma unroll
            for (int c = 0; c < C; ++c) if (lane == r * C + c) { const size_t o = (size_t)(rb + r) * ldc + g * C + c; out[o] = base[o] + v[r][c]; } } };
struct ESiluAct { float* act;
    __device__ __forceinline__ void operator()(int rb, int g, const float (&v)[4][8], int lane) const {
#pragma unroll
        for (int r = 0; r < 4; ++r)
#pragma unroll
            for (int c = 0; c < 4; ++c) if (lane == r * 4 + c) act[(size_t)(rb + r) * FF + 4 * g + c] = pg8::silu_mul(v[r][c], v[r][c + 4]); } };

namespace att {
constexpr int NSLOT = 3, SLOT = 32768, OFF_KM = 98304, OFF_VM = OFF_KM + 4096, OFF_QM = OFF_VM + 4096, OFF_BIAS = OFF_QM + 4096, OFF_MB = OFF_BIAS + 4096, OFF_SC = OFF_MB + 256;
constexpr int BIAS_SLACK = 256;
__device__ __forceinline__ int swzK(int key) { return ((key >> 3) & 3) * 4 + (key & 3); }
__device__ __forceinline__ int gswV(int row) { return ((row & 3) << 2) | ((row >> 2) & 3); }
__device__ __forceinline__ int r0_of(int r) { const int a = r - 4; return a < 0 ? 0 : (a > GR - 8 ? GR - 8 : a); }
__device__ __forceinline__ bf16x4 tr_read(unsigned addr) { bf16x4 r; asm volatile("ds_read_b64_tr_b16 %0, %1" : "=v"(r) : "v"(addr)); return r; }

__device__ __forceinline__ void meta_step(LAS unsigned char* lds, const bf16x8 (&qf)[4], float Mq, f32x4 (&O)[8], float& lsum, int fr, int fq, int lane) {
    f32x4 s = (f32x4){0.f, 0.f, 0.f, 0.f};
#pragma unroll
    for (int ks = 0; ks < 4; ++ks) { const bf16x8 kf = *(const LAS bf16x8*)(lds + OFF_KM + fr * 256 + (((4 * ks + fq) ^ fr) << 4)); s = __builtin_amdgcn_mfma_f32_16x16x32_bf16(kf, qf[ks], s, 0, 0, 0); }
    const LAS float* mb = (const LAS float*)(lds + OFF_MB);
    float p[4];
#pragma unroll
    for (int i = 0; i < 4; ++i) { p[i] = __builtin_amdgcn_exp2f(s[i] + mb[4 * fq + i] - Mq); lsum += p[i]; }
    u32x4 pw; pw.x = cvt_pk_bf16(p[0], p[1]); pw.y = cvt_pk_bf16(p[2], p[3]); pw.z = 0u; pw.w = 0u;
    const bf16x8 pf = __builtin_bit_cast(bf16x8, pw);
    const int g = lane >> 4, q = (lane & 15) >> 2, pp = lane & 3, row = 4 * g + q;
    const unsigned vbase = (unsigned)(size_t)(lds + OFF_VM) + 256u * row + 8u * (pp & 1);
    bf16x4 v[8];
#pragma unroll
    for (int dt = 0; dt < 8; ++dt) v[dt] = tr_read(vbase + 16u * ((unsigned)(2 * dt + (pp >> 1)) ^ (unsigned)gswV(row)));
    asm volatile("s_waitcnt lgkmcnt(0)" : "+v"(v[0]), "+v"(v[1]), "+v"(v[2]), "+v"(v[3]), "+v"(v[4]), "+v"(v[5]), "+v"(v[6]), "+v"(v[7]) :: "memory");
#pragma unroll
    for (int dt = 0; dt < 8; ++dt) { bf16x8 vf; vf[0] = v[dt][0]; vf[1] = v[dt][1]; vf[2] = v[dt][2]; vf[3] = v[dt][3]; vf[4] = v[dt][0]; vf[5] = v[dt][1]; vf[6] = v[dt][2]; vf[7] = v[dt][3];
        O[dt] = __builtin_amdgcn_mfma_f32_16x16x32_bf16(vf, pf, O[dt], 0, 0, 0); }
}

__device__ __forceinline__ void attn_phase(LAS unsigned char* lds, const bf16_t* qkv, const float* qkv_m, const float* q_gain, const float* k_gain, const float* rel_bias,
                                           const float* meta_bias, bf16_t* o, float* o_m, int G, int bid) {
    const int tid = threadIdx.x, wid = __builtin_amdgcn_readfirstlane(tid >> 6), lane = tid & 63, fr = lane & 15, fq = lane >> 4;
    const int UPW = (NB * NH * (GR / 2)) / G;
    const int u0 = bid * UPW, bh = u0 / (GR / 2), b = bh / NH, h = bh % NH;
    const float QSCALE = 0.08838834764831845f * LOG2E;
    if (tid < 256) { const int m = tid >> 4, ch = tid & 15;
        { const f32x4* p = (const f32x4*)(qkv_m + (size_t)m * NQKV + D + h * HD + ch * 8); const f32x4 a = p[0], c = p[1];
          float ss = (a.x * a.x + a.y * a.y) + (a.z * a.z + a.w * a.w) + (c.x * c.x + c.y * c.y) + (c.z * c.z + c.w * c.w);
          ss += __shfl_xor(ss, 1); ss += __shfl_xor(ss, 2); ss += __shfl_xor(ss, 4); ss += __shfl_xor(ss, 8);
          const float r = 1.0f / sqrtf(ss * (1.0f / HD) + RMS_EPS); const f32x4* gp = (const f32x4*)(k_gain + ch * 8); const f32x4 x = a * gp[0] * r, y = c * gp[1] * r;
          u32x4 w; w.x = cvt_pk_bf16(x.x, x.y); w.y = cvt_pk_bf16(x.z, x.w); w.z = cvt_pk_bf16(y.x, y.y); w.w = cvt_pk_bf16(y.z, y.w);
          *(LAS u32x4*)(lds + OFF_KM + m * 256 + ((ch ^ m) << 4)) = w; }
        { const f32x4* p = (const f32x4*)(qkv_m + (size_t)m * NQKV + 2 * D + h * HD + ch * 8); const f32x4 a = p[0], c = p[1];
          u32x4 w; w.x = cvt_pk_bf16(a.x, a.y); w.y = cvt_pk_bf16(a.z, a.w); w.z = cvt_pk_bf16(c.x, c.y); w.w = cvt_pk_bf16(c.z, c.w);
          *(LAS u32x4*)(lds + OFF_VM + m * 256 + ((ch ^ gswV(m)) << 4)) = w; }
        { const f32x4* p = (const f32x4*)(qkv_m + (size_t)m * NQKV + h * HD + ch * 8); const f32x4 a = p[0], c = p[1];
          float ss = (a.x * a.x + a.y * a.y) + (a.z * a.z + a.w * a.w) + (c.x * c.x + c.y * c.y) + (c.z * c.z + c.w * c.w);
          ss += __shfl_xor(ss, 1); ss += __shfl_xor(ss, 2); ss += __shfl_xor(ss, 4); ss += __shfl_xor(ss, 8);
          const float r = QSCALE / sqrtf(ss * (1.0f / HD) + RMS_EPS); const f32x4* gp = (const f32x4*)(q_gain + ch * 8); const f32x4 x = a * gp[0] * r, y = c * gp[1] * r;
          u32x4 w; w.x = cvt_pk_bf16(x.x, x.y); w.y = cvt_pk_bf16(x.z, x.w); w.z = cvt_pk_bf16(y.x, y.y); w.w = cvt_pk_bf16(y.z, y.w);
          *(LAS u32x4*)(lds + OFF_QM + m * 256 + (ch << 4)) = w; }
    }
    { LAS float* bt = (LAS float*)(lds + OFF_BIAS); for (int i = tid; i < 1024; i += NTHREADS) { const int j = i - BIAS_SLACK; bt[i] = (j >= 0 && j < 15 * 31) ? rel_bias[h * 465 + j] * LOG2E : 0.f; }
      if (tid < 16) ((LAS float*)(lds + OFF_MB))[tid] = meta_bias[h * 16 + tid] * LOG2E; }
    __syncthreads();
    float maxbias, KB;
    { const LAS float* bt = (const LAS float*)(lds + OFF_BIAS) + BIAS_SLACK; float mx = -1e30f;
      for (int i = lane; i < 465; i += 64) mx = fmaxf(mx, bt[i]);
      if (lane < 16) mx = fmaxf(mx, ((const LAS float*)(lds + OFF_MB))[lane]);
      maxbias = wave_max(mx);
      KB = wave_max(fmaxf(fabsf(k_gain[lane]), fabsf(k_gain[lane + 64]))) * 11.313708498984761f * 1.01f; }
    const int j = wid & 3, cq = 16 * j + fr, kc0 = (16 * j - 8) < 0 ? 0 : ((16 * j - 8) > 32 ? 32 : (16 * j - 8));
    const int c0 = (cq - 8) < 0 ? 0 : ((cq - 8) > GW - 16 ? GW - 16 : (cq - 8)), dlo = c0 - cq;
    const int cb = kc0 + 8 * fq - cq + 15;
    unsigned vmask = 0u;
#pragma unroll
    for (int t = 0; t < 2; ++t)
#pragma unroll
        for (int i = 0; i < 4; ++i) { const int dc = kc0 + 8 * fq + 4 * t + i - cq; if (dc >= dlo && dc <= dlo + 15) vmask |= 1u << (4 * t + i); }
    unsigned koff[2];
#pragma unroll
    for (int t = 0; t < 2; ++t) { const int key = kc0 + 8 * (fr >> 2) + (fr & 3) + 4 * t; koff[t] = (unsigned)(key * 256) | ((unsigned)swzK(key) << 16); }
    const int tg = lane >> 4, tq = (lane & 15) >> 2, tp = lane & 3;
    unsigned vrow[2], vsw[2];
#pragma unroll
    for (int t = 0; t < 2; ++t) { const int row = kc0 + 8 * tg + 4 * t + tq; vrow[t] = (unsigned)(row * 256 + 8 * (tp & 1)); vsw[t] = (unsigned)gswV(row); }
    unsigned dK[2], dV[2];
#pragma unroll
    for (int ii = 0; ii < 2; ++ii) { const int p = tid + 512 * ii, key = p >> 4, sc = p & 15; dK[ii] = (unsigned)(key * (NQKV * 2) + ((sc ^ swzK(key)) << 4)); dV[ii] = (unsigned)(key * (NQKV * 2) + ((sc ^ gswV(key)) << 4)); }
    const char* kbase = (const char*)qkv + ((size_t)b * SEQ * NQKV + D + h * HD) * 2;
    const unsigned ldsw = (unsigned)wid * 1024u;
#define ATT_ISSUE(krow, slot) do { const char* _s = kbase + (size_t)(krow) * (GW * NQKV * 2); _Pragma("unroll") for (int _i = 0; _i < 2; ++_i) { \
        __builtin_amdgcn_global_load_lds((const unsigned*)(_s + dK[_i]), (LAS unsigned*)(lds + (slot) * SLOT + ldsw + _i * 8192), 16, 0, 0); \
        __builtin_amdgcn_global_load_lds((const unsigned*)(_s + D * 2 + dV[_i]), (LAS unsigned*)(lds + (slot) * SLOT + 16384 + ldsw + _i * 8192), 16, 0, 0); } } while (0)

    if (b == 0 && (bid % (G / (NB * NH))) == 0 && wid == 0) {
        bf16x8 qf[4]; float ssq = 0.f;
#pragma unroll
        for (int ks = 0; ks < 4; ++ks) { qf[ks] = *(const LAS bf16x8*)(lds + OFF_QM + fr * 256 + ((4 * ks + fq) << 4));
#pragma unroll
            for (int e = 0; e < 8; ++e) { const float f = bf2f((unsigned short)qf[ks][e]); ssq += f * f; } }
        ssq += __shfl_xor(ssq, 16); ssq += __shfl_xor(ssq, 32);
        const float Mq = sqrtf(ssq) * KB + maxbias;
        f32x4 O[8]; float lsum = 0.f;
#pragma unroll
        for (int dt = 0; dt < 8; ++dt) O[dt] = (f32x4){0.f, 0.f, 0.f, 0.f};
        meta_step(lds, qf, Mq, O, lsum, fr, fq, lane);
        lsum += __shfl_xor(lsum, 16); lsum += __shfl_xor(lsum, 32);
        const float inv = 1.0f / lsum;
#pragma unroll
        for (int dt = 0; dt < 8; ++dt) *(f32x4*)(o_m + (size_t)fr * D + h * HD + 16 * dt + 4 * fq) = O[dt] * inv;
    }

    int iu = 0, irp = (u0 % (GR / 2)), ilo = r0_of(2 * irp), ihi = r0_of(2 * irp + 1) + 7, ii_ = ilo, gI = 0;
#define ATT_ADV() do { if (++ii_ > ihi) { ++iu; ++irp; if (iu < UPW) { ilo = r0_of(2 * irp); ihi = r0_of(2 * irp + 1) + 7; ii_ = ilo; } } } while (0)
    for (int d = 0; d < 2; ++d) if (iu < UPW) { ATT_ISSUE(ii_, gI % NSLOT); ATT_ADV(); ++gI; }
    int gC = 0;
    for (int ku = 0; ku < UPW; ++ku) {
        const int rp = (u0 % (GR / 2)) + ku, qr = 2 * rp + (wid >> 2), r0w = r0_of(qr), lo = r0_of(2 * rp), hi = r0_of(2 * rp + 1) + 7;
        const size_t qrow = (size_t)b * SEQ + (size_t)qr * GW + cq;
        bf16x8 qf[4]; float ssq = 0.f;
#pragma unroll
        for (int ks = 0; ks < 4; ++ks) { qf[ks] = *(const bf16x8*)(qkv + qrow * NQKV + h * HD + 32 * ks + 8 * fq);
#pragma unroll
            for (int e = 0; e < 8; ++e) { const float f = bf2f((unsigned short)qf[ks][e]); ssq += f * f; } }
        ssq += __shfl_xor(ssq, 16); ssq += __shfl_xor(ssq, 32);
        const float Mq = sqrtf(ssq) * KB + maxbias;
        f32x4 O[8]; float lsum = 0.f;
#pragma unroll
        for (int dt = 0; dt < 8; ++dt) O[dt] = (f32x4){0.f, 0.f, 0.f, 0.f};
        for (int i = lo; i <= hi; ++i) {
            if (gI > gC + 1) asm volatile("s_waitcnt vmcnt(4)" ::: "memory"); else asm volatile("s_waitcnt vmcnt(0)" ::: "memory");
            __builtin_amdgcn_s_barrier();
            if (iu < UPW) { ATT_ISSUE(ii_, gI % NSLOT); ATT_ADV(); ++gI; }
            if (i >= r0w && i <= r0w + 7) {
                const int slot = gC % NSLOT; const int dr = i - qr;
                LAS unsigned char* sk = lds + slot * SLOT;
                f32x4 s[2];
#pragma unroll
                for (int t = 0; t < 2; ++t) { s[t] = (f32x4){0.f, 0.f, 0.f, 0.f};
#pragma unroll
                    for (int ks = 0; ks < 4; ++ks) { const bf16x8 kf = *(const LAS bf16x8*)(sk + (koff[t] & 0xffffu) + ((((unsigned)(4 * ks + fq)) ^ (koff[t] >> 16)) << 4));
                        s[t] = __builtin_amdgcn_mfma_f32_16x16x32_bf16(kf, qf[ks], s[t], 0, 0, 0); } }
                const LAS float* bt = (const LAS float*)(lds + OFF_BIAS) + BIAS_SLACK + (dr + 7) * 31 + cb;
                float p[8];
#pragma unroll
                for (int t = 0; t < 2; ++t)
#pragma unroll
                    for (int e = 0; e < 4; ++e) { const float v = __builtin_amdgcn_exp2f(s[t][e] + bt[4 * t + e] - Mq); p[4 * t + e] = ((vmask >> (4 * t + e)) & 1u) ? v : 0.f; lsum += p[4 * t + e]; }
                u32x4 pw; pw.x = cvt_pk_bf16(p[0], p[1]); pw.y = cvt_pk_bf16(p[2], p[3]); pw.z = cvt_pk_bf16(p[4], p[5]); pw.w = cvt_pk_bf16(p[6], p[7]);
                const bf16x8 pf = __builtin_bit_cast(bf16x8, pw);
                const unsigned vb = (unsigned)(size_t)(sk + 16384);
#pragma unroll
                for (int hb = 0; hb < 2; ++hb) {
                    bf16x4 v0[4], v1[4];
#pragma unroll
                    for (int d4 = 0; d4 < 4; ++d4) { const int dt = 4 * hb + d4;
                        v0[d4] = tr_read(vb + vrow[0] + 16u * (((unsigned)(2 * dt + (tp >> 1))) ^ vsw[0]));
                        v1[d4] = tr_read(vb + vrow[1] + 16u * (((unsigned)(2 * dt + (tp >> 1))) ^ vsw[1])); }
                    asm volatile("s_waitcnt lgkmcnt(0)" : "+v"(v0[0]), "+v"(v0[1]), "+v"(v0[2]), "+v"(v0[3]), "+v"(v1[0]), "+v"(v1[1]), "+v"(v1[2]), "+v"(v1[3]) :: "memory");
#pragma unroll
                    for (int d4 = 0; d4 < 4; ++d4) { bf16x8 vf; vf[0] = v0[d4][0]; vf[1] = v0[d4][1]; vf[2] = v0[d4][2]; vf[3] = v0[d4][3]; vf[4] = v1[d4][0]; vf[5] = v1[d4][1]; vf[6] = v1[d4][2]; vf[7] = v1[d4][3];
                        O[4 * hb + d4] = __builtin_amdgcn_mfma_f32_16x16x32_bf16(vf, pf, O[4 * hb + d4], 0, 0, 0); }
                }
            }
            ++gC;
        }
        meta_step(lds, qf, Mq, O, lsum, fr, fq, lane);
        lsum += __shfl_xor(lsum, 16); lsum += __shfl_xor(lsum, 32);
        const float inv = 1.0f / lsum;
#pragma unroll
        for (int dt = 0; dt < 8; ++dt) { const f32x4 v = O[dt] * (inv * SC_O8);
            *(unsigned*)((unsigned char*)o + qrow * D + h * HD + 16 * dt + 4 * fq) = pk4_i8(v[0], v[1], v[2], v[3]); }
    }
    VM_WAIT();
    __syncthreads();
#undef ATT_ISSUE
#undef ATT_ADV
}
}


constexpr int NPHASES = 17;
struct Args { const float* in[22]; float* out; unsigned char* ws; int ph_lo, ph_hi; };
static_assert(sizeof(Args) == 22 * 8 + 8 + 8 + 8, "Args has no padding");
enum { I_X = 0, I_META, I_ATTN_NORM, I_WQKV, I_QGAIN, I_KGAIN, I_RELBIAS, I_METABIAS, I_WO, I_CONV_NORM, I_WIN, I_CONVW, I_WOUT, I_DENSE_NORM, I_WGATE, I_WUP, I_WDOWN,
       I_MOE_NORM, I_WROUTER, I_MGATE, I_MUP, I_MDOWN };

__global__ void __launch_bounds__(NTHREADS, 2) enc_fwd(Args args) {
    extern __shared__ __attribute__((aligned(16))) unsigned char lds_raw[];
    LAS unsigned char* lds = (LAS unsigned char*)lds_raw;
    const int tid = threadIdx.x, lane = tid & 63, wave = __builtin_amdgcn_readfirstlane(tid >> 6);
    const int G = gridDim.x, bid = blockIdx.x;
    const int gw = bid * NWAVES + wave, NGW = G * NWAVES;
    unsigned char* ws = args.ws;
    unsigned* ctl = (unsigned*)(ws + WS_CTL);
    float* out = args.out;
    bf16_t* XA = (bf16_t*)(ws + WS_XA); bf16_t* BIG = (bf16_t*)(ws + WS_BIG); bf16_t* Y1 = (bf16_t*)(ws + WS_Y1);
    unsigned char* XQ = ws + WS_XQ; unsigned char* ACT8 = ws + WS_BIG;
    float* rs1 = (float*)(ws + WS_RS1); float* rs2 = (float*)(ws + WS_RS2); unsigned char* HB1 = ws + WS_XBUF;
    bf16_t* H1B = (bf16_t*)(ws + WS_H1B); bf16_t* H2B = (bf16_t*)(ws + WS_H2B); bf16_t* H3B = H1B; bf16_t* Y0 = H2B;
    float* qkv_m = (float*)(ws + MT_QKV); float* o_m = (float*)(ws + MT_O); float* h1_m = (float*)(ws + MT_H1); float* act_m = (float*)(ws + MT_GU); float* h2_m = (float*)(ws + MT_H2); float* cgu_m = (float*)(ws + MT_CGU);
    int* tok_e = (int*)(ws + MO_TOKE); float* tok_g = (float*)(ws + MO_TOKG); int* cnt = (int*)(ws + MO_CNT); int* rowinfo = (int*)(ws + MO_ROWINFO); float* rowgate = (float*)(ws + MO_ROWGATE); int* tile_e = (int*)(ws + MO_TILEE);

    if (tid < 2) ((LAS unsigned*)(lds + XBW_OFF))[tid] = 0u;
    __syncthreads();
#if MK_N_LAUNCHES == 1
    XcdBarrier bar = xcd_barrier_post(ctl + CW_BAR, (volatile LAS unsigned*)(lds + XBW_OFF));
#define GRID_BAR() xcd_barrier(bar)
#else
#define GRID_BAR() do { } while (0)
#endif
    const int lo = args.ph_lo, hi = args.ph_hi;
#define IN(k) (lo <= (k) && (k) < hi)
#define SEAM(k) do { if (IN((k) + 1)) GRID_BAR(); } while (0)


    if (IN(0)) {
        LAS float* scr = (LAS float*)(lds + wave * 16896);
        constexpr int I_A = (D / 64) * (NQKV / 64), I_B = (D / 64) * (D / 64), I_F = (D / 64) * (FF / 64), I_Dn = (FF / 64) * (D / 64);
        static_assert(I_F == I_Dn, "items");
        constexpr int NITEMS = 2 * I_A + 2 * I_B + 3 * I_F + 3 * NE * I_F;
        for (int it = gw; it < NITEMS; it += NGW) {
            int r = it;
            if (r < I_A) { p0_matrix_i8(args.in[I_WQKV], D, NQKV, ws + W_QKV8, -1, SC_W8, r, scr, lane, nullptr); continue; } r -= I_A;
            if (r < I_B) { p0_matrix_i8(args.in[I_WO], D, D, ws + W_O8, -1, SC_W8, r, scr, lane, nullptr); continue; } r -= I_B;
            if (r < I_F) { p0_matrix_i8(args.in[I_WGATE], D, FF, ws + W_GU8, 0, SC_W8, r, scr, lane, args.in[I_DENSE_NORM]); continue; } r -= I_F;
            if (r < I_F) { p0_matrix_i8(args.in[I_WUP], D, FF, ws + W_GU8, 1, SC_W8, r, scr, lane, args.in[I_DENSE_NORM]); continue; } r -= I_F;
            if (r < I_F) { const int nblk = D / 64, kb = (r / (4 * nblk)) * 4 + (r & 3), nb = (r >> 2) % nblk;
                p0_item_dn<8>(args.in[I_WDOWN], FF, D, (bf16_t*)(ws + W_DN), ws + W_DN8, SC_WDR, 64 * kb, 64 * nb, scr, lane); continue; } r -= I_F;
            if (r < I_A) {
                const int nblk = NQKV / 64, kb = (r / (4 * nblk)) * 4 + (r & 3), nb = (r >> 2) % nblk, n0 = 64 * nb; int drow0;
                if (n0 < D) drow0 = n0; else { const int part = (n0 - D) / D, zc = (n0 - D) % D; drow0 = D + (zc / 128) * 256 + part * 128 + (zc % 128); }
                p0_transpose_item_i8(args.in[I_WIN], D, NQKV, ws + W_IN, 64 * kb, n0, drow0, SC_W8, scr, lane, args.in[I_CONV_NORM]); continue; } r -= I_A;
            if (r < I_B) { const int nblk = D / 64, kb = (r / (4 * nblk)) * 4 + (r & 3), nb = (r >> 2) % nblk;
                p0_item_dn<32>(args.in[I_WOUT], D, D, nullptr, ws + W_OUT, SC_W8, 64 * kb, 64 * nb, scr, lane); continue; } r -= I_B;
            { const int which = r / (NE * I_F), rr = r % (NE * I_F), e = rr / I_F, ri = rr % I_F;
              if (which == 0) p0_matrix_i8(args.in[I_MGATE] + (size_t)e * D * FF, D, FF, ws + W_MGU + (size_t)e * NGU * D, 0, SC_W8, ri, scr, lane, nullptr);
              else if (which == 1) p0_matrix_i8(args.in[I_MUP] + (size_t)e * D * FF, D, FF, ws + W_MGU + (size_t)e * NGU * D, 1, SC_W8, ri, scr, lane, nullptr);
              else p0_matrix8(args.in[I_MDOWN] + (size_t)e * FF * D, FF, D, ws + W_MDN + (size_t)e * D * FF, -1, SC_WDN, ri, scr, lane); }
        }
        rms_rows_to_i8(args.in[I_X], args.in[I_ATTN_NORM], (unsigned char*)XA, gw, NGW, M, lane);
        SEAM(0);
    }
    if (IN(1)) {
        { pg8::Gemm g{XA, ws + W_QKV8, D}; pg8::StaticOrder S; S.init(M, NQKV, G, bid); pg8::EpiQKV E{BIG, NQKV, 1.0f / (SC_A8 * SC_W8), args.in[I_QGAIN], args.in[I_KGAIN], (LAS float*)(lds + MISC_OFF)};
          pg8::gemm_phase<pg8::EpiQKV, pg8::StaticOrder, 8>(lds, g, S, E); }
        { LAS float* rs = (LAS float*)(lds + 8192); meta_rstd(args.in[I_META], rs, wave, lane);
          FNorm A{args.in[I_META], args.in[I_ATTN_NORM], rs, D}; EStoreC<3> E{qkv_m, NQKV};
          meta_gemm_mc<1, 3>(ws + W_QKV8, D, NQKV / 3, 1.0f / SC_W8, A, CMCons<3>{}, E, gw, NGW, lane); }
        SEAM(1);
    }
    if (IN(3)) {
        att::attn_phase(lds, BIG, qkv_m, args.in[I_QGAIN], args.in[I_KGAIN], args.in[I_RELBIAS], args.in[I_METABIAS], XA, o_m, G, bid);
        SEAM(3);
    }
    if (IN(4)) {
        { pg8::Gemm g{XA, ws + W_O8, D}; pg8::StaticOrder S; S.init(M, D, G, bid); pg8::EpiResidNormB<false> E{args.in[I_X], H1B, HB1, rs1, D, (LAS float*)(lds + MISC_OFF), 1.0f / (SC_O8 * SC_W8), SC_A8};
          pg8::gemm_phase<pg8::EpiResidNormB<false>, pg8::StaticOrder, 8>(lds, g, S, E); }
        { FCvt A{o_m, D}; EResidC<1> E{args.in[I_META], h1_m, D}; meta_gemm_mc<1, 1>(ws + W_O8, D, D, 1.0f / SC_W8, A, CMCons<1>{}, E, gw, NGW, lane); }
        SEAM(4);
    }
    if (IN(6)) {
        { pg8::Gemm g{HB1, ws + W_GU8, D}; pg8::StaticOrder S; S.init(M, NGU, G, bid); pg8::EpiSwiGLU E{(unsigned char*)BIG, FF, rs1, 1.0f / (SC_A8 * SC_W8), (LAS float*)(lds + MISC_OFF)};
          pg8::gemm_phase<pg8::EpiSwiGLU, pg8::StaticOrder, 8>(lds, g, S, E); }
        { LAS float* rs = (LAS float*)(lds + 8192); meta_rstd(h1_m, rs, wave, lane);
          FNorm A{h1_m, nullptr, rs, D}; ESiluAct E{act_m}; meta_gemm_mc<1, 8>(ws + W_GU8, D, FF / 4, 1.0f / SC_W8, A, CMGateUp{}, E, gw, NGW, lane); }
        SEAM(6);
    }
    if (IN(7)) {
        { pg8::Gemm g{BIG, ws + W_DN8, FF}; pg8::StaticOrder S; S.init(M, D, G, bid); pg8::EpiResidNormB<true> E{H1B, H2B, (unsigned char*)XA, rs2, D, (LAS float*)(lds + MISC_OFF), 1.0f / (SC_ACTR * SC_WDR), SC_A8B};
          pg8::gemm_phase<pg8::EpiResidNormB<true>, pg8::StaticOrder, 8>(lds, g, S, E); }
        if (wave < 4) { FCvt A{act_m, FF}; EResidC<2> E{h1_m, h2_m, D}; meta_gemm_mc<0, 2>(ws + W_DN, FF, D / 2, 1.0f, A, CMCons<2>{}, E, bid * 4 + wave, G * 4, lane); }
        SEAM(7);
    }
    if (IN(9)) {
        { pg8::Gemm g{XA, ws + W_IN, D}; pg8::StaticOrder S; S.init(M, NQKV, G, bid); pg8::EpiWin E{BIG, 2 * D, rs2, 1.0f / (SC_A8B * SC_W8), (LAS float*)(lds + MISC_OFF)};
          pg8::gemm_phase<pg8::EpiWin, pg8::StaticOrder, 8>(lds, g, S, E); }
        { LAS float* rs = (LAS float*)(lds + 8192); meta_rstd(h2_m, rs, wave, lane);
          FNorm A{h2_m, nullptr, rs, D}; EStoreC<2> E{cgu_m, 2 * D}; meta_gemm_mc<1, 2>(ws + W_IN + (size_t)D * D, D, D, 1.0f / SC_W8, A, CMCons<2>{}, E, gw, NGW, lane); }
        SEAM(9);
    }
    if (IN(10)) {
        const int cc = tid & 255, half = tid >> 8;
        const float* cw = args.in[I_CONVW] + (size_t)cc * 8 * 3;
        float w0[8], w1[8], w2[8];
#pragma unroll
        for (int e = 0; e < 8; ++e) { w0[e] = cw[3 * e]; w1[e] = cw[3 * e + 1]; w2[e] = cw[3 * e + 2]; }
        const int RPW = M / G;
        const int m0 = bid * RPW + half * (RPW / 2), m1 = m0 + RPW / 2;
#define ldz(m_, z_) ld8bf(BIG + (size_t)(m_) * (2 * D) + D + cc * 8, z_)
        float zp[8], zc[8], zn[8];
        if ((m0 % SEQ) == 0) { const float* gp = cgu_m + (size_t)15 * (2 * D) + (cc * 8 / 128) * 256 + (cc * 8 % 128);
#pragma unroll
            for (int e = 0; e < 8; ++e) zp[e] = gp[e] * gp[128 + e]; }
        else ldz(m0 - 1, zp);
        ldz(m0, zc);
        for (int m = m0; m < m1; m += 4) {
            u32x4 zw[4], bw[4];
#pragma unroll
            for (int i = 0; i < 4; ++i) { const int mm = m + 1 + i, mc = mm < M ? mm : M - 1; zw[i] = *(const u32x4*)(BIG + (size_t)mc * (2 * D) + D + cc * 8);
                if ((mm % SEQ) == 0) zw[i] = (u32x4){0u, 0u, 0u, 0u}; }
#pragma unroll
            for (int i = 0; i < 4; ++i) bw[i] = *(const u32x4*)(BIG + (size_t)(m + i) * (2 * D) + cc * 8);
#pragma unroll
            for (int i = 0; i < 4; ++i) {
                zn[0] = bflo(zw[i].x); zn[1] = bfhi(zw[i].x); zn[2] = bflo(zw[i].y); zn[3] = bfhi(zw[i].y); zn[4] = bflo(zw[i].z); zn[5] = bfhi(zw[i].z); zn[6] = bflo(zw[i].w); zn[7] = bfhi(zw[i].w);
                const float bg[8] = {bflo(bw[i].x), bfhi(bw[i].x), bflo(bw[i].y), bfhi(bw[i].y), bflo(bw[i].z), bfhi(bw[i].z), bflo(bw[i].w), bfhi(bw[i].w)};
                float y[8];
#pragma unroll
                for (int e = 0; e < 8; ++e) y[e] = bg[e] * (zp[e] * w0[e] + zc[e] * w1[e] + zn[e] * w2[e]);
                wht_inlane8(y);
#pragma unroll
                for (int e = 0; e < 8; ++e) { const float o = __shfl_xor(y[e], 1); y[e] = (cc & 1) ? o - y[e] : y[e] + o; }
#pragma unroll
                for (int e = 0; e < 8; ++e) { const float o = __shfl_xor(y[e], 2); y[e] = ((cc & 2) ? o - y[e] : y[e] + o) * (SC_YR * 0.17677669529663687f); }
                u32x2 o; o.x = pk4_i8(y[0], y[1], y[2], y[3]); o.y = pk4_i8(y[4], y[5], y[6], y[7]);
                *(u32x2*)((unsigned char*)XA + (size_t)(m + i) * D + cc * 8) = o;
#pragma unroll
                for (int e = 0; e < 8; ++e) { zp[e] = zc[e]; zc[e] = zn[e]; }
            }
        }
#undef ldz
        SEAM(10);
    }
    if (IN(11)) {
        { pg8::Gemm g{XA, ws + W_OUT, D}; pg8::StaticOrder S; S.init(M, D, G, bid); pg8::EpiResidB E{H2B, H3B, D, 1.0f / (SC_YR * SC_W8)};
          pg8::gemm_phase<pg8::EpiResidB, pg8::StaticOrder, 8>(lds, g, S, E); }
        SEAM(11);
    }
    if (IN(12)) {
        LAS float* wr_t = (LAS float*)lds;
        LAS int* lcnt = (LAS int*)(lds + 65536);
        for (int i = tid; i < D * NE; i += NTHREADS) { const int k = i >> 3, e = i & 7; wr_t[e * D + k] = args.in[I_WROUTER][i]; }
        if (tid < 8) lcnt[tid] = 0;
        __syncthreads();
        const int RPW = M / G, RPV = RPW / NWAVES;
        u32x4 vn[4];
        { const bf16_t* xr0 = H3B + (size_t)(bid * RPW + wave * RPV) * D;
#pragma unroll
          for (int j = 0; j < 4; ++j) vn[j] = *(const u32x4*)(xr0 + 8 * (lane + 64 * j)); }
        for (int rr = 0; rr < RPV; ++rr) {
            const int m = bid * RPW + wave * RPV + rr;
            const float* gain = args.in[I_MOE_NORM];
            f32x4 v[4][2]; float s = 0.f;
#pragma unroll
            for (int j = 0; j < 4; ++j) { v[j][0] = (f32x4){bflo(vn[j].x), bfhi(vn[j].x), bflo(vn[j].y), bfhi(vn[j].y)}; v[j][1] = (f32x4){bflo(vn[j].z), bfhi(vn[j].z), bflo(vn[j].w), bfhi(vn[j].w)}; }
            if (rr + 1 < RPV) { const bf16_t* xr1 = H3B + (size_t)(m + 1) * D;
#pragma unroll
                for (int j = 0; j < 4; ++j) vn[j] = *(const u32x4*)(xr1 + 8 * (lane + 64 * j)); }
#pragma unroll
            for (int j = 0; j < 4; ++j)
                s += (v[j][0].x * v[j][0].x + v[j][0].y * v[j][0].y) + (v[j][0].z * v[j][0].z + v[j][0].w * v[j][0].w) + (v[j][1].x * v[j][1].x + v[j][1].y * v[j][1].y) + (v[j][1].z * v[j][1].z + v[j][1].w * v[j][1].w);
            const float rstd = 1.0f / sqrtf(wave_sum(s) * (1.0f / D) + RMS_EPS);
            float lg[8];
#pragma unroll
            for (int e = 0; e < 8; ++e) lg[e] = 0.f;
#pragma unroll
            for (int j = 0; j < 4; ++j) { const f32x4* gp = (const f32x4*)(gain + 8 * (lane + 64 * j)); const f32x4 a = v[j][0] * rstd * gp[0], b = v[j][1] * rstd * gp[1];
                u32x2 w; w.x = pk4_i8(a.x * SC_A8, a.y * SC_A8, a.z * SC_A8, a.w * SC_A8); w.y = pk4_i8(b.x * SC_A8, b.y * SC_A8, b.z * SC_A8, b.w * SC_A8);
                *(u32x2*)(XQ + (size_t)m * D + 8 * (lane + 64 * j)) = w;
#pragma unroll
                for (int e = 0; e < 8; ++e) { const LAS f32x4* wp = (const LAS f32x4*)(wr_t + e * D + 8 * (lane + 64 * j)); const f32x4 w0 = wp[0], w1 = wp[1];
                    lg[e] += (a.x * w0.x + a.y * w0.y) + (a.z * w0.z + a.w * w0.w) + (b.x * w1.x + b.y * w1.y) + (b.z * w1.z + b.w * w1.w); } }
#pragma unroll
            for (int e = 0; e < 8; ++e) lg[e] = wave_sum(lg[e]);
            int e0 = 0; float l0 = lg[0];
#pragma unroll
            for (int e = 1; e < 8; ++e) if (lg[e] > l0) { l0 = lg[e]; e0 = e; }
            int e1 = -1; float l1 = -3.0e38f;
#pragma unroll
            for (int e = 0; e < 8; ++e) if (e != e0 && lg[e] > l1) { l1 = lg[e]; e1 = e; }
            const float g0 = 1.0f / (1.0f + __expf(l1 - l0)), g1 = 1.0f - g0;
            if (lane == 0) { tok_e[2 * m] = e0; tok_e[2 * m + 1] = e1; tok_g[2 * m] = g0; tok_g[2 * m + 1] = g1; lds_add(&lcnt[e0], 1); lds_add(&lcnt[e1], 1); }
        }
        __syncthreads();
        if (tid < 8) cnt[bid * 8 + tid] = lcnt[tid];
        SEAM(12);
    }
    if (IN(13)) {
        LAS int* tot = (LAS int*)lds; LAS int* pre = tot + 8; LAS int* start = tot + 16; LAS int* wcnt = tot + 32;
        if (tid < 16) tot[tid] = 0;
        __syncthreads();
        if (tid < 256) { const i32x4 a = *(const i32x4*)(cnt + tid * 8), c = *(const i32x4*)(cnt + tid * 8 + 4);
            const int v[8] = {a.x, a.y, a.z, a.w, c.x, c.y, c.z, c.w};
#pragma unroll
            for (int e = 0; e < 8; ++e) { lds_add(&tot[e], v[e]); if (tid < bid) lds_add(&pre[e], v[e]); } }
        __syncthreads();
        if (tid == 0) { int s = 0; for (int e = 0; e < 8; ++e) { start[e] = s; s += (tot[e] + 255) / 256 * 256; } start[8] = s; }
        __syncthreads();
        const int RPW = M / G;
        int my_e = 0, my_tok = 0, my_k = 0; float my_g = 0.f;
        if (tid < 2 * RPW) { my_tok = bid * RPW + (tid >> 1); my_k = tid & 1; my_e = tok_e[2 * my_tok + my_k]; my_g = tok_g[2 * my_tok + my_k]; }
        int rank_in_wave = 0;
        if (tid < 2 * RPW) {
#pragma unroll
            for (int e = 0; e < 8; ++e) { const unsigned long long mk = __ballot(my_e == e); if (my_e == e) rank_in_wave = __popcll(mk & ((1ull << lane) - 1ull)); if (lane == 0) wcnt[wave * 8 + e] = __popcll(mk); }
        }
        __syncthreads();
        if (tid < 2 * RPW) { int r = start[my_e] + pre[my_e] + rank_in_wave; for (int w = 0; w < wave; ++w) r += wcnt[w * 8 + my_e];
            rowinfo[r] = my_tok | (my_k << 16); rowgate[r] = my_g; }
        if (bid == 0) {
            for (int e = 0; e < 8; ++e) { const int a = start[e] + tot[e], z = start[e + 1]; for (int r = a + tid; r < z; r += NTHREADS) { rowinfo[r] = -1; rowgate[r] = 0.f; } }
            const int nt = start[8] / 256;
            for (int t = tid; t < nt; t += NTHREADS) { int e = 0; while (e < 7 && t * 256 >= start[e + 1]) ++e; tile_e[t] = e; }
            if (tid == 0) ctl[CW_NTILES] = (unsigned)nt;
        }
        __syncthreads();
        SEAM(13);
    }
    if (IN(14)) {
        const int ntl = (int)__builtin_amdgcn_readfirstlane(ld_agent(ctl + CW_NTILES));
        LAS int* te = (LAS int*)(lds + MISC_OFF + 16384);
        for (int i = tid; i < ntl; i += NTHREADS) te[i] = tile_e[i];
        __syncthreads();
        if (ntl > 0) { pg8::Gemm g{XQ, ws + W_MGU, D}; pg8::MoeGatherOrder S{ntl, NGU / 256, G, bid, 0, te, false, rowinfo, lds + MISC_OFF}; pg8::EpiSwiGLU8 E{ACT8, FF};
            pg8::gemm_phase<pg8::EpiSwiGLU8, pg8::MoeGatherOrder, 8>(lds, g, S, E); }
        SEAM(14);
    }
    if (IN(15)) {
        const int ntl = (int)__builtin_amdgcn_readfirstlane(ld_agent(ctl + CW_NTILES));
        LAS int* te = (LAS int*)(lds + MISC_OFF + 16384);
        for (int i = tid; i < ntl; i += NTHREADS) te[i] = tile_e[i];
        __syncthreads();
        if (ntl > 0) { pg8::Gemm g{ACT8, ws + W_MDN, FF}; pg8::MoeOrder S{ntl, D / 256, G, bid, 0, te, true, nullptr, nullptr}; pg8::EpiMoeDown E{Y0, Y1, rowinfo, rowgate, 1.0f / (SC_ACT * SC_WDN)};
            pg8::gemm_phase<pg8::EpiMoeDown, pg8::MoeOrder, 0>(lds, g, S, E); }
        SEAM(15);
    }
    if (IN(16)) {
        const size_t n8 = (size_t)M * D / 8;
        for (size_t i = (size_t)bid * NTHREADS + tid; i < n8; i += (size_t)G * NTHREADS) {
            const u32x4 h = *(const u32x4*)(H3B + i * 8), w0 = *(const u32x4*)(Y0 + i * 8), w1 = *(const u32x4*)(Y1 + i * 8); f32x4* o = (f32x4*)(out + i * 8);
            f32x4 a, b;
            a.x = bflo(h.x) + (bflo(w0.x) + bflo(w1.x)); a.y = bfhi(h.x) + (bfhi(w0.x) + bfhi(w1.x)); a.z = bflo(h.y) + (bflo(w0.y) + bflo(w1.y)); a.w = bfhi(h.y) + (bfhi(w0.y) + bfhi(w1.y));
            b.x = bflo(h.z) + (bflo(w0.z) + bflo(w1.z)); b.y = bfhi(h.z) + (bfhi(w0.z) + bfhi(w1.z)); b.z = bflo(h.w) + (bflo(w0.w) + bflo(w1.w)); b.w = bfhi(h.w) + (bfhi(w0.w) + bfhi(w1.w));
            o[0] = a; o[1] = b;
        }
    }
#undef IN
#undef SEAM
}

extern "C" void kernel_launch(void* const* d_in, const int* in_sizes, int n_in, void* d_out, int out_size, void* d_ws, size_t ws_size, hipStream_t stream) {
    static int grid = 0;
    if (grid == 0) {
        if (n_in != 22 || in_sizes[0] != M * D || out_size != M * D || ws_size < WS_END) {
            fprintf(stderr, "kernel_launch: unexpected shapes (n_in %d, in0 %d, out %d, ws %zu < %zu); nothing launched\n", n_in, n_in > 0 ? in_sizes[0] : -1, out_size, ws_size, (size_t)WS_END); grid = -1; return; }
        int dev = 0, cus = 0, per_cu = 0;
        if (hipGetDevice(&dev) != hipSuccess || hipDeviceGetAttribute(&cus, hipDeviceAttributeMultiprocessorCount, dev) != hipSuccess) { grid = -1; return; }
        if (hipFuncSetAttribute((const void*)enc_fwd, hipFuncAttributeMaxDynamicSharedMemorySize, LDS_BYTES) != hipSuccess) { fprintf(stderr, "kernel_launch: hipFuncSetAttribute failed\n"); grid = -1; return; }
        if (hipOccupancyMaxActiveBlocksPerMultiprocessor(&per_cu, (const void*)enc_fwd, NTHREADS, LDS_BYTES) != hipSuccess || per_cu < 1)
            fprintf(stderr, "kernel_launch: note: occupancy query reports %d workgroups per CU\n", per_cu);
        (void)hipGetLastError();
        grid = cus;
        if (grid != 256) { fprintf(stderr, "kernel_launch: built for 256 CUs, device has %d; nothing launched\n", cus); grid = -1; return; }
    }
    if (grid < 0) return;
    if (hipMemsetAsync((char*)d_ws + WS_CTL, 0, CTL_ZERO_BYTES, stream) != hipSuccess) return;
    Args a{};
    for (int i = 0; i < 22; ++i) a.in[i] = (const float*)d_in[i];
    a.out = (float*)d_out; a.ws = (unsigned char*)d_ws;
#if MK_N_LAUNCHES == 1
    a.ph_lo = 0; a.ph_hi = NPHASES;
    hipLaunchKernelGGL(enc_fwd, dim3(grid), dim3(NTHREADS), LDS_BYTES, stream, a);
#else
    for (int p = 0; p < NPHASES; ++p) { a.ph_lo = p; a.ph_hi = p + 1; hipLaunchKernelGGL(enc_fwd, dim3(grid), dim3(NTHREADS), LDS_BYTES, stream, a);
    }
#endif
}
```

```cpp
#include <hip/hip_runtime.h>
#include <cstdio>
#include <cstdint>

#ifndef MK_N_LAUNCHES
#define MK_N_LAUNCHES 1
#endif

#define LAS __attribute__((address_space(3)))
#define GAS __attribute__((address_space(1)))
typedef unsigned short bf16_t;
typedef short bf16x8 __attribute__((ext_vector_type(8)));
typedef short bf16x4 __attribute__((ext_vector_type(4)));
typedef float f32x4 __attribute__((ext_vector_type(4)));
typedef float f32x2 __attribute__((ext_vector_type(2)));
typedef unsigned u32x4 __attribute__((ext_vector_type(4)));
typedef unsigned u32x2 __attribute__((ext_vector_type(2)));
typedef int i32x4 __attribute__((ext_vector_type(4)));
typedef int i32x8 __attribute__((ext_vector_type(8)));

constexpr int D = 2048, NB = 2, SEQ = 16384, M = NB * SEQ, NMETA = 16, NH = 16, HD = 128, GW = 64, GR = 256;
constexpr int FF = 7168, NE = 8, NQKV = 3 * D, NGU = 2 * FF;
constexpr float RMS_EPS = 1e-6f;
constexpr float LOG2E = 1.4426950408889634f;
constexpr int NWAVES = 8, NTHREADS = 512;
constexpr int MAXTILES = 264;

constexpr size_t MiB = 1u << 20;
constexpr size_t WS_CTL = 0, CTL_ZERO_BYTES = 64 * 1024;
constexpr size_t WS_META = 1 * MiB;
constexpr size_t MT_QKV = WS_META, MT_O = MT_QKV + 16 * NQKV * 4, MT_H1 = MT_O + 16 * D * 4, MT_GU = MT_H1 + 16 * D * 4, MT_H2 = MT_GU + 16 * NGU * 4,
                 MT_CGU = MT_H2 + 16 * D * 4, MT_END = MT_CGU + 16 * 2 * D * 4;
static_assert(MT_END <= 3 * MiB, "meta scratch");
constexpr size_t WS_RS1 = 5 * MiB + 512 * 1024, WS_RS2 = WS_RS1 + (size_t)M * 8 * 4;
constexpr size_t WS_MOE = 4 * MiB;
constexpr size_t MO_TOKE = WS_MOE, MO_TOKG = MO_TOKE + (size_t)M * 8, MO_CNT = MO_TOKG + (size_t)M * 8, MO_ROWINFO = MO_CNT + 256 * 8 * 4,
                 MO_ROWGATE = MO_ROWINFO + (size_t)MAXTILES * 256 * 4, MO_TILEE = MO_ROWGATE + (size_t)MAXTILES * 256 * 4, MO_END = MO_TILEE + 2048;
static_assert(MO_END <= 5 * MiB + 512 * 1024, "moe tables");
constexpr size_t WS_WB = 8 * MiB;
constexpr size_t W_QKV = WS_WB, W_O = W_QKV + (size_t)NQKV * D * 2, W_GU = W_O + (size_t)D * D * 2, W_DN = W_GU + (size_t)NGU * D * 2,
                 W_IN = W_DN + (size_t)D * FF * 2, W_OUT = W_IN + (size_t)NQKV * D * 2, W_MGU = W_OUT + (size_t)D * D * 2, W_MDN = W_MGU + (size_t)NE * NGU * D,
                 W_END = W_MDN + (size_t)NE * D * FF;
static_assert(W_END == (8 + 148 + 336) * MiB, "weights");
constexpr size_t WS_XA = W_END;
constexpr size_t WS_BIG = WS_XA + (size_t)M * D * 2;
constexpr size_t WS_XBUF = WS_BIG + (size_t)MAXTILES * 256 * FF;
constexpr size_t W_QKV8 = WS_XBUF + (size_t)MAXTILES * 256 * D;
constexpr size_t W_O8 = W_QKV8 + (size_t)NQKV * D;
constexpr size_t W_GU8 = W_O8 + (size_t)D * D;
constexpr size_t WS_H1B = W_GU8 + (size_t)NGU * D;
constexpr size_t WS_H2B = WS_H1B + (size_t)M * D * 2;
constexpr size_t W_DN8 = WS_H2B + (size_t)M * D * 2;
constexpr size_t WS_END = W_DN8 + (size_t)D * FF;
static_assert((size_t)MAXTILES * 256 * FF >= (size_t)M * FF * 2, "BIG holds the dense act too");
constexpr size_t WS_XQ = WS_XA + (size_t)M * D;
constexpr size_t WS_Y1 = WS_XA;

constexpr int CW_TMO = 0, CW_NTILES = 64, CW_BAR = 4096;

constexpr int RING_BYTES = 131072;
constexpr int MISC_OFF = RING_BYTES;
constexpr int LDS_BYTES = 163840 - 1024;
constexpr int XBW_OFF = LDS_BYTES - 64;

#define RLX_AGENT __ATOMIC_RELAXED, __HIP_MEMORY_SCOPE_AGENT
#define LDS_WAIT() asm volatile("s_waitcnt lgkmcnt(0)" ::: "memory")
#define VM_WAIT() asm volatile("s_waitcnt vmcnt(0)" ::: "memory")
typedef __bf16 bf16v2 __attribute__((ext_vector_type(2)));
__device__ __forceinline__ unsigned cvt_pk_bf16(float lo, float hi) { const f32x2 v = (f32x2){lo, hi}; return __builtin_bit_cast(unsigned, __builtin_convertvector(v, bf16v2)); }
__device__ __forceinline__ float bf2f(unsigned short b) { return __builtin_bit_cast(float, (unsigned)b << 16); }
__device__ __forceinline__ float bflo(unsigned w) { return __builtin_bit_cast(float, w << 16); }
__device__ __forceinline__ float bfhi(unsigned w) { return __builtin_bit_cast(float, w & 0xffff0000u); }
__device__ __forceinline__ float wave_sum(float v) {
#pragma unroll
    for (int o = 1; o < 64; o <<= 1) v += __shfl_xor(v, o);
    return v;
}
__device__ __forceinline__ float wave_max(float v) {
#pragma unroll
    for (int o = 1; o < 64; o <<= 1) v = fmaxf(v, __shfl_xor(v, o));
    return v;
}
__device__ __forceinline__ void ld8bf(const bf16_t* p, float (&z)[8]) { const u32x4 w = *(const u32x4*)p;
    z[0] = bflo(w.x); z[1] = bfhi(w.x); z[2] = bflo(w.y); z[3] = bfhi(w.y); z[4] = bflo(w.z); z[5] = bfhi(w.z); z[6] = bflo(w.w); z[7] = bfhi(w.w); }
__device__ __forceinline__ void lds_add(LAS int* p, int v) { __hip_atomic_fetch_add((int*)p, v, __ATOMIC_RELAXED, __HIP_MEMORY_SCOPE_WORKGROUP); }
__device__ __forceinline__ unsigned ld_agent(const unsigned* p) { return __hip_atomic_load(p, RLX_AGENT); }
__device__ __forceinline__ float ld_agent_f(const float* p) { return __builtin_bit_cast(float, __hip_atomic_load((const unsigned*)p, RLX_AGENT)); }
__device__ __forceinline__ int ld_agent_i(const int* p) { return (int)__hip_atomic_load((const unsigned*)p, RLX_AGENT); }


constexpr float SC_ACT = 8.f, SC_WDN = 64.f;
__device__ __forceinline__ float sat8(float v) { return __builtin_amdgcn_fmed3f(v, -448.f, 448.f); }
__device__ __forceinline__ unsigned pk4_fp8(float a, float b, float c, float d) { int w = 0; w = __builtin_amdgcn_cvt_pk_fp8_f32(sat8(a), sat8(b), w, false); w = __builtin_amdgcn_cvt_pk_fp8_f32(sat8(c), sat8(d), w, true); return (unsigned)w; }

constexpr float SC_A8B = 24.f;
constexpr float SC_A8 = 28.f, SC_W8 = 1536.f;
constexpr float SC_O8 = 160.f;
constexpr float SC_YR = 20.f;
constexpr float SC_ACTR = 32.f, SC_WDR = 2880.f;
__device__ __forceinline__ void wht_inlane8(float (&v)[8]) {
#pragma unroll
    for (int h = 1; h < 8; h <<= 1)
#pragma unroll
        for (int i = 0; i < 8; ++i) if ((i & h) == 0) { const float a = v[i], b = v[i + h]; v[i] = a + b; v[i + h] = a - b; }
}
__device__ __forceinline__ unsigned q8m(float v) { const float MG = 12582912.f; return __builtin_bit_cast(unsigned, __builtin_amdgcn_fmed3f(v + MG, MG - 127.f, MG + 127.f)); }
__device__ __forceinline__ unsigned pk4_i8(float a, float b, float c, float d) {
    const unsigned lo = __builtin_amdgcn_perm(q8m(b), q8m(a), 0x0c0c0400u), hi = __builtin_amdgcn_perm(q8m(d), q8m(c), 0x0c0c0400u);
    return __builtin_amdgcn_perm(hi, lo, 0x05040100u); }

namespace pg8 {
constexpr int BM = 256, BK = 64, HALF = 128, HTB = HALF * BK * 2, STAGE_BYTES = 8 * HTB, NXCD = 8;
__host__ __device__ __forceinline__ int lds_byte(int r, int c) { const int st = (r >> 4) * 2 + (c >> 5), rr = r & 15, cc = c & 31, ob = rr * 64 + cc * 2; return st * 1024 + (ob ^ (((ob >> 9) & 1) << 5)); }
__host__ __device__ __forceinline__ void stage_rc(int b, int& R, int& C) { const int st = b / 1024, sb = b % 1024, swz = sb ^ (((sb >> 9) & 1) << 5); R = (st >> 1) * 16 + swz / 64; C = (st & 1) * 32 + (swz % 64) / 2; }
__host__ __device__ __forceinline__ int perm32(int rho) { const int n = rho >> 4, i = rho & 15; return 8 * (i >> 2) + 4 * n + (i & 3); }

struct Unit { int pm, pn, pb, po, ui; };
struct Gemm { const void* A; const void* Bt; int KB; };

__device__ __forceinline__ bool tile_of(int i, int G, int c, int nM, int nN, int& pm, int& pn) {
    const int WGM = nN <= 24 ? 4 : 8;
    const int nwg = nM * nN; const long L = (long)i * G + c; if (L >= nwg) return false;
    int wgid = (int)L; { const int q = nwg / NXCD, r = nwg % NXCD, xcd = wgid % NXCD, off = wgid / NXCD; wgid = (xcd < r ? xcd * (q + 1) : r * (q + 1) + (xcd - r) * q) + off; }
    const int nig = WGM * nN, gid = wgid / nig, fm = gid * WGM, gsz = (nM - fm) < WGM ? (nM - fm) : WGM;
    pm = fm + ((wgid % nig) % gsz); pn = (wgid % nig) / gsz; return true;
}
struct StaticOrder {
    static constexpr bool GATHER = false;
    int nM, nN, G, c;
    __device__ __forceinline__ void init(int M_, int N_, int G_, int c_) { nM = M_ / BM; nN = N_ / BM; G = G_; c = c_; }
    __device__ __forceinline__ bool next(int i, Unit& u) const { int pm, pn; if (!tile_of(i, G, c, nM, nN, pm, pn)) return false; u.pm = pm; u.pn = pn; u.pb = pn; u.po = pm; return true; }
};
__device__ __forceinline__ int lds_ld_i32(unsigned addr) { int r; asm volatile("ds_read_b32 %0, %1\n\ts_waitcnt lgkmcnt(0)" : "=v"(r) : "v"(addr) : "memory"); return r; }
template <bool GA> struct MoeOrderT {
    static constexpr bool GATHER = GA;
    int nM, nN, G, c, t0; LAS const int* tile_e; bool a_local; const int* rowinfo; LAS unsigned char* gl;
    __device__ __forceinline__ bool next(int i, Unit& u) const {
        int pm, pn; if (!tile_of(i, G, c, nM, nN, pm, pn)) return false;
        const int e = __builtin_amdgcn_readfirstlane(lds_ld_i32((unsigned)(size_t)(tile_e + t0 + pm)));
        u.pn = pn; u.pb = e * nN + pn; u.pm = a_local ? pm : t0 + pm; u.po = a_local ? t0 + pm : pm; return true; }
    __device__ __forceinline__ bool row_tile(int i, int& tile) const { int pm, pn; if (!tile_of(i, G, c, nM, nN, pm, pn)) return false; tile = t0 + pm; return true; }
};
typedef MoeOrderT<false> MoeOrder;
typedef MoeOrderT<true> MoeGatherOrder;

struct EpiStoreBf16 {
    static constexpr bool PERM = true, RS_LDS = false;
    bf16_t* O; int ldc; float sc;
    __device__ __forceinline__ void operator()(const f32x4 (&acc)[2][2][4][2], const Unit& u, int wr, int wc, int fr, int fq) const {
        const int row0 = u.po * BM + wr * 64 + fr, col0 = u.pn * BM + wc * 32 + 8 * fq;
#pragma unroll
        for (int ai = 0; ai < 2; ++ai)
#pragma unroll
            for (int m = 0; m < 4; ++m) { bf16_t* rowp = O + (size_t)(row0 + ai * HALF + m * 16) * ldc + col0;
#pragma unroll
                for (int bj = 0; bj < 2; ++bj) { const f32x4 v0 = acc[ai][bj][m][0] * sc, v1 = acc[ai][bj][m][1] * sc;
                    u32x4 w; w.x = cvt_pk_bf16(v0[0], v0[1]); w.y = cvt_pk_bf16(v0[2], v0[3]); w.z = cvt_pk_bf16(v1[0], v1[1]); w.w = cvt_pk_bf16(v1[2], v1[3]);
                    *(u32x4*)(rowp + bj * HALF) = w; } }
    }
};
struct EpiQKV {
    static constexpr bool PERM = true, RS_LDS = false;
    bf16_t* O; int ldc; float sc; const float* q_gain; const float* k_gain; LAS float* P;
    __device__ __forceinline__ void operator()(const f32x4 (&acc)[2][2][4][2], const Unit& u, int wr, int wc, int fr, int fq) const {
        const int rl0 = wr * 64 + fr, row0 = u.po * BM + rl0, col0 = u.pn * BM + wc * 32 + 8 * fq;
        if (u.pn >= 16) {
#pragma unroll
            for (int ai = 0; ai < 2; ++ai)
#pragma unroll
                for (int m = 0; m < 4; ++m) { bf16_t* rowp = O + (size_t)(row0 + ai * HALF + m * 16) * ldc + col0;
#pragma unroll
                    for (int bj = 0; bj < 2; ++bj) { const f32x4 v0 = acc[ai][bj][m][0] * sc, v1 = acc[ai][bj][m][1] * sc;
                        u32x4 w; w.x = cvt_pk_bf16(v0[0], v0[1]); w.y = cvt_pk_bf16(v0[2], v0[3]); w.z = cvt_pk_bf16(v1[0], v1[1]); w.w = cvt_pk_bf16(v1[2], v1[3]);
                        *(u32x4*)(rowp + bj * HALF) = w; } }
            return;
        }
#pragma unroll
        for (int ai = 0; ai < 2; ++ai)
#pragma unroll
            for (int m = 0; m < 4; ++m)
#pragma unroll
                for (int bj = 0; bj < 2; ++bj) { const f32x4 a = acc[ai][bj][m][0], b = acc[ai][bj][m][1];
                    float ss = (a.x * a.x + a.y * a.y) + (a.z * a.z + a.w * a.w) + (b.x * b.x + b.y * b.y) + (b.z * b.z + b.w * b.w);
                    ss += __shfl_xor(ss, 16); ss += __shfl_xor(ss, 32);
                    if (fq == 0) P[((rl0 + ai * HALF + m * 16) * 2 + bj) * 4 + wc] = ss; }
        asm volatile("s_waitcnt lgkmcnt(0)" ::: "memory"); __builtin_amdgcn_s_barrier(); asm volatile("" ::: "memory");
        const bool isq = u.pn < 8; const float* gn = (isq ? q_gain : k_gain) + wc * 32 + 8 * fq; const float gs = isq ? 0.08838834764831845f * LOG2E : 1.0f;
        const f32x4 g0 = *(const f32x4*)gn * gs, g1 = *(const f32x4*)(gn + 4) * gs;
#pragma unroll
        for (int ai = 0; ai < 2; ++ai)
#pragma unroll
            for (int m = 0; m < 4; ++m) { bf16_t* rowp = O + (size_t)(row0 + ai * HALF + m * 16) * ldc + col0;
#pragma unroll
                for (int bj = 0; bj < 2; ++bj) { const f32x4 q = *(const LAS f32x4*)(P + ((rl0 + ai * HALF + m * 16) * 2 + bj) * 4);
                    const float r = __builtin_amdgcn_rsqf(((q.x + q.y) + (q.z + q.w)) * (sc * sc) * (1.0f / HD) + RMS_EPS) * sc;
                    const f32x4 v0 = acc[ai][bj][m][0] * g0 * r, v1 = acc[ai][bj][m][1] * g1 * r;
                    u32x4 w; w.x = cvt_pk_bf16(v0[0], v0[1]); w.y = cvt_pk_bf16(v0[2], v0[3]); w.z = cvt_pk_bf16(v1[0], v1[1]); w.w = cvt_pk_bf16(v1[2], v1[3]);
                    *(u32x4*)(rowp + bj * HALF) = w; } }
    }
};
template <bool BASE_BF16> struct EpiResidNormB {
    static constexpr bool PERM = true, RS_LDS = false;
    const void* base; bf16_t* ob; unsigned char* hb; float* rsp; int ldc; LAS float* P; float sc; float hsc;
    __device__ __forceinline__ void operator()(const f32x4 (&acc)[2][2][4][2], const Unit& u, int wr, int wc, int fr, int fq) const {
        const int rl0 = wr * 64 + fr, row0 = u.po * BM + rl0, col0 = u.pn * BM + wc * 32 + 8 * fq;
#pragma unroll
        for (int ai = 0; ai < 2; ++ai)
#pragma unroll
            for (int m = 0; m < 4; ++m) { const int row = row0 + ai * HALF + m * 16; const size_t off = (size_t)row * ldc + col0; float ss = 0.f;
#pragma unroll
                for (int bj = 0; bj < 2; ++bj) { f32x4 b0, b1;
                    if constexpr (BASE_BF16) { const u32x4 w = *(const u32x4*)((const bf16_t*)base + off + bj * HALF);
                        b0 = (f32x4){bflo(w.x), bfhi(w.x), bflo(w.y), bfhi(w.y)}; b1 = (f32x4){bflo(w.z), bfhi(w.z), bflo(w.w), bfhi(w.w)}; }
                    else { const f32x4* bp = (const f32x4*)((const float*)base + off + bj * HALF); b0 = bp[0]; b1 = bp[1]; }
                    const f32x4 v0 = b0 + acc[ai][bj][m][0] * sc, v1 = b1 + acc[ai][bj][m][1] * sc;
                    u32x4 w; w.x = cvt_pk_bf16(v0[0], v0[1]); w.y = cvt_pk_bf16(v0[2], v0[3]); w.z = cvt_pk_bf16(v1[0], v1[1]); w.w = cvt_pk_bf16(v1[2], v1[3]);
                    *(u32x4*)(ob + off + bj * HALF) = w;
                    u32x2 q; q.x = pk4_i8(v0[0] * hsc, v0[1] * hsc, v0[2] * hsc, v0[3] * hsc); q.y = pk4_i8(v1[0] * hsc, v1[1] * hsc, v1[2] * hsc, v1[3] * hsc);
                    *(u32x2*)(hb + off + bj * HALF) = q;
                    ss += ((v0.x * v0.x + v0.y * v0.y) + (v0.z * v0.z + v0.w * v0.w)) + ((v1.x * v1.x + v1.y * v1.y) + (v1.z * v1.z + v1.w * v1.w)); }
                ss += __shfl_xor(ss, 16); ss += __shfl_xor(ss, 32);
                if (fq == 0) P[(rl0 + ai * HALF + m * 16) * 4 + wc] = ss; }
        asm volatile("s_waitcnt lgkmcnt(0)" ::: "memory"); __builtin_amdgcn_s_barrier(); asm volatile("" ::: "memory");
        const int t = threadIdx.x;
        if (t < BM) { const LAS f32x4* pp = (const LAS f32x4*)(P + t * 4); const f32x4 q = *pp; rsp[(size_t)(u.po * BM + t) * 8 + u.pn] = (q.x + q.y) + (q.z + q.w); }
    }
};
struct EpiResidB {
    static constexpr bool PERM = true, RS_LDS = false;
    const bf16_t* base; bf16_t* ob; int ldc; float sc;
    __device__ __forceinline__ void operator()(const f32x4 (&acc)[2][2][4][2], const Unit& u, int wr, int wc, int fr, int fq) const {
        const int row0 = u.po * BM + wr * 64 + fr, col0 = u.pn * BM + wc * 32 + 8 * fq;
#pragma unroll
        for (int ai = 0; ai < 2; ++ai)
#pragma unroll
            for (int m = 0; m < 4; ++m) { const size_t off = (size_t)(row0 + ai * HALF + m * 16) * ldc + col0;
#pragma unroll
                for (int bj = 0; bj < 2; ++bj) { const u32x4 b = *(const u32x4*)(base + off + bj * HALF);
                    const f32x4 v0 = (f32x4){bflo(b.x), bfhi(b.x), bflo(b.y), bfhi(b.y)} + acc[ai][bj][m][0] * sc, v1 = (f32x4){bflo(b.z), bfhi(b.z), bflo(b.w), bfhi(b.w)} + acc[ai][bj][m][1] * sc;
                    u32x4 w; w.x = cvt_pk_bf16(v0[0], v0[1]); w.y = cvt_pk_bf16(v0[2], v0[3]); w.z = cvt_pk_bf16(v1[0], v1[1]); w.w = cvt_pk_bf16(v1[2], v1[3]);
                    *(u32x4*)(ob + off + bj * HALF) = w; } }
    }
};
__device__ __forceinline__ void rs_prefetch(const float* rs, LAS float* PR, const Unit& u, int wid, int tid) {
    __builtin_amdgcn_global_load_lds((const unsigned*)(rs + (size_t)(u.po * BM) * 8 + tid * 4), (LAS unsigned*)((LAS unsigned char*)PR + (u.ui & 1) * 8192 + wid * 1024), 16, 0, 0); }
__device__ __forceinline__ float row_rstd8(const LAS float* PR, const Unit& u, int rl) { const LAS f32x4* p = (const LAS f32x4*)(PR + (u.ui & 1) * 2048 + rl * 8); const f32x4 a = p[0], b = p[1];
    return __builtin_amdgcn_rsqf((((a.x + a.y) + (a.z + a.w)) + ((b.x + b.y) + (b.z + b.w))) * (1.0f / D) + RMS_EPS); }
__device__ __forceinline__ float silu_mul(float g, float u) { return g * u * __builtin_amdgcn_rcpf(1.0f + __builtin_amdgcn_exp2f(-g * LOG2E)); }
__device__ __forceinline__ f32x4 silu_mul4(f32x4 g, f32x4 u) {
    const f32x2 ga = (f32x2){g.x, g.y}, gb = (f32x2){g.z, g.w}, ua = (f32x2){u.x, u.y}, ub = (f32x2){u.z, u.w};
    const f32x2 ta = ga * (-LOG2E), tb = gb * (-LOG2E);
    f32x2 ea, eb; ea.x = __builtin_amdgcn_exp2f(ta.x); ea.y = __builtin_amdgcn_exp2f(ta.y); eb.x = __builtin_amdgcn_exp2f(tb.x); eb.y = __builtin_amdgcn_exp2f(tb.y);
    const f32x2 da = ea + 1.0f, db = eb + 1.0f;
    f32x2 ra, rb; ra.x = __builtin_amdgcn_rcpf(da.x); ra.y = __builtin_amdgcn_rcpf(da.y); rb.x = __builtin_amdgcn_rcpf(db.x); rb.y = __builtin_amdgcn_rcpf(db.y);
    const f32x2 oa = (ga * ua) * ra, ob = (gb * ub) * rb;
    return (f32x4){oa.x, oa.y, ob.x, ob.y}; }
struct EpiSwiGLU {
    static constexpr bool PERM = true, RS_LDS = true;
    unsigned char* O; int ldc; const float* rs; float sc; LAS float* PR;
    __device__ __forceinline__ void prefetch(const Unit& u, int wid, int tid) const { rs_prefetch(rs, PR, u, wid, tid); }
    __device__ __forceinline__ void operator()(const f32x4 (&acc)[2][2][4][2], const Unit& u, int wr, int wc, int fr, int fq) const {
        const int row0 = u.po * BM + wr * 64 + fr, col0 = u.pn * HALF + wc * 32 + 8 * fq; const float qs = SC_ACTR * 0.35355339059327373f;
#pragma unroll
        for (int ai = 0; ai < 2; ++ai)
#pragma unroll
            for (int m = 0; m < 4; ++m) { const int row = row0 + ai * HALF + m * 16; unsigned char* rowp = O + (size_t)row * ldc + col0;
                const float r = row_rstd8(PR, u, wr * 64 + fr + ai * HALF + m * 16) * sc;
                const f32x4 g0 = acc[ai][0][m][0] * r, g1 = acc[ai][0][m][1] * r, u0 = acc[ai][1][m][0] * r, u1 = acc[ai][1][m][1] * r;
                const f32x4 s0 = silu_mul4(g0, u0), s1 = silu_mul4(g1, u1);
                float a[8] = {s0[0], s0[1], s0[2], s0[3], s1[0], s1[1], s1[2], s1[3]};
                wht_inlane8(a);
                u32x2 w; w.x = pk4_i8(a[0] * qs, a[1] * qs, a[2] * qs, a[3] * qs); w.y = pk4_i8(a[4] * qs, a[5] * qs, a[6] * qs, a[7] * qs);
                *(u32x2*)rowp = w; }
    }
};
struct EpiWin {
    static constexpr bool PERM = true, RS_LDS = true;
    bf16_t* O; int ldc; const float* rs; float sc; LAS float* PR;
    __device__ __forceinline__ void prefetch(const Unit& u, int wid, int tid) const { rs_prefetch(rs, PR, u, wid, tid); }
    __device__ __forceinline__ void operator()(const f32x4 (&acc)[2][2][4][2], const Unit& u, int wr, int wc, int fr, int fq) const {
        const int row0 = u.po * BM + wr * 64 + fr;
        float rr[2][4];
#pragma unroll
        for (int ai = 0; ai < 2; ++ai)
#pragma unroll
            for (int m = 0; m < 4; ++m) rr[ai][m] = row_rstd8(PR, u, wr * 64 + fr + ai * HALF + m * 16) * sc;
        if (u.pn < 8) {
            const int col0 = u.pn * BM + wc * 32 + 8 * fq;
#pragma unroll
            for (int ai = 0; ai < 2; ++ai)
#pragma unroll
                for (int m = 0; m < 4; ++m) { bf16_t* rowp = O + (size_t)(row0 + ai * HALF + m * 16) * ldc + col0;
#pragma unroll
                    for (int bj = 0; bj < 2; ++bj) { const f32x4 v0 = acc[ai][bj][m][0] * rr[ai][m], v1 = acc[ai][bj][m][1] * rr[ai][m];
                        u32x4 w; w.x = cvt_pk_bf16(v0[0], v0[1]); w.y = cvt_pk_bf16(v0[2], v0[3]); w.z = cvt_pk_bf16(v1[0], v1[1]); w.w = cvt_pk_bf16(v1[2], v1[3]);
                        *(u32x4*)(rowp + bj * HALF) = w; } }
        } else {
            const int col0 = D + (u.pn - 8) * HALF + wc * 32 + 8 * fq;
#pragma unroll
            for (int ai = 0; ai < 2; ++ai)
#pragma unroll
                for (int m = 0; m < 4; ++m) { bf16_t* rowp = O + (size_t)(row0 + ai * HALF + m * 16) * ldc + col0;
                    const float r2 = rr[ai][m] * rr[ai][m]; const f32x4 a0 = acc[ai][0][m][0] * acc[ai][1][m][0] * r2, a1 = acc[ai][0][m][1] * acc[ai][1][m][1] * r2;
                    u32x4 w; w.x = cvt_pk_bf16(a0[0], a0[1]); w.y = cvt_pk_bf16(a0[2], a0[3]); w.z = cvt_pk_bf16(a1[0], a1[1]); w.w = cvt_pk_bf16(a1[2], a1[3]);
                    *(u32x4*)rowp = w; }
        }
    }
};
struct EpiSwiGLU8 {
    static constexpr bool PERM = true, RS_LDS = false;
    unsigned char* O; int ldc;
    __device__ __forceinline__ void operator()(const f32x4 (&acc)[2][2][4][2], const Unit& u, int wr, int wc, int fr, int fq) const {
        const int row0 = u.po * BM + wr * 64 + fr, col0 = u.pn * HALF + wc * 32 + 8 * fq; const float si = 1.0f / (SC_A8 * SC_W8);
#pragma unroll
        for (int ai = 0; ai < 2; ++ai)
#pragma unroll
            for (int m = 0; m < 4; ++m) { unsigned char* rowp = O + (size_t)(row0 + ai * HALF + m * 16) * ldc + col0;
                const f32x4 g0 = acc[ai][0][m][0] * si, g1 = acc[ai][0][m][1] * si, u0 = acc[ai][1][m][0] * (si * SC_ACT), u1 = acc[ai][1][m][1] * (si * SC_ACT);
                const f32x4 s0 = silu_mul4(g0, u0), s1 = silu_mul4(g1, u1);
                u32x2 w; w.x = pk4_fp8(s0[0], s0[1], s0[2], s0[3]); w.y = pk4_fp8(s1[0], s1[1], s1[2], s1[3]);
                __builtin_nontemporal_store(w, (u32x2*)rowp); }
    }
};
struct EpiMoeDown {
    static constexpr bool PERM = true, RS_LDS = false;
    bf16_t* Y0; bf16_t* Y1; const int* rowinfo; const float* rowgate; float osc;
    __device__ __forceinline__ void operator()(const f32x4 (&acc)[2][2][4][2], const Unit& u, int wr, int wc, int fr, int fq) const {
        const int row0 = u.po * BM + wr * 64 + fr, col0 = u.pn * BM + wc * 32 + 8 * fq;
#pragma unroll
        for (int ai = 0; ai < 2; ++ai)
#pragma unroll
            for (int m = 0; m < 4; ++m) { const int r = row0 + ai * HALF + m * 16; const int info = rowinfo[r]; const float g = rowgate[r] * osc;
                if (info >= 0) { const int tok = info & 0xffff; bf16_t* rowp = ((info >> 16) == 0 ? Y0 : Y1) + (size_t)tok * D + col0;
#pragma unroll
                    for (int bj = 0; bj < 2; ++bj) { const f32x4 v0 = acc[ai][bj][m][0] * g, v1 = acc[ai][bj][m][1] * g;
                        u32x4 w; w.x = cvt_pk_bf16(v0[0], v0[1]); w.y = cvt_pk_bf16(v0[2], v0[3]); w.z = cvt_pk_bf16(v1[0], v1[1]); w.w = cvt_pk_bf16(v1[2], v1[3]);
                        *(u32x4*)(rowp + bj * HALF) = w; } } }
    }
};

template <class Epi, class Sched, int FMT = -1>
__device__ __forceinline__ void gemm_phase(LAS unsigned char* lds, const Gemm g, const Sched& S, const Epi& E) {
    const int tid = threadIdx.x, wid = __builtin_amdgcn_readfirstlane(tid >> 6), lane = tid & 63, wr = wid >> 2, wc = wid & 3, fr = lane & 15, fq = lane >> 4;
    const int KB = g.KB, nt = KB / (BK * 2);
    constexpr bool GA = Sched::GATHER;
    unsigned voffA, voffB; int gR, gC2;
    { int R, C; stage_rc(tid * 16, R, C); const int Rb = Epi::PERM ? ((R & ~31) + perm32(R & 31)) : R; voffA = (unsigned)(R * KB + C * 2); voffB = (unsigned)(Rb * KB + C * 2); gR = R; gC2 = C * 2; }
    const size_t pstep = (size_t)64 * KB;
    const size_t kstep = (size_t)(BK * 2);
    const size_t hstep = (size_t)HALF * KB;
    const size_t tstep = 2 * hstep;
    const size_t hstepA = GA ? 0 : hstep;
    const unsigned ldsw = (unsigned)wid * 1024u;
    const int aoff = lds_byte(wr * 64 + fr, fq * 8), boff = lds_byte(wc * 32 + fr, fq * 8);
#define PG8_SA(b, h) (((b) * 2 + (h)) * HTB)
#define PG8_SB(b, h) ((4 + (b) * 2 + (h)) * HTB)
#define PG8_STAGE2(bufoff, gbase, v0, v1, pst) do { _Pragma("unroll") for (int _i = 0; _i < 2; ++_i) { unsigned _vo = _i ? (v1) : (v0); asm volatile("" : "+v"(_vo)); \
        const char* _gb = (const char*)(gbase) + _i * (pst); asm volatile("" : "+s"(_gb)); \
        __builtin_amdgcn_global_load_lds((const unsigned*)(_gb + _vo), (LAS unsigned*)(lds + (bufoff) + ldsw + _i * 8192), 16, 0, 0); } } while (0)
#define PG8_STAGE(bufoff, gbase, voff) PG8_STAGE2(bufoff, gbase, voff, voff, pstep)
#define PG8_STAGE_A(bufoff, gbase, h, nx) do { if constexpr (GA) PG8_STAGE2(bufoff, gbase, ((nx) ? vn[h][0] : vc[h][0]), ((nx) ? vn[h][1] : vc[h][1]), 0); else PG8_STAGE2(bufoff, gbase, voffA, voffA, pstep); } while (0)
#define PG8_GISSUE(tile, slot) __builtin_amdgcn_global_load_lds((const unsigned*)(S.rowinfo + (size_t)(tile) * 256 + lane * 4), (LAS unsigned*)(S.gl + wid * 2048 + (slot) * 1024), 16, 0, 0)
#define PG8_GREAD(dst, slot) do { _Pragma("unroll") for (int _h = 0; _h < 2; ++_h) _Pragma("unroll") for (int _i = 0; _i < 2; ++_i) { \
        const int _info = lds_ld_i32((unsigned)(size_t)(S.gl + wid * 2048 + (slot) * 1024) + (unsigned)((_h * 128 + _i * 64 + gR) * 4)); \
        dst[_h][_i] = (unsigned)((_info < 0 ? 0 : (_info & 0xffff)) * KB + gC2); } } while (0)
#define PG8_LDA(dst, b, h) do { _Pragma("unroll") for (int m = 0; m < 4; ++m) { dst[m].lo = *(const LAS i32x4*)(lds + PG8_SA(b, h) + aoff + m * 2048); dst[m].hi = *(const LAS i32x4*)(lds + PG8_SA(b, h) + aoff + m * 2048 + 1024); } } while (0)
#define PG8_LDB(dst, b, h) do { _Pragma("unroll") for (int n = 0; n < 2; ++n) { dst[n].lo = *(const LAS i32x4*)(lds + PG8_SB(b, h) + boff + n * 2048); dst[n].hi = *(const LAS i32x4*)(lds + PG8_SB(b, h) + boff + n * 2048 + 1024); } } while (0)
#define PG8_MMA(ai, bj, At, Bt) do { __builtin_amdgcn_s_setprio(1); _Pragma("unroll") for (int m = 0; m < 4; ++m) _Pragma("unroll") for (int n = 0; n < 2; ++n) { \
        if constexpr (FMT == 0) acc[ai][bj][m][n] = __builtin_amdgcn_mfma_scale_f32_16x16x128_f8f6f4(Bt[n], At[m], acc[ai][bj][m][n], 0, 0, 0, 0x7f7f7f7f, 0, 0x7f7f7f7f); \
        else if constexpr (FMT == 8) { const i32x4 _bl = Bt[n].lo, _bh = Bt[n].hi, _al = At[m].lo, _ah = At[m].hi; i32x4 _c = __builtin_bit_cast(i32x4, acc[ai][bj][m][n]); \
               _c = __builtin_amdgcn_mfma_i32_16x16x64_i8(_bl, _al, _c, 0, 0, 0); _c = __builtin_amdgcn_mfma_i32_16x16x64_i8(_bh, _ah, _c, 0, 0, 0); acc[ai][bj][m][n] = __builtin_bit_cast(f32x4, _c); } \
        else { const i32x4 _bl = Bt[n].lo, _bh = Bt[n].hi, _al = At[m].lo, _ah = At[m].hi; \
               acc[ai][bj][m][n] = __builtin_amdgcn_mfma_f32_16x16x32_bf16(__builtin_bit_cast(bf16x8, _bl), __builtin_bit_cast(bf16x8, _al), acc[ai][bj][m][n], 0, 0, 0); \
               acc[ai][bj][m][n] = __builtin_amdgcn_mfma_f32_16x16x32_bf16(__builtin_bit_cast(bf16x8, _bh), __builtin_bit_cast(bf16x8, _ah), acc[ai][bj][m][n], 0, 0, 0); } } __builtin_amdgcn_s_setprio(0); } while (0)
#define PG8_WAIT_V(n) asm volatile("s_waitcnt vmcnt(" #n ")" ::: "memory")
#define PG8_WAIT_L(n) asm volatile("s_waitcnt lgkmcnt(" #n ")" ::: "memory")
#define PG8_BAR __builtin_amdgcn_s_barrier()
#define PG8_SCHED __builtin_amdgcn_sched_barrier(0)
    Unit cur, nxt; int ui = 0;
    if (!S.next(0, cur)) return;
    cur.ui = 0;
    if constexpr (Epi::RS_LDS) E.prefetch(cur, wid, tid);
    f32x4 acc[2][2][4][2];
#pragma unroll
    for (int a = 0; a < 2; ++a)
#pragma unroll
        for (int b = 0; b < 2; ++b)
#pragma unroll
            for (int m = 0; m < 4; ++m)
#pragma unroll
                for (int n = 0; n < 2; ++n) { typedef unsigned long long u64x2_t __attribute__((ext_vector_type(2))); u64x2_t z_; asm volatile("v_mov_b64 %0, 0" : "=v"(z_.x)); asm volatile("v_mov_b64 %0, 0" : "=v"(z_.y)); acc[a][b][m][n] = __builtin_bit_cast(f32x4, z_); }
    i32x8 At[4], B0[2], B1[2];
    unsigned vc[2][2], vn[2][2];
    if constexpr (GA) { int t1; PG8_GISSUE(cur.pm, 0); if (S.row_tile(1, t1)) PG8_GISSUE(t1, 1); asm volatile("s_waitcnt vmcnt(0)" ::: "memory"); PG8_GREAD(vc, 0);
#pragma unroll
        for (int h = 0; h < 2; ++h) { vn[h][0] = vc[h][0]; vn[h][1] = vc[h][1]; } }
    const char* cA = GA ? (const char*)g.A : (const char*)g.A + (size_t)cur.pm * tstep; const char* cB = (const char*)g.Bt + (size_t)cur.pb * tstep;
    PG8_STAGE(PG8_SB(0, 0), cB, voffB); PG8_STAGE(PG8_SB(0, 1), cB + hstep, voffB); PG8_STAGE_A(PG8_SA(0, 0), cA, 0, false); PG8_STAGE_A(PG8_SA(0, 1), cA + hstepA, 1, false);
    if (wr == 1) PG8_BAR;
    PG8_WAIT_V(2); PG8_BAR;
    PG8_STAGE(PG8_SB(1, 0), cB + kstep, voffB); PG8_STAGE_A(PG8_SA(1, 0), cA + kstep, 0, false); PG8_STAGE(PG8_SB(1, 1), cB + hstep + kstep, voffB);
    PG8_WAIT_V(6); PG8_BAR;
    for (;;) {
        const bool has_next = S.next(ui + 1, nxt); nxt.ui = ui + 1;
        if constexpr (GA) { if (has_next) PG8_GREAD(vn, (ui + 1) & 1); int t2; if (S.row_tile(ui + 2, t2)) PG8_GISSUE(t2, ui & 1); }
        const char* nA = GA ? cA : (has_next ? (const char*)g.A + (size_t)nxt.pm * tstep : cA); const char* nB = has_next ? (const char*)g.Bt + (size_t)nxt.pb * tstep : cB;
        for (int t = 0; t < nt; t += 2) {
            const bool last = (t == nt - 2);
            const char* a1 = cA + (size_t)(t + 1) * kstep;
            const char* a2 = last ? nA : cA + (size_t)(t + 2) * kstep; const char* b2 = last ? nB : cB + (size_t)(t + 2) * kstep;
            const char* a3 = a2 + kstep; const char* b3 = b2 + kstep;
            PG8_LDB(B0, 0, 0); PG8_LDB(B1, 0, 1); PG8_SCHED; PG8_LDA(At, 0, 0); PG8_STAGE_A(PG8_SA(1, 1), a1 + hstepA, 1, false);
            PG8_WAIT_V(8); PG8_WAIT_L(0); PG8_BAR; PG8_MMA(0, 0, At, B0); PG8_MMA(0, 1, At, B1); PG8_BAR; PG8_SCHED;
            PG8_LDA(At, 0, 1); PG8_STAGE(PG8_SB(0, 0), b2, voffB); PG8_STAGE(PG8_SB(0, 1), b2 + hstep, voffB); PG8_STAGE_A(PG8_SA(0, 0), a2, 0, last);
            PG8_WAIT_V(8); PG8_WAIT_L(0); PG8_BAR; PG8_MMA(1, 0, At, B0); PG8_MMA(1, 1, At, B1); PG8_BAR; PG8_SCHED;
            PG8_LDB(B0, 1, 0); PG8_LDB(B1, 1, 1); PG8_SCHED; PG8_LDA(At, 1, 0); PG8_STAGE_A(PG8_SA(0, 1), a2 + hstepA, 1, last);
            PG8_WAIT_V(8); PG8_WAIT_L(0); PG8_BAR; PG8_MMA(0, 0, At, B0); PG8_MMA(0, 1, At, B1); PG8_BAR; PG8_SCHED;
            PG8_LDA(At, 1, 1); PG8_STAGE(PG8_SB(1, 0), b3, voffB); PG8_STAGE(PG8_SB(1, 1), b3 + hstep, voffB); PG8_STAGE_A(PG8_SA(1, 0), a3, 0, last);
            PG8_WAIT_V(8); PG8_WAIT_L(0); PG8_BAR; PG8_MMA(1, 0, At, B0); PG8_MMA(1, 1, At, B1); PG8_BAR; PG8_SCHED;
        }
        if (wr == 0) PG8_BAR;
        if constexpr (FMT == 8) {
#pragma unroll
            for (int a = 0; a < 2; ++a)
#pragma unroll
                for (int b = 0; b < 2; ++b)
#pragma unroll
                    for (int m = 0; m < 4; ++m)
#pragma unroll
                        for (int n = 0; n < 2; ++n) acc[a][b][m][n] = __builtin_convertvector(__builtin_bit_cast(i32x4, acc[a][b][m][n]), f32x4); }
        E(acc, cur, wr, wc, fr, fq);
        if (!has_next) break;
        if constexpr (Epi::RS_LDS) E.prefetch(nxt, wid, tid);
#pragma unroll
        for (int a = 0; a < 2; ++a)
#pragma unroll
            for (int b = 0; b < 2; ++b)
#pragma unroll
                for (int m = 0; m < 4; ++m)
#pragma unroll
                    for (int n = 0; n < 2; ++n) { typedef unsigned long long u64x2_t __attribute__((ext_vector_type(2))); u64x2_t z_; asm volatile("v_mov_b64 %0, 0" : "=v"(z_.x)); asm volatile("v_mov_b64 %0, 0" : "=v"(z_.y)); acc[a][b][m][n] = __builtin_bit_cast(f32x4, z_); }
        cur = nxt; cA = nA; cB = nB; ++ui;
        if constexpr (GA) {
#pragma unroll
            for (int h = 0; h < 2; ++h) { vc[h][0] = vn[h][0]; vc[h][1] = vn[h][1]; } }
        if (wr == 1) PG8_BAR;
    }
    PG8_WAIT_V(0);
    PG8_BAR;
#undef PG8_SA
#undef PG8_SB
#undef PG8_STAGE
#undef PG8_STAGE2
#undef PG8_STAGE_A
#undef PG8_GISSUE
#undef PG8_GREAD
#undef PG8_LDA
#undef PG8_LDB
#undef PG8_MMA
#undef PG8_WAIT_V
#undef PG8_WAIT_L
#undef PG8_BAR
#undef PG8_SCHED
}
}

#define XB_TMO      128
#define XB_XCNT(j)  (256  + 64 * (j))
#define XB_XSUB(j)  (1280 + 64 * (j))
#define XB_XGEN(j)  (2304 + 64 * (j))
#define XB_TOP      3328
#define XB_TOPGEN   3392
#define XCD_BAR_WORDS 3456
#define XB_SPIN_CAP (1u << 20)
__device__ __forceinline__ unsigned xb_ld(unsigned* p)              { return __hip_atomic_load(p, __ATOMIC_RELAXED, __HIP_MEMORY_SCOPE_AGENT); }
__device__ __forceinline__ unsigned xb_add(unsigned* p, unsigned v) { return __hip_atomic_fetch_add(p, v, __ATOMIC_RELAXED, __HIP_MEMORY_SCOPE_AGENT); }
__device__ __forceinline__ unsigned xb_xcc_id() { return (unsigned)__builtin_amdgcn_s_getreg((3 << 11) | 20) & 0xFu; }
#define XB_SPIN(cond, bar) do { unsigned _sp = 0; while (cond) { __builtin_amdgcn_s_sleep(1); \
    if ((++_sp & 255u) == 0u) { if (xb_ld(&(bar)[XB_TMO])) break; if (_sp > XB_SPIN_CAP) { atomicAdd(&(bar)[XB_TMO], 1u); break; } } } } while (0)
struct XcdBarrier { unsigned* bar; unsigned x; volatile LAS unsigned* st; };
__device__ __forceinline__ XcdBarrier xcd_barrier_post(unsigned* bar, volatile LAS unsigned* st) {
    XcdBarrier b; b.bar = bar; b.x = xb_xcc_id(); b.st = st;
    if (threadIdx.x == 0) (void)xb_add(&bar[XB_XCNT(b.x)], 1u);
    return b;
}
__device__ __forceinline__ void xcd_barrier_complete(unsigned* bar, unsigned x, unsigned& nloc, unsigned& nx) {
    const unsigned G = gridDim.x * gridDim.y * gridDim.z;
    unsigned sum, cnt, mine, sp = 0u;
    for (;;) {
        sum = 0u; cnt = 0u; mine = 0u;
#pragma unroll
        for (unsigned j = 0; j < 16; ++j) { const unsigned c = xb_ld(&bar[XB_XCNT(j)]); sum += c; cnt += (c > 0u) ? 1u : 0u; mine = (j == x) ? c : mine; }
        if (sum == G) break;
        __builtin_amdgcn_s_sleep(1);
        if ((++sp & 255u) == 0u) { if (xb_ld(&bar[XB_TMO])) break; if (sp > XB_SPIN_CAP) { atomicAdd(&bar[XB_TMO], 1u); break; } }
    }
    nloc = mine > 0u ? mine : 1u; nx = cnt > 0u ? cnt : 1u;
}
__device__ __forceinline__ void xcd_barrier(const XcdBarrier& b) {
    asm volatile("s_waitcnt vmcnt(0)" ::: "memory");
    __syncthreads();
    if (threadIdx.x == 0) {
        unsigned* bar = b.bar;
        __builtin_amdgcn_s_waitcnt(0);
        unsigned nloc = b.st[0], nx = b.st[1];
        if (nloc == 0u) { xcd_barrier_complete(bar, b.x, nloc, nx); b.st[0] = nloc; b.st[1] = nx; }
        const unsigned old = xb_add(&bar[XB_XSUB(b.x)], 1u);
        const unsigned gen = old / nloc;
        if (old + 1u == (gen + 1u) * nloc) {
            __builtin_amdgcn_fence(__ATOMIC_RELEASE, "agent");
            asm volatile("s_waitcnt vmcnt(0)" ::: "memory");
            const unsigned og = xb_add(&bar[XB_TOP], 1u);
            const unsigned tg = og / nx;
            if (og + 1u == (tg + 1u) * nx) xb_add(&bar[XB_TOPGEN], 1u);
            else XB_SPIN(xb_ld(&bar[XB_TOPGEN]) == tg, bar);
            __builtin_amdgcn_fence(__ATOMIC_ACQUIRE, "agent");
            xb_add(&bar[XB_XGEN(b.x)], 1u);
            asm volatile("s_waitcnt vmcnt(0)" ::: "memory");
        } else {
            XB_SPIN(xb_ld(&bar[XB_XGEN(b.x)]) == gen, bar);
            __builtin_amdgcn_fence(__ATOMIC_ACQUIRE, "agent");
            asm volatile("s_waitcnt vmcnt(0)" ::: "memory");
        }
    }
    __syncthreads();
}

constexpr int P0S = 65;
__device__ __forceinline__ void p0_load_tile(const float* W, int N, int k0, int n0, LAS float* scr, int lane, const float* kgain = nullptr) {
    f32x4 v[16];
#pragma unroll
    for (int i = 0; i < 16; ++i) v[i] = *(const f32x4*)(W + (size_t)(k0 + 4 * i + (lane >> 4)) * N + n0 + 4 * (lane & 15));
    if (kgain) {
#pragma unroll
        for (int i = 0; i < 16; ++i) v[i] = v[i] * kgain[k0 + 4 * i + (lane >> 4)]; }
#pragma unroll
    for (int i = 0; i < 16; ++i) { LAS float* d = scr + (4 * i + (lane >> 4)) * P0S + 4 * (lane & 15); d[0] = v[i].x; d[1] = v[i].y; d[2] = v[i].z; d[3] = v[i].w; }
    LDS_WAIT(); asm volatile("" ::: "memory");
}
__device__ __forceinline__ void p0_transpose_item(const float* W, int K, int N, bf16_t* WT, int k0, int n0, int drow0, LAS float* scr, int lane, const float* kgain = nullptr) {
    p0_load_tile(W, N, k0, n0, scr, lane, kgain);
    const int c = lane & 7;
#pragma unroll
    for (int j = 0; j < 8; ++j) { const int n = (lane >> 3) + 8 * j; const LAS float* s = scr + (8 * c) * P0S + n;
        u32x4 o; o.x = cvt_pk_bf16(s[0 * P0S], s[1 * P0S]); o.y = cvt_pk_bf16(s[2 * P0S], s[3 * P0S]); o.z = cvt_pk_bf16(s[4 * P0S], s[5 * P0S]); o.w = cvt_pk_bf16(s[6 * P0S], s[7 * P0S]);
        *(u32x4*)(WT + (size_t)(drow0 + n) * K + k0 + 8 * c) = o; }
    LDS_WAIT(); asm volatile("" ::: "memory");
}
template <int BLK>
__device__ __forceinline__ void p0_item_dn(const float* W, int K, int N, bf16_t* WT  , unsigned char* WT8, float wsc, int k0, int n0, LAS float* scr, int lane) {
    p0_load_tile(W, N, k0, n0, scr, lane, nullptr);
    if (WT) { const int c = lane & 7;
#pragma unroll
      for (int j = 0; j < 8; ++j) { const int n = (lane >> 3) + 8 * j; const LAS float* s = scr + (8 * c) * P0S + n;
          u32x4 o; o.x = cvt_pk_bf16(s[0 * P0S], s[1 * P0S]); o.y = cvt_pk_bf16(s[2 * P0S], s[3 * P0S]); o.z = cvt_pk_bf16(s[4 * P0S], s[5 * P0S]); o.w = cvt_pk_bf16(s[6 * P0S], s[7 * P0S]);
          *(u32x4*)(WT + (size_t)(n0 + n) * K + k0 + 8 * c) = o; } }
    { const int c = lane & 3; const float sc = wsc * (BLK == 32 ? 0.17677669529663687f : 0.35355339059327373f);
#pragma unroll
      for (int j = 0; j < 4; ++j) { const int n = (lane >> 2) + 16 * j; const LAS float* s = scr + (16 * c) * P0S + n;
          float f[16];
#pragma unroll
          for (int e = 0; e < 16; ++e) f[e] = s[e * P0S];
#pragma unroll
          for (int h = 1; h < (BLK == 32 ? 16 : 8); h <<= 1)
#pragma unroll
              for (int i = 0; i < 16; ++i) if ((i & h) == 0) { const float a = f[i], b = f[i + h]; f[i] = a + b; f[i + h] = a - b; }
#pragma unroll
          for (int e = 0; e < 16; ++e) { if constexpr (BLK == 32) { const float o = __shfl_xor(f[e], 1); f[e] = ((c & 1) ? o - f[e] : f[e] + o) * sc; } else f[e] *= sc; }
          u32x4 o; o.x = pk4_i8(f[0], f[1], f[2], f[3]); o.y = pk4_i8(f[4], f[5], f[6], f[7]); o.z = pk4_i8(f[8], f[9], f[10], f[11]); o.w = pk4_i8(f[12], f[13], f[14], f[15]);
          *(u32x4*)(WT8 + (size_t)(n0 + n) * K + k0 + 16 * c) = o; } }
    LDS_WAIT(); asm volatile("" ::: "memory");
}
__device__ __forceinline__ void p0_matrix(const float* W, int K, int N, bf16_t* WT, int ilv_half  , int r, LAS float* scr, int lane, const float* kgain = nullptr) {
    const int nblk = N / 64, kb = (r / (4 * nblk)) * 4 + (r & 3), nb = (r >> 2) % nblk, n0 = 64 * nb;
    const int drow0 = ilv_half < 0 ? n0 : (n0 / 128) * 256 + ilv_half * 128 + (n0 % 128);
    p0_transpose_item(W, K, N, WT, 64 * kb, n0, drow0, scr, lane, kgain);
}
__device__ __forceinline__ void p0_transpose_item8(const float* W, int K, int N, unsigned char* WT, int k0, int n0, int drow0, float sc, LAS float* scr, int lane) {
    p0_load_tile(W, N, k0, n0, scr, lane);
    const int c = lane & 3;
#pragma unroll
    for (int j = 0; j < 4; ++j) { const int n = (lane >> 2) + 16 * j; const LAS float* s = scr + (16 * c) * P0S + n;
        u32x4 o; o.x = pk4_fp8(s[0 * P0S] * sc, s[1 * P0S] * sc, s[2 * P0S] * sc, s[3 * P0S] * sc); o.y = pk4_fp8(s[4 * P0S] * sc, s[5 * P0S] * sc, s[6 * P0S] * sc, s[7 * P0S] * sc);
        o.z = pk4_fp8(s[8 * P0S] * sc, s[9 * P0S] * sc, s[10 * P0S] * sc, s[11 * P0S] * sc); o.w = pk4_fp8(s[12 * P0S] * sc, s[13 * P0S] * sc, s[14 * P0S] * sc, s[15 * P0S] * sc);
        *(u32x4*)(WT + (size_t)(drow0 + n) * K + k0 + 16 * c) = o; }
    LDS_WAIT(); asm volatile("" ::: "memory");
}
__device__ __forceinline__ void p0_matrix8(const float* W, int K, int N, unsigned char* WT, int ilv_half, float sc, int r, LAS float* scr, int lane) {
    const int nblk = N / 64, kb = (r / (4 * nblk)) * 4 + (r & 3), nb = (r >> 2) % nblk, n0 = 64 * nb;
    const int drow0 = ilv_half < 0 ? n0 : (n0 / 128) * 256 + ilv_half * 128 + (n0 % 128);
    p0_transpose_item8(W, K, N, WT, 64 * kb, n0, drow0, sc, scr, lane);
}

__device__ __forceinline__ void p0_transpose_item_i8(const float* W, int K, int N, unsigned char* WT, int k0, int n0, int drow0, float sc, LAS float* scr, int lane, const float* kgain) {
    p0_load_tile(W, N, k0, n0, scr, lane, kgain);
    const int c = lane & 3;
#pragma unroll
    for (int j = 0; j < 4; ++j) { const int n = (lane >> 2) + 16 * j; const LAS float* s = scr + (16 * c) * P0S + n;
        u32x4 o; o.x = pk4_i8(s[0 * P0S] * sc, s[1 * P0S] * sc, s[2 * P0S] * sc, s[3 * P0S] * sc); o.y = pk4_i8(s[4 * P0S] * sc, s[5 * P0S] * sc, s[6 * P0S] * sc, s[7 * P0S] * sc);
        o.z = pk4_i8(s[8 * P0S] * sc, s[9 * P0S] * sc, s[10 * P0S] * sc, s[11 * P0S] * sc); o.w = pk4_i8(s[12 * P0S] * sc, s[13 * P0S] * sc, s[14 * P0S] * sc, s[15 * P0S] * sc);
        *(u32x4*)(WT + (size_t)(drow0 + n) * K + k0 + 16 * c) = o; }
    LDS_WAIT(); asm volatile("" ::: "memory");
}
__device__ __forceinline__ void p0_matrix_i8(const float* W, int K, int N, unsigned char* WT, int ilv_half, float sc, int r, LAS float* scr, int lane, const float* kgain) {
    const int nblk = N / 64, kb = (r / (4 * nblk)) * 4 + (r & 3), nb = (r >> 2) % nblk, n0 = 64 * nb;
    const int drow0 = ilv_half < 0 ? n0 : (n0 / 128) * 256 + ilv_half * 128 + (n0 % 128);
    p0_transpose_item_i8(W, K, N, WT, 64 * kb, n0, drow0, sc, scr, lane, kgain);
}

__device__ __forceinline__ void rms_rows_to_bf16(const float* x, const float* gain, bf16_t* o, int m0, int step, int m1, int lane) {
    f32x4 g[4][2];
#pragma unroll
    for (int j = 0; j < 4; ++j) { const f32x4* gp = (const f32x4*)(gain + 8 * (lane + 64 * j)); g[j][0] = gp[0]; g[j][1] = gp[1]; }
    for (int m = m0; m < m1; m += step) {
        const float* xrow = x + (size_t)m * D; bf16_t* orow = o + (size_t)m * D;
        f32x4 v[4][2]; float s = 0.f;
#pragma unroll
        for (int j = 0; j < 4; ++j) { const f32x4* p = (const f32x4*)(xrow + 8 * (lane + 64 * j)); v[j][0] = p[0]; v[j][1] = p[1]; }
#pragma unroll
        for (int j = 0; j < 4; ++j)
            s += (v[j][0].x * v[j][0].x + v[j][0].y * v[j][0].y) + (v[j][0].z * v[j][0].z + v[j][0].w * v[j][0].w) + (v[j][1].x * v[j][1].x + v[j][1].y * v[j][1].y) + (v[j][1].z * v[j][1].z + v[j][1].w * v[j][1].w);
        const float rstd = 1.0f / sqrtf(wave_sum(s) * (1.0f / D) + RMS_EPS);
#pragma unroll
        for (int j = 0; j < 4; ++j) { const f32x4 a = v[j][0] * rstd * g[j][0], b = v[j][1] * rstd * g[j][1];
            u32x4 w; w.x = cvt_pk_bf16(a.x, a.y); w.y = cvt_pk_bf16(a.z, a.w); w.z = cvt_pk_bf16(b.x, b.y); w.w = cvt_pk_bf16(b.z, b.w);
            *(u32x4*)(orow + 8 * (lane + 64 * j)) = w; }
    }
}

__device__ __forceinline__ void rms_rows_to_i8(const float* x, const float* gain, unsigned char* o, int m0, int step, int m1, int lane) {
    f32x4 g[4][2];
#pragma unroll
    for (int j = 0; j < 4; ++j) { const f32x4* gp = (const f32x4*)(gain + 8 * (lane + 64 * j)); g[j][0] = gp[0] * SC_A8; g[j][1] = gp[1] * SC_A8; }
    for (int m = m0; m < m1; m += step) {
        const float* xrow = x + (size_t)m * D; unsigned char* orow = o + (size_t)m * D;
        f32x4 v[4][2]; float s = 0.f;
#pragma unroll
        for (int j = 0; j < 4; ++j) { const f32x4* p = (const f32x4*)(xrow + 8 * (lane + 64 * j)); v[j][0] = p[0]; v[j][1] = p[1]; }
#pragma unroll
        for (int j = 0; j < 4; ++j)
            s += (v[j][0].x * v[j][0].x + v[j][0].y * v[j][0].y) + (v[j][0].z * v[j][0].z + v[j][0].w * v[j][0].w) + (v[j][1].x * v[j][1].x + v[j][1].y * v[j][1].y) + (v[j][1].z * v[j][1].z + v[j][1].w * v[j][1].w);
        const float rstd = 1.0f / sqrtf(wave_sum(s) * (1.0f / D) + RMS_EPS);
#pragma unroll
        for (int j = 0; j < 4; ++j) { const f32x4 a = v[j][0] * rstd * g[j][0], b = v[j][1] * rstd * g[j][1];
            u32x2 w; w.x = pk4_i8(a.x, a.y, a.z, a.w); w.y = pk4_i8(b.x, b.y, b.z, b.w); *(u32x2*)(orow + 8 * (lane + 64 * j)) = w; }
    }
}


__device__ __forceinline__ void meta_rstd(const float* src, LAS float* rs, int wave, int lane) {
#pragma unroll
    for (int rr = 0; rr < 2; ++rr) { const int row = 2 * wave + rr; float s = 0.f;
#pragma unroll
        for (int j = 0; j < 8; ++j) { const f32x4 v = *(const f32x4*)(src + (size_t)row * D + 4 * (lane + 64 * j)); s += (v.x * v.x + v.y * v.y) + (v.z * v.z + v.w * v.w); }
        s = wave_sum(s); if (lane == 0) rs[row] = 1.0f / sqrtf(s * (1.0f / D) + RMS_EPS); }
    __syncthreads();
}

struct FNorm { const float* src; const float* gain; const LAS float* rstd; int K;
    __device__ __forceinline__ void operator()(int row, int k, float (&a)[8]) const { const f32x4* p = (const f32x4*)(src + (size_t)row * K + k); const float r = rstd[row]; f32x4 x = p[0] * r, y = p[1] * r;
        if (gain) { const f32x4* gp = (const f32x4*)(gain + k); x = x * gp[0]; y = y * gp[1]; } a[0] = x.x; a[1] = x.y; a[2] = x.z; a[3] = x.w; a[4] = y.x; a[5] = y.y; a[6] = y.z; a[7] = y.w; } };
struct FCvt { const float* src; int K;
    __device__ __forceinline__ void operator()(int row, int k, float (&a)[8]) const { const f32x4* p = (const f32x4*)(src + (size_t)row * K + k); const f32x4 x = p[0], y = p[1];
        a[0] = x.x; a[1] = x.y; a[2] = x.z; a[3] = x.w; a[4] = y.x; a[5] = y.y; a[6] = y.z; a[7] = y.w; } };
template <int WF, int C, class AL, class CM, class EP>
__device__ __forceinline__ void meta_gemm_mc(const void* Btv, int K, int ngroups, float wsc, const AL& A, const CM& colmap, const EP& E, int gw, int NGW, int lane) {
    for (int g = gw; g < ngroups; g += NGW) {
#pragma unroll 1
        for (int rb = 0; rb < 16; rb += 4) {
            float acc[4][C];
#pragma unroll
            for (int r = 0; r < 4; ++r)
#pragma unroll
                for (int c = 0; c < C; ++c) acc[r][c] = 0.f;
#pragma unroll 1
            for (int k = lane * 8; k < K; k += 512) {
                float a[4][8];
#pragma unroll
                for (int r = 0; r < 4; ++r) A(rb + r, k, a[r]);
#pragma unroll
                for (int c = 0; c < C; ++c) { const int n = colmap(g, c); float wf[8];
                    if constexpr (WF == 0) { const u32x4 w = *(const u32x4*)((const bf16_t*)Btv + (size_t)n * K + k);
                        wf[0] = bflo(w.x); wf[1] = bfhi(w.x); wf[2] = bflo(w.y); wf[3] = bfhi(w.y); wf[4] = bflo(w.z); wf[5] = bfhi(w.z); wf[6] = bflo(w.w); wf[7] = bfhi(w.w); }
                    else { const u32x2 w = *(const u32x2*)((const unsigned char*)Btv + (size_t)n * K + k);
                        if constexpr (WF == 1) {
#pragma unroll
                            for (int e = 0; e < 4; ++e) { wf[e] = (float)((int)(w.x << (24 - 8 * e)) >> 24); wf[4 + e] = (float)((int)(w.y << (24 - 8 * e)) >> 24); } }
                        else { wf[0] = __builtin_amdgcn_cvt_f32_fp8((int)w.x, 0); wf[1] = __builtin_amdgcn_cvt_f32_fp8((int)w.x, 1); wf[2] = __builtin_amdgcn_cvt_f32_fp8((int)w.x, 2); wf[3] = __builtin_amdgcn_cvt_f32_fp8((int)w.x, 3);
                               wf[4] = __builtin_amdgcn_cvt_f32_fp8((int)w.y, 0); wf[5] = __builtin_amdgcn_cvt_f32_fp8((int)w.y, 1); wf[6] = __builtin_amdgcn_cvt_f32_fp8((int)w.y, 2); wf[7] = __builtin_amdgcn_cvt_f32_fp8((int)w.y, 3); } }
#pragma unroll
                    for (int r = 0; r < 4; ++r)
#pragma unroll
                        for (int e = 0; e < 8; ++e) acc[r][c] += a[r][e] * wf[e]; }
            }
#pragma unroll
            for (int r = 0; r < 4; ++r)
#pragma unroll
                for (int c = 0; c < C; ++c) acc[r][c] = wave_sum(acc[r][c]) * wsc;
            E(rb, g, acc, lane);
        }
    }
}
template <int C> struct CMCons { __device__ __forceinline__ int operator()(int g, int c) const { return g * C + c; } };
struct CMGateUp { __device__ __forceinline__ int operator()(int g, int c) const { const int ch = 4 * g + (c & 3); return (ch >> 7) * 256 + (ch & 127) + (c >> 2) * 128; } };
template <int C> struct EStoreC { float* out; int ldc;
    __device__ __forceinline__ void operator()(int rb, int g, const float (&v)[4][C], int lane) const {
#pragma unroll
        for (int r = 0; r < 4; ++r)
#pragma unroll
            for (int c = 0; c < C; ++c) if (lane == r * C + c) out[(size_t)(rb + r) * ldc + g * C + c] = v[r][c]; } };
template <int C> struct EResidC { const float* base; float* out; int ldc;
    __device__ __forceinline__ void operator()(int rb, int g, const float (&v)[4][C], int lane) const {
#pragma unroll
        for (int r = 0; r < 4; ++r)
#pragma unroll
            for (int c = 0; c < C; ++c) if (lane == r * C + c) { const size_t o = (size_t)(rb + r) * ldc + g * C + c; out[o] = base[o] + v[r][c]; } } };
struct ESiluAct { float* act;
    __device__ __forceinline__ void operator()(int rb, int g, const float (&v)[4][8], int lane) const {
#pragma unroll
        for (int r = 0; r < 4; ++r)
#pragma unroll
            for (int c = 0; c < 4; ++c) if (lane == r * 4 + c) act[(size_t)(rb + r) * FF + 4 * g + c] = pg8::silu_mul(v[r][c], v[r][c + 4]); } };

namespace att {
constexpr int NSLOT = 3, SLOT = 32768, OFF_KM = 98304, OFF_VM = OFF_KM + 4096, OFF_QM = OFF_VM + 4096, OFF_BIAS = OFF_QM + 4096, OFF_MB = OFF_BIAS + 4096, OFF_SC = OFF_MB + 256;
constexpr int BIAS_SLACK = 256;
__device__ __forceinline__ int swzK(int key) { return ((key >> 3) & 3) * 4 + (key & 3); }
__device__ __forceinline__ int gswV(int row) { return ((row & 3) << 2) | ((row >> 2) & 3); }
__device__ __forceinline__ int r0_of(int r) { const int a = r - 4; return a < 0 ? 0 : (a > GR - 8 ? GR - 8 : a); }
__device__ __forceinline__ bf16x4 tr_read(unsigned addr) { bf16x4 r; asm volatile("ds_read_b64_tr_b16 %0, %1" : "=v"(r) : "v"(addr)); return r; }

__device__ __forceinline__ void meta_step(LAS unsigned char* lds, const bf16x8 (&qf)[4], float Mq, f32x4 (&O)[8], float& lsum, int fr, int fq, int lane) {
    f32x4 s = (f32x4){0.f, 0.f, 0.f, 0.f};
#pragma unroll
    for (int ks = 0; ks < 4; ++ks) { const bf16x8 kf = *(const LAS bf16x8*)(lds + OFF_KM + fr * 256 + (((4 * ks + fq) ^ fr) << 4)); s = __builtin_amdgcn_mfma_f32_16x16x32_bf16(kf, qf[ks], s, 0, 0, 0); }
    const LAS float* mb = (const LAS float*)(lds + OFF_MB);
    float p[4];
#pragma unroll
    for (int i = 0; i < 4; ++i) { p[i] = __builtin_amdgcn_exp2f(s[i] + mb[4 * fq + i] - Mq); lsum += p[i]; }
    u32x4 pw; pw.x = cvt_pk_bf16(p[0], p[1]); pw.y = cvt_pk_bf16(p[2], p[3]); pw.z = 0u; pw.w = 0u;
    const bf16x8 pf = __builtin_bit_cast(bf16x8, pw);
    const int g = lane >> 4, q = (lane & 15) >> 2, pp = lane & 3, row = 4 * g + q;
    const unsigned vbase = (unsigned)(size_t)(lds + OFF_VM) + 256u * row + 8u * (pp & 1);
    bf16x4 v[8];
#pragma unroll
    for (int dt = 0; dt < 8; ++dt) v[dt] = tr_read(vbase + 16u * ((unsigned)(2 * dt + (pp >> 1)) ^ (unsigned)gswV(row)));
    asm volatile("s_waitcnt lgkmcnt(0)" : "+v"(v[0]), "+v"(v[1]), "+v"(v[2]), "+v"(v[3]), "+v"(v[4]), "+v"(v[5]), "+v"(v[6]), "+v"(v[7]) :: "memory");
#pragma unroll
    for (int dt = 0; dt < 8; ++dt) { bf16x8 vf; vf[0] = v[dt][0]; vf[1] = v[dt][1]; vf[2] = v[dt][2]; vf[3] = v[dt][3]; vf[4] = v[dt][0]; vf[5] = v[dt][1]; vf[6] = v[dt][2]; vf[7] = v[dt][3];
        O[dt] = __builtin_amdgcn_mfma_f32_16x16x32_bf16(vf, pf, O[dt], 0, 0, 0); }
}

__device__ __forceinline__ void attn_phase(LAS unsigned char* lds, const bf16_t* qkv, const float* qkv_m, const float* q_gain, const float* k_gain, const float* rel_bias,
                                           const float* meta_bias, bf16_t* o, float* o_m, int G, int bid) {
    const int tid = threadIdx.x, wid = __builtin_amdgcn_readfirstlane(tid >> 6), lane = tid & 63, fr = lane & 15, fq = lane >> 4;
    const int UPW = (NB * NH * (GR / 2)) / G;
    const int u0 = bid * UPW, bh = u0 / (GR / 2), b = bh / NH, h = bh % NH;
    const float QSCALE = 0.08838834764831845f * LOG2E;
    if (tid < 256) { const int m = tid >> 4, ch = tid & 15;
        { const f32x4* p = (const f32x4*)(qkv_m + (size_t)m * NQKV + D + h * HD + ch * 8); const f32x4 a = p[0], c = p[1];
          float ss = (a.x * a.x + a.y * a.y) + (a.z * a.z + a.w * a.w) + (c.x * c.x + c.y * c.y) + (c.z * c.z + c.w * c.w);
          ss += __shfl_xor(ss, 1); ss += __shfl_xor(ss, 2); ss += __shfl_xor(ss, 4); ss += __shfl_xor(ss, 8);
          const float r = 1.0f / sqrtf(ss * (1.0f / HD) + RMS_EPS); const f32x4* gp = (const f32x4*)(k_gain + ch * 8); const f32x4 x = a * gp[0] * r, y = c * gp[1] * r;
          u32x4 w; w.x = cvt_pk_bf16(x.x, x.y); w.y = cvt_pk_bf16(x.z, x.w); w.z = cvt_pk_bf16(y.x, y.y); w.w = cvt_pk_bf16(y.z, y.w);
          *(LAS u32x4*)(lds + OFF_KM + m * 256 + ((ch ^ m) << 4)) = w; }
        { const f32x4* p = (const f32x4*)(qkv_m + (size_t)m * NQKV + 2 * D + h * HD + ch * 8); const f32x4 a = p[0], c = p[1];
          u32x4 w; w.x = cvt_pk_bf16(a.x, a.y); w.y = cvt_pk_bf16(a.z, a.w); w.z = cvt_pk_bf16(c.x, c.y); w.w = cvt_pk_bf16(c.z, c.w);
          *(LAS u32x4*)(lds + OFF_VM + m * 256 + ((ch ^ gswV(m)) << 4)) = w; }
        { const f32x4* p = (const f32x4*)(qkv_m + (size_t)m * NQKV + h * HD + ch * 8); const f32x4 a = p[0], c = p[1];
          float ss = (a.x * a.x + a.y * a.y) + (a.z * a.z + a.w * a.w) + (c.x * c.x + c.y * c.y) + (c.z * c.z + c.w * c.w);
          ss += __shfl_xor(ss, 1); ss += __shfl_xor(ss, 2); ss += __shfl_xor(ss, 4); ss += __shfl_xor(ss, 8);
          const float r = QSCALE / sqrtf(ss * (1.0f / HD) + RMS_EPS); const f32x4* gp = (const f32x4*)(q_gain + ch * 8); const f32x4 x = a * gp[0] * r, y = c * gp[1] * r;
          u32x4 w; w.x = cvt_pk_bf16(x.x, x.y); w.y = cvt_pk_bf16(x.z, x.w); w.z = cvt_pk_bf16(y.x, y.y); w.w = cvt_pk_bf16(y.z, y.w);
          *(LAS u32x4*)(lds + OFF_QM + m * 256 + (ch << 4)) = w; }
    }
    { LAS float* bt = (LAS float*)(lds + OFF_BIAS); for (int i = tid; i < 1024; i += NTHREADS) { const int j = i - BIAS_SLACK; bt[i] = (j >= 0 && j < 15 * 31) ? rel_bias[h * 465 + j] * LOG2E : 0.f; }
      if (tid < 16) ((LAS float*)(lds + OFF_MB))[tid] = meta_bias[h * 16 + tid] * LOG2E; }
    __syncthreads();
    float maxbias, KB;
    { const LAS float* bt = (const LAS float*)(lds + OFF_BIAS) + BIAS_SLACK; float mx = -1e30f;
      for (int i = lane; i < 465; i += 64) mx = fmaxf(mx, bt[i]);
      if (lane < 16) mx = fmaxf(mx, ((const LAS float*)(lds + OFF_MB))[lane]);
      maxbias = wave_max(mx);
      KB = wave_max(fmaxf(fabsf(k_gain[lane]), fabsf(k_gain[lane + 64]))) * 11.313708498984761f * 1.01f; }
    const int j = wid & 3, cq = 16 * j + fr, kc0 = (16 * j - 8) < 0 ? 0 : ((16 * j - 8) > 32 ? 32 : (16 * j - 8));
    const int c0 = (cq - 8) < 0 ? 0 : ((cq - 8) > GW - 16 ? GW - 16 : (cq - 8)), dlo = c0 - cq;
    const int cb = kc0 + 8 * fq - cq + 15;
    unsigned vmask = 0u;
#pragma unroll
    for (int t = 0; t < 2; ++t)
#pragma unroll
        for (int i = 0; i < 4; ++i) { const int dc = kc0 + 8 * fq + 4 * t + i - cq; if (dc >= dlo && dc <= dlo + 15) vmask |= 1u << (4 * t + i); }
    unsigned koff[2];
#pragma unroll
    for (int t = 0; t < 2; ++t) { const int key = kc0 + 8 * (fr >> 2) + (fr & 3) + 4 * t; koff[t] = (unsigned)(key * 256) | ((unsigned)swzK(key) << 16); }
    const int tg = lane >> 4, tq = (lane & 15) >> 2, tp = lane & 3;
    unsigned vrow[2], vsw[2];
#pragma unroll
    for (int t = 0; t < 2; ++t) { const int row = kc0 + 8 * tg + 4 * t + tq; vrow[t] = (unsigned)(row * 256 + 8 * (tp & 1)); vsw[t] = (unsigned)gswV(row); }
    unsigned dK[2], dV[2];
#pragma unroll
    for (int ii = 0; ii < 2; ++ii) { const int p = tid + 512 * ii, key = p >> 4, sc = p & 15; dK[ii] = (unsigned)(key * (NQKV * 2) + ((sc ^ swzK(key)) << 4)); dV[ii] = (unsigned)(key * (NQKV * 2) + ((sc ^ gswV(key)) << 4)); }
    const char* kbase = (const char*)qkv + ((size_t)b * SEQ * NQKV + D + h * HD) * 2;
    const unsigned ldsw = (unsigned)wid * 1024u;
#define ATT_ISSUE(krow, slot) do { const char* _s = kbase + (size_t)(krow) * (GW * NQKV * 2); _Pragma("unroll") for (int _i = 0; _i < 2; ++_i) { \
        __builtin_amdgcn_global_load_lds((const unsigned*)(_s + dK[_i]), (LAS unsigned*)(lds + (slot) * SLOT + ldsw + _i * 8192), 16, 0, 0); \
        __builtin_amdgcn_global_load_lds((const unsigned*)(_s + D * 2 + dV[_i]), (LAS unsigned*)(lds + (slot) * SLOT + 16384 + ldsw + _i * 8192), 16, 0, 0); } } while (0)

    if (b == 0 && (bid % (G / (NB * NH))) == 0 && wid == 0) {
        bf16x8 qf[4]; float ssq = 0.f;
#pragma unroll
        for (int ks = 0; ks < 4; ++ks) { qf[ks] = *(const LAS bf16x8*)(lds + OFF_QM + fr * 256 + ((4 * ks + fq) << 4));
#pragma unroll
            for (int e = 0; e < 8; ++e) { const float f = bf2f((unsigned short)qf[ks][e]); ssq += f * f; } }
        ssq += __shfl_xor(ssq, 16); ssq += __shfl_xor(ssq, 32);
        const float Mq = sqrtf(ssq) * KB + maxbias;
        f32x4 O[8]; float lsum = 0.f;
#pragma unroll
        for (int dt = 0; dt < 8; ++dt) O[dt] = (f32x4){0.f, 0.f, 0.f, 0.f};
        meta_step(lds, qf, Mq, O, lsum, fr, fq, lane);
        lsum += __shfl_xor(lsum, 16); lsum += __shfl_xor(lsum, 32);
        const float inv = 1.0f / lsum;
#pragma unroll
        for (int dt = 0; dt < 8; ++dt) *(f32x4*)(o_m + (size_t)fr * D + h * HD + 16 * dt + 4 * fq) = O[dt] * inv;
    }

    int iu = 0, irp = (u0 % (GR / 2)), ilo = r0_of(2 * irp), ihi = r0_of(2 * irp + 1) + 7, ii_ = ilo, gI = 0;
#define ATT_ADV() do { if (++ii_ > ihi) { ++iu; ++irp; if (iu < UPW) { ilo = r0_of(2 * irp); ihi = r0_of(2 * irp + 1) + 7; ii_ = ilo; } } } while (0)
    for (int d = 0; d < 2; ++d) if (iu < UPW) { ATT_ISSUE(ii_, gI % NSLOT); ATT_ADV(); ++gI; }
    int gC = 0;
    for (int ku = 0; ku < UPW; ++ku) {
        const int rp = (u0 % (GR / 2)) + ku, qr = 2 * rp + (wid >> 2), r0w = r0_of(qr), lo = r0_of(2 * rp), hi = r0_of(2 * rp + 1) + 7;
        const size_t qrow = (size_t)b * SEQ + (size_t)qr * GW + cq;
        bf16x8 qf[4]; float ssq = 0.f;
#pragma unroll
        for (int ks = 0; ks < 4; ++ks) { qf[ks] = *(const bf16x8*)(qkv + qrow * NQKV + h * HD + 32 * ks + 8 * fq);
#pragma unroll
            for (int e = 0; e < 8; ++e) { const float f = bf2f((unsigned short)qf[ks][e]); ssq += f * f; } }
        ssq += __shfl_xor(ssq, 16); ssq += __shfl_xor(ssq, 32);
        const float Mq = sqrtf(ssq) * KB + maxbias;
        f32x4 O[8]; float lsum = 0.f;
#pragma unroll
        for (int dt = 0; dt < 8; ++dt) O[dt] = (f32x4){0.f, 0.f, 0.f, 0.f};
        for (int i = lo; i <= hi; ++i) {
            if (gI > gC + 1) asm volatile("s_waitcnt vmcnt(4)" ::: "memory"); else asm volatile("s_waitcnt vmcnt(0)" ::: "memory");
            __builtin_amdgcn_s_barrier();
            if (iu < UPW) { ATT_ISSUE(ii_, gI % NSLOT); ATT_ADV(); ++gI; }
            if (i >= r0w && i <= r0w + 7) {
                const int slot = gC % NSLOT; const int dr = i - qr;
                LAS unsigned char* sk = lds + slot * SLOT;
                f32x4 s[2];
#pragma unroll
                for (int t = 0; t < 2; ++t) { s[t] = (f32x4){0.f, 0.f, 0.f, 0.f};
#pragma unroll
                    for (int ks = 0; ks < 4; ++ks) { const bf16x8 kf = *(const LAS bf16x8*)(sk + (koff[t] & 0xffffu) + ((((unsigned)(4 * ks + fq)) ^ (koff[t] >> 16)) << 4));
                        s[t] = __builtin_amdgcn_mfma_f32_16x16x32_bf16(kf, qf[ks], s[t], 0, 0, 0); } }
                const LAS float* bt = (const LAS float*)(lds + OFF_BIAS) + BIAS_SLACK + (dr + 7) * 31 + cb;
                float p[8];
#pragma unroll
                for (int t = 0; t < 2; ++t)
#pragma unroll
                    for (int e = 0; e < 4; ++e) { const float v = __builtin_amdgcn_exp2f(s[t][e] + bt[4 * t + e] - Mq); p[4 * t + e] = ((vmask >> (4 * t + e)) & 1u) ? v : 0.f; lsum += p[4 * t + e]; }
                u32x4 pw; pw.x = cvt_pk_bf16(p[0], p[1]); pw.y = cvt_pk_bf16(p[2], p[3]); pw.z = cvt_pk_bf16(p[4], p[5]); pw.w = cvt_pk_bf16(p[6], p[7]);
                const bf16x8 pf = __builtin_bit_cast(bf16x8, pw);
                const unsigned vb = (unsigned)(size_t)(sk + 16384);
#pragma unroll
                for (int hb = 0; hb < 2; ++hb) {
                    bf16x4 v0[4], v1[4];
#pragma unroll
                    for (int d4 = 0; d4 < 4; ++d4) { const int dt = 4 * hb + d4;
                        v0[d4] = tr_read(vb + vrow[0] + 16u * (((unsigned)(2 * dt + (tp >> 1))) ^ vsw[0]));
                        v1[d4] = tr_read(vb + vrow[1] + 16u * (((unsigned)(2 * dt + (tp >> 1))) ^ vsw[1])); }
                    asm volatile("s_waitcnt lgkmcnt(0)" : "+v"(v0[0]), "+v"(v0[1]), "+v"(v0[2]), "+v"(v0[3]), "+v"(v1[0]), "+v"(v1[1]), "+v"(v1[2]), "+v"(v1[3]) :: "memory");
#pragma unroll
                    for (int d4 = 0; d4 < 4; ++d4) { bf16x8 vf; vf[0] = v0[d4][0]; vf[1] = v0[d4][1]; vf[2] = v0[d4][2]; vf[3] = v0[d4][3]; vf[4] = v1[d4][0]; vf[5] = v1[d4][1]; vf[6] = v1[d4][2]; vf[7] = v1[d4][3];
                        O[4 * hb + d4] = __builtin_amdgcn_mfma_f32_16x16x32_bf16(vf, pf, O[4 * hb + d4], 0, 0, 0); }
                }
            }
            ++gC;
        }
        meta_step(lds, qf, Mq, O, lsum, fr, fq, lane);
        lsum += __shfl_xor(lsum, 16); lsum += __shfl_xor(lsum, 32);
        const float inv = 1.0f / lsum;
#pragma unroll
        for (int dt = 0; dt < 8; ++dt) { const f32x4 v = O[dt] * (inv * SC_O8);
            *(unsigned*)((unsigned char*)o + qrow * D + h * HD + 16 * dt + 4 * fq) = pk4_i8(v[0], v[1], v[2], v[3]); }
    }
    VM_WAIT();
    __syncthreads();
#undef ATT_ISSUE
#undef ATT_ADV
}
}


constexpr int NPHASES = 17;
struct Args { const float* in[22]; float* out; unsigned char* ws; int ph_lo, ph_hi; };
static_assert(sizeof(Args) == 22 * 8 + 8 + 8 + 8, "Args has no padding");
enum { I_X = 0, I_META, I_ATTN_NORM, I_WQKV, I_QGAIN, I_KGAIN, I_RELBIAS, I_METABIAS, I_WO, I_CONV_NORM, I_WIN, I_CONVW, I_WOUT, I_DENSE_NORM, I_WGATE, I_WUP, I_WDOWN,
       I_MOE_NORM, I_WROUTER, I_MGATE, I_MUP, I_MDOWN };

__global__ void __launch_bounds__(NTHREADS, 2) enc_fwd(Args args) {
    extern __shared__ __attribute__((aligned(16))) unsigned char lds_raw[];
    LAS unsigned char* lds = (LAS unsigned char*)lds_raw;
    const int tid = threadIdx.x, lane = tid & 63, wave = __builtin_amdgcn_readfirstlane(tid >> 6);
    const int G = gridDim.x, bid = blockIdx.x;
    const int gw = bid * NWAVES + wave, NGW = G * NWAVES;
    unsigned char* ws = args.ws;
    unsigned* ctl = (unsigned*)(ws + WS_CTL);
    float* out = args.out;
    bf16_t* XA = (bf16_t*)(ws + WS_XA); bf16_t* BIG = (bf16_t*)(ws + WS_BIG); bf16_t* Y1 = (bf16_t*)(ws + WS_Y1);
    unsigned char* XQ = ws + WS_XQ; unsigned char* ACT8 = ws + WS_BIG;
    float* rs1 = (float*)(ws + WS_RS1); float* rs2 = (float*)(ws + WS_RS2); unsigned char* HB1 = ws + WS_XBUF;
    bf16_t* H1B = (bf16_t*)(ws + WS_H1B); bf16_t* H2B = (bf16_t*)(ws + WS_H2B); bf16_t* H3B = H1B; bf16_t* Y0 = H2B;
    float* qkv_m = (float*)(ws + MT_QKV); float* o_m = (float*)(ws + MT_O); float* h1_m = (float*)(ws + MT_H1); float* act_m = (float*)(ws + MT_GU); float* h2_m = (float*)(ws + MT_H2); float* cgu_m = (float*)(ws + MT_CGU);
    int* tok_e = (int*)(ws + MO_TOKE); float* tok_g = (float*)(ws + MO_TOKG); int* cnt = (int*)(ws + MO_CNT); int* rowinfo = (int*)(ws + MO_ROWINFO); float* rowgate = (float*)(ws + MO_ROWGATE); int* tile_e = (int*)(ws + MO_TILEE);

    if (tid < 2) ((LAS unsigned*)(lds + XBW_OFF))[tid] = 0u;
    __syncthreads();
#if MK_N_LAUNCHES == 1
    XcdBarrier bar = xcd_barrier_post(ctl + CW_BAR, (volatile LAS unsigned*)(lds + XBW_OFF));
#define GRID_BAR() xcd_barrier(bar)
#else
#define GRID_BAR() do { } while (0)
#endif
    const int lo = args.ph_lo, hi = args.ph_hi;
#define IN(k) (lo <= (k) && (k) < hi)
#define SEAM(k) do { if (IN((k) + 1)) GRID_BAR(); } while (0)


    if (IN(0)) {
        LAS float* scr = (LAS float*)(lds + wave * 16896);
        constexpr int I_A = (D / 64) * (NQKV / 64), I_B = (D / 64) * (D / 64), I_F = (D / 64) * (FF / 64), I_Dn = (FF / 64) * (D / 64);
        static_assert(I_F == I_Dn, "items");
        constexpr int NITEMS = 2 * I_A + 2 * I_B + 3 * I_F + 3 * NE * I_F;
        for (int it = gw; it < NITEMS; it += NGW) {
            int r = it;
            if (r < I_A) { p0_matrix_i8(args.in[I_WQKV], D, NQKV, ws + W_QKV8, -1, SC_W8, r, scr, lane, nullptr); continue; } r -= I_A;
            if (r < I_B) { p0_matrix_i8(args.in[I_WO], D, D, ws + W_O8, -1, SC_W8, r, scr, lane, nullptr); continue; } r -= I_B;
            if (r < I_F) { p0_matrix_i8(args.in[I_WGATE], D, FF, ws + W_GU8, 0, SC_W8, r, scr, lane, args.in[I_DENSE_NORM]); continue; } r -= I_F;
            if (r < I_F) { p0_matrix_i8(args.in[I_WUP], D, FF, ws + W_GU8, 1, SC_W8, r, scr, lane, args.in[I_DENSE_NORM]); continue; } r -= I_F;
            if (r < I_F) { const int nblk = D / 64, kb = (r / (4 * nblk)) * 4 + (r & 3), nb = (r >> 2) % nblk;
                p0_item_dn<8>(args.in[I_WDOWN], FF, D, (bf16_t*)(ws + W_DN), ws + W_DN8, SC_WDR, 64 * kb, 64 * nb, scr, lane); continue; } r -= I_F;
            if (r < I_A) {
                const int nblk = NQKV / 64, kb = (r / (4 * nblk)) * 4 + (r & 3), nb = (r >> 2) % nblk, n0 = 64 * nb; int drow0;
                if (n0 < D) drow0 = n0; else { const int part = (n0 - D) / D, zc = (n0 - D) % D; drow0 = D + (zc / 128) * 256 + part * 128 + (zc % 128); }
                p0_transpose_item_i8(args.in[I_WIN], D, NQKV, ws + W_IN, 64 * kb, n0, drow0, SC_W8, scr, lane, args.in[I_CONV_NORM]); continue; } r -= I_A;
            if (r < I_B) { const int nblk = D / 64, kb = (r / (4 * nblk)) * 4 + (r & 3), nb = (r >> 2) % nblk;
                p0_item_dn<32>(args.in[I_WOUT], D, D, nullptr, ws + W_OUT, SC_W8, 64 * kb, 64 * nb, scr, lane); continue; } r -= I_B;
            { const int which = r / (NE * I_F), rr = r % (NE * I_F), e = rr / I_F, ri = rr % I_F;
              if (which == 0) p0_matrix_i8(args.in[I_MGATE] + (size_t)e * D * FF, D, FF, ws + W_MGU + (size_t)e * NGU * D, 0, SC_W8, ri, scr, lane, nullptr);
              else if (which == 1) p0_matrix_i8(args.in[I_MUP] + (size_t)e * D * FF, D, FF, ws + W_MGU + (size_t)e * NGU * D, 1, SC_W8, ri, scr, lane, nullptr);
              else p0_matrix8(args.in[I_MDOWN] + (size_t)e * FF * D, FF, D, ws + W_MDN + (size_t)e * D * FF, -1, SC_WDN, ri, scr, lane); }
        }
        rms_rows_to_i8(args.in[I_X], args.in[I_ATTN_NORM], (unsigned char*)XA, gw, NGW, M, lane);
        SEAM(0);
    }
    if (IN(1)) {
        { pg8::Gemm g{XA, ws + W_QKV8, D}; pg8::StaticOrder S; S.init(M, NQKV, G, bid); pg8::EpiQKV E{BIG, NQKV, 1.0f / (SC_A8 * SC_W8), args.in[I_QGAIN], args.in[I_KGAIN], (LAS float*)(lds + MISC_OFF)};
          pg8::gemm_phase<pg8::EpiQKV, pg8::StaticOrder, 8>(lds, g, S, E); }
        { LAS float* rs = (LAS float*)(lds + 8192); meta_rstd(args.in[I_META], rs, wave, lane);
          FNorm A{args.in[I_META], args.in[I_ATTN_NORM], rs, D}; EStoreC<3> E{qkv_m, NQKV};
          meta_gemm_mc<1, 3>(ws + W_QKV8, D, NQKV / 3, 1.0f / SC_W8, A, CMCons<3>{}, E, gw, NGW, lane); }
        SEAM(1);
    }
    if (IN(3)) {
        att::attn_phase(lds, BIG, qkv_m, args.in[I_QGAIN], args.in[I_KGAIN], args.in[I_RELBIAS], args.in[I_METABIAS], XA, o_m, G, bid);
        SEAM(3);
    }
    if (IN(4)) {
        { pg8::Gemm g{XA, ws + W_O8, D}; pg8::StaticOrder S; S.init(M, D, G, bid); pg8::EpiResidNormB<false> E{args.in[I_X], H1B, HB1, rs1, D, (LAS float*)(lds + MISC_OFF), 1.0f / (SC_O8 * SC_W8), SC_A8};
          pg8::gemm_phase<pg8::EpiResidNormB<false>, pg8::StaticOrder, 8>(lds, g, S, E); }
        { FCvt A{o_m, D}; EResidC<1> E{args.in[I_META], h1_m, D}; meta_gemm_mc<1, 1>(ws + W_O8, D, D, 1.0f / SC_W8, A, CMCons<1>{}, E, gw, NGW, lane); }
        SEAM(4);
    }
    if (IN(6)) {
        { pg8::Gemm g{HB1, ws + W_GU8, D}; pg8::StaticOrder S; S.init(M, NGU, G, bid); pg8::EpiSwiGLU E{(unsigned char*)BIG, FF, rs1, 1.0f / (SC_A8 * SC_W8), (LAS float*)(lds + MISC_OFF)};
          pg8::gemm_phase<pg8::EpiSwiGLU, pg8::StaticOrder, 8>(lds, g, S, E); }
        { LAS float* rs = (LAS float*)(lds + 8192); meta_rstd(h1_m, rs, wave, lane);
          FNorm A{h1_m, nullptr, rs, D}; ESiluAct E{act_m}; meta_gemm_mc<1, 8>(ws + W_GU8, D, FF / 4, 1.0f / SC_W8, A, CMGateUp{}, E, gw, NGW, lane); }
        SEAM(6);
    }
    if (IN(7)) {
        { pg8::Gemm g{BIG, ws + W_DN8, FF}; pg8::StaticOrder S; S.init(M, D, G, bid); pg8::EpiResidNormB<true> E{H1B, H2B, (unsigned char*)XA, rs2, D, (LAS float*)(lds + MISC_OFF), 1.0f / (SC_ACTR * SC_WDR), SC_A8B};
          pg8::gemm_phase<pg8::EpiResidNormB<true>, pg8::StaticOrder, 8>(lds, g, S, E); }
        if (wave < 4) { FCvt A{act_m, FF}; EResidC<2> E{h1_m, h2_m, D}; meta_gemm_mc<0, 2>(ws + W_DN, FF, D / 2, 1.0f, A, CMCons<2>{}, E, bid * 4 + wave, G * 4, lane); }
        SEAM(7);
    }
    if (IN(9)) {
        { pg8::Gemm g{XA, ws + W_IN, D}; pg8::StaticOrder S; S.init(M, NQKV, G, bid); pg8::EpiWin E{BIG, 2 * D, rs2, 1.0f / (SC_A8B * SC_W8), (LAS float*)(lds + MISC_OFF)};
          pg8::gemm_phase<pg8::EpiWin, pg8::StaticOrder, 8>(lds, g, S, E); }
        { LAS float* rs = (LAS float*)(lds + 8192); meta_rstd(h2_m, rs, wave, lane);
          FNorm A{h2_m, nullptr, rs, D}; EStoreC<2> E{cgu_m, 2 * D}; meta_gemm_mc<1, 2>(ws + W_IN + (size_t)D * D, D, D, 1.0f / SC_W8, A, CMCons<2>{}, E, gw, NGW, lane); }
        SEAM(9);
    }
    if (IN(10)) {
        const int cc = tid & 255, half = tid >> 8;
        const float* cw = args.in[I_CONVW] + (size_t)cc * 8 * 3;
        float w0[8], w1[8], w2[8];
#pragma unroll
        for (int e = 0; e < 8; ++e) { w0[e] = cw[3 * e]; w1[e] = cw[3 * e + 1]; w2[e] = cw[3 * e + 2]; }
        const int RPW = M / G;
        const int m0 = bid * RPW + half * (RPW / 2), m1 = m0 + RPW / 2;
#define ldz(m_, z_) ld8bf(BIG + (size_t)(m_) * (2 * D) + D + cc * 8, z_)
        float zp[8], zc[8], zn[8];
        if ((m0 % SEQ) == 0) { const float* gp = cgu_m + (size_t)15 * (2 * D) + (cc * 8 / 128) * 256 + (cc * 8 % 128);
#pragma unroll
            for (int e = 0; e < 8; ++e) zp[e] = gp[e] * gp[128 + e]; }
        else ldz(m0 - 1, zp);
        ldz(m0, zc);
        for (int m = m0; m < m1; m += 4) {
            u32x4 zw[4], bw[4];
#pragma unroll
            for (int i = 0; i < 4; ++i) { const int mm = m + 1 + i, mc = mm < M ? mm : M - 1; zw[i] = *(const u32x4*)(BIG + (size_t)mc * (2 * D) + D + cc * 8);
                if ((mm % SEQ) == 0) zw[i] = (u32x4){0u, 0u, 0u, 0u}; }
#pragma unroll
            for (int i = 0; i < 4; ++i) bw[i] = *(const u32x4*)(BIG + (size_t)(m + i) * (2 * D) + cc * 8);
#pragma unroll
            for (int i = 0; i < 4; ++i) {
                zn[0] = bflo(zw[i].x); zn[1] = bfhi(zw[i].x); zn[2] = bflo(zw[i].y); zn[3] = bfhi(zw[i].y); zn[4] = bflo(zw[i].z); zn[5] = bfhi(zw[i].z); zn[6] = bflo(zw[i].w); zn[7] = bfhi(zw[i].w);
                const float bg[8] = {bflo(bw[i].x), bfhi(bw[i].x), bflo(bw[i].y), bfhi(bw[i].y), bflo(bw[i].z), bfhi(bw[i].z), bflo(bw[i].w), bfhi(bw[i].w)};
                float y[8];
#pragma unroll
                for (int e = 0; e < 8; ++e) y[e] = bg[e] * (zp[e] * w0[e] + zc[e] * w1[e] + zn[e] * w2[e]);
                wht_inlane8(y);
#pragma unroll
                for (int e = 0; e < 8; ++e) { const float o = __shfl_xor(y[e], 1); y[e] = (cc & 1) ? o - y[e] : y[e] + o; }
#pragma unroll
                for (int e = 0; e < 8; ++e) { const float o = __shfl_xor(y[e], 2); y[e] = ((cc & 2) ? o - y[e] : y[e] + o) * (SC_YR * 0.17677669529663687f); }
                u32x2 o; o.x = pk4_i8(y[0], y[1], y[2], y[3]); o.y = pk4_i8(y[4], y[5], y[6], y[7]);
                *(u32x2*)((unsigned char*)XA + (size_t)(m + i) * D + cc * 8) = o;
#pragma unroll
                for (int e = 0; e < 8; ++e) { zp[e] = zc[e]; zc[e] = zn[e]; }
            }
        }
#undef ldz
        SEAM(10);
    }
    if (IN(11)) {
        { pg8::Gemm g{XA, ws + W_OUT, D}; pg8::StaticOrder S; S.init(M, D, G, bid); pg8::EpiResidB E{H2B, H3B, D, 1.0f / (SC_YR * SC_W8)};
          pg8::gemm_phase<pg8::EpiResidB, pg8::StaticOrder, 8>(lds, g, S, E); }
        SEAM(11);
    }
    if (IN(12)) {
        constexpr int RSTR = 4096 + 32;
        LAS unsigned char* wl = lds;
        LAS int* lcnt = (LAS int*)(lds + 2 * 8 * RSTR);
        for (int i = tid; i < D * NE; i += NTHREADS) { const int k = i >> 3, e = i & 7; const float w = args.in[I_WROUTER][i] * args.in[I_MOE_NORM][k];
            const unsigned hi = cvt_pk_bf16(w, 0.f) & 0xffffu; const float rem = w - bf2f((unsigned short)hi); const unsigned lo = cvt_pk_bf16(rem, 0.f) & 0xffffu;
            *(LAS unsigned short*)(wl + e * RSTR + 2 * k) = (unsigned short)hi; *(LAS unsigned short*)(wl + 8 * RSTR + e * RSTR + 2 * k) = (unsigned short)lo; }
        if (tid < 8) lcnt[tid] = 0;
        __syncthreads();
        const int RPW = M / G, RPV = RPW / NWAVES;
        static_assert(M / 256 / NWAVES == 16, "one 16-row MFMA block per wave");
        const int row0 = bid * RPW + wave * RPV, r = lane & 15, kq = lane >> 4;
        float rstd;
        { const bf16_t* yrow = H3B + (size_t)(row0 + r) * D + 8 * kq;
          const LAS unsigned char* xrow = wl + (r & 7) * RSTR + 16 * kq;
          f32x4 acc = (f32x4){0.f, 0.f, 0.f, 0.f}, gram = (f32x4){0.f, 0.f, 0.f, 0.f}; float ss = 0.f;
#pragma unroll 1
          for (int ib = 0; ib < D / 32; ib += 8) {
              u32x4 y[8];
#pragma unroll
              for (int j = 0; j < 8; ++j) y[j] = *(const u32x4*)(yrow + 32 * (ib + j));
#pragma unroll
              for (int j = 0; j < 8; ++j) { const bf16x8 yf = __builtin_bit_cast(bf16x8, y[j]);
                  const bf16x8 xh = *(const LAS bf16x8*)(xrow + 64 * (ib + j)), xl = *(const LAS bf16x8*)(xrow + 8 * RSTR + 64 * (ib + j));
                  acc = __builtin_amdgcn_mfma_f32_16x16x32_bf16(xh, yf, acc, 0, 0, 0); acc = __builtin_amdgcn_mfma_f32_16x16x32_bf16(xl, yf, acc, 0, 0, 0);
                  gram = __builtin_amdgcn_mfma_f32_16x16x32_bf16(yf, yf, gram, 0, 0, 0); }
          }
          { const float dsel = (r & 3) == 0 ? gram[0] : (r & 3) == 1 ? gram[1] : (r & 3) == 2 ? gram[2] : gram[3]; ss = __shfl(dsel, (r >> 2) * 16 + r); }
          rstd = 1.0f / sqrtf(ss * (1.0f / D) + RMS_EPS);
          float lg[8];
#pragma unroll
          for (int i = 0; i < 4; ++i) { lg[i] = acc[i] * rstd; lg[4 + i] = __shfl_xor(acc[i], 16) * rstd; }
          int e0 = 0; float l0 = lg[0];
#pragma unroll
          for (int e = 1; e < 8; ++e) if (lg[e] > l0) { l0 = lg[e]; e0 = e; }
          int e1 = -1; float l1 = -3.0e38f;
#pragma unroll
          for (int e = 0; e < 8; ++e) if (e != e0 && lg[e] > l1) { l1 = lg[e]; e1 = e; }
          const float g0 = 1.0f / (1.0f + __expf(l1 - l0)), g1 = 1.0f - g0; const int mm = row0 + r;
          if (kq == 0) { tok_e[2 * mm] = e0; tok_e[2 * mm + 1] = e1; tok_g[2 * mm] = g0; tok_g[2 * mm + 1] = g1; lds_add(&lcnt[e0], 1); lds_add(&lcnt[e1], 1); } }
        { const float* gain = args.in[I_MOE_NORM]; f32x4 gg[4][2];
#pragma unroll
          for (int j = 0; j < 4; ++j) { const f32x4* gp = (const f32x4*)(gain + 8 * (lane + 64 * j)); gg[j][0] = gp[0] * SC_A8; gg[j][1] = gp[1] * SC_A8; }
          u32x4 vn[4];
#pragma unroll
          for (int j = 0; j < 4; ++j) vn[j] = *(const u32x4*)(H3B + (size_t)row0 * D + 8 * (lane + 64 * j));
          for (int rr = 0; rr < RPV; ++rr) { const int m = row0 + rr; const float rs = __shfl(rstd, rr);
              u32x4 vc[4];
#pragma unroll
              for (int j = 0; j < 4; ++j) vc[j] = vn[j];
              if (rr + 1 < RPV) {
#pragma unroll
                  for (int j = 0; j < 4; ++j) vn[j] = *(const u32x4*)(H3B + (size_t)(m + 1) * D + 8 * (lane + 64 * j)); }
#pragma unroll
              for (int j = 0; j < 4; ++j) { const f32x4 a = (f32x4){bflo(vc[j].x), bfhi(vc[j].x), bflo(vc[j].y), bfhi(vc[j].y)} * rs * gg[j][0], b = (f32x4){bflo(vc[j].z), bfhi(vc[j].z), bflo(vc[j].w), bfhi(vc[j].w)} * rs * gg[j][1];
                  u32x2 w; w.x = pk4_i8(a.x, a.y, a.z, a.w); w.y = pk4_i8(b.x, b.y, b.z, b.w);
                  *(u32x2*)(XQ + (size_t)m * D + 8 * (lane + 64 * j)) = w; } } }
        __syncthreads();
        if (tid < 8) cnt[bid * 8 + tid] = lcnt[tid];
        SEAM(12);
    }
    if (IN(13)) {
        LAS int* tot = (LAS int*)lds; LAS int* pre = tot + 8; LAS int* start = tot + 16; LAS int* wcnt = tot + 32;
        if (tid < 16) tot[tid] = 0;
        __syncthreads();
        if (tid < 256) { const i32x4 a = *(const i32x4*)(cnt + tid * 8), c = *(const i32x4*)(cnt + tid * 8 + 4);
            const int v[8] = {a.x, a.y, a.z, a.w, c.x, c.y, c.z, c.w};
#pragma unroll
            for (int e = 0; e < 8; ++e) { lds_add(&tot[e], v[e]); if (tid < bid) lds_add(&pre[e], v[e]); } }
        __syncthreads();
        if (tid == 0) { int s = 0; for (int e = 0; e < 8; ++e) { start[e] = s; s += (tot[e] + 255) / 256 * 256; } start[8] = s; }
        __syncthreads();
        const int RPW = M / G;
        int my_e = 0, my_tok = 0, my_k = 0; float my_g = 0.f;
        if (tid < 2 * RPW) { my_tok = bid * RPW + (tid >> 1); my_k = tid & 1; my_e = tok_e[2 * my_tok + my_k]; my_g = tok_g[2 * my_tok + my_k]; }
        int rank_in_wave = 0;
        if (tid < 2 * RPW) {
#pragma unroll
            for (int e = 0; e < 8; ++e) { const unsigned long long mk = __ballot(my_e == e); if (my_e == e) rank_in_wave = __popcll(mk & ((1ull << lane) - 1ull)); if (lane == 0) wcnt[wave * 8 + e] = __popcll(mk); }
        }
        __syncthreads();
        if (tid < 2 * RPW) { int r = start[my_e] + pre[my_e] + rank_in_wave; for (int w = 0; w < wave; ++w) r += wcnt[w * 8 + my_e];
            rowinfo[r] = my_tok | (my_k << 16); rowgate[r] = my_g; }
        if (bid == 0) {
            for (int e = 0; e < 8; ++e) { const int a = start[e] + tot[e], z = start[e + 1]; for (int r = a + tid; r < z; r += NTHREADS) { rowinfo[r] = -1; rowgate[r] = 0.f; } }
            const int nt = start[8] / 256;
            for (int t = tid; t < nt; t += NTHREADS) { int e = 0; while (e < 7 && t * 256 >= start[e + 1]) ++e; tile_e[t] = e; }
            if (tid == 0) ctl[CW_NTILES] = (unsigned)nt;
        }
        __syncthreads();
        SEAM(13);
    }
    if (IN(14)) {
        const int ntl = (int)__builtin_amdgcn_readfirstlane(ld_agent(ctl + CW_NTILES));
        LAS int* te = (LAS int*)(lds + MISC_OFF + 16384);
        for (int i = tid; i < ntl; i += NTHREADS) te[i] = tile_e[i];
        __syncthreads();
        if (ntl > 0) { pg8::Gemm g{XQ, ws + W_MGU, D}; pg8::MoeGatherOrder S{ntl, NGU / 256, G, bid, 0, te, false, rowinfo, lds + MISC_OFF}; pg8::EpiSwiGLU8 E{ACT8, FF};
            pg8::gemm_phase<pg8::EpiSwiGLU8, pg8::MoeGatherOrder, 8>(lds, g, S, E); }
        SEAM(14);
    }
    if (IN(15)) {
        const int ntl = (int)__builtin_amdgcn_readfirstlane(ld_agent(ctl + CW_NTILES));
        LAS int* te = (LAS int*)(lds + MISC_OFF + 16384);
        for (int i = tid; i < ntl; i += NTHREADS) te[i] = tile_e[i];
        __syncthreads();
        if (ntl > 0) { pg8::Gemm g{ACT8, ws + W_MDN, FF}; pg8::MoeOrder S{ntl, D / 256, G, bid, 0, te, true, nullptr, nullptr}; pg8::EpiMoeDown E{Y0, Y1, rowinfo, rowgate, 1.0f / (SC_ACT * SC_WDN)};
            pg8::gemm_phase<pg8::EpiMoeDown, pg8::MoeOrder, 0>(lds, g, S, E); }
        SEAM(15);
    }
    if (IN(16)) {
        const size_t n8 = (size_t)M * D / 8;
        for (size_t i = (size_t)bid * NTHREADS + tid; i < n8; i += (size_t)G * NTHREADS) {
            const u32x4 h = *(const u32x4*)(H3B + i * 8), w0 = *(const u32x4*)(Y0 + i * 8), w1 = *(const u32x4*)(Y1 + i * 8); f32x4* o = (f32x4*)(out + i * 8);
            f32x4 a, b;
            a.x = bflo(h.x) + (bflo(w0.x) + bflo(w1.x)); a.y = bfhi(h.x) + (bfhi(w0.x) + bfhi(w1.x)); a.z = bflo(h.y) + (bflo(w0.y) + bflo(w1.y)); a.w = bfhi(h.y) + (bfhi(w0.y) + bfhi(w1.y));
            b.x = bflo(h.z) + (bflo(w0.z) + bflo(w1.z)); b.y = bfhi(h.z) + (bfhi(w0.z) + bfhi(w1.z)); b.z = bflo(h.w) + (bflo(w0.w) + bflo(w1.w)); b.w = bfhi(h.w) + (bfhi(w0.w) + bfhi(w1.w));
            o[0] = a; o[1] = b;
        }
    }
#undef IN
#undef SEAM
}

extern "C" void kernel_launch(void* const* d_in, const int* in_sizes, int n_in, void* d_out, int out_size, void* d_ws, size_t ws_size, hipStream_t stream) {
    static int grid = 0;
    if (grid == 0) {
        if (n_in != 22 || in_sizes[0] != M * D || out_size != M * D || ws_size < WS_END) {
            fprintf(stderr, "kernel_launch: unexpected shapes (n_in %d, in0 %d, out %d, ws %zu < %zu); nothing launched\n", n_in, n_in > 0 ? in_sizes[0] : -1, out_size, ws_size, (size_t)WS_END); grid = -1; return; }
        int dev = 0, cus = 0, per_cu = 0;
        if (hipGetDevice(&dev) != hipSuccess || hipDeviceGetAttribute(&cus, hipDeviceAttributeMultiprocessorCount, dev) != hipSuccess) { grid = -1; return; }
        if (hipFuncSetAttribute((const void*)enc_fwd, hipFuncAttributeMaxDynamicSharedMemorySize, LDS_BYTES) != hipSuccess) { fprintf(stderr, "kernel_launch: hipFuncSetAttribute failed\n"); grid = -1; return; }
        if (hipOccupancyMaxActiveBlocksPerMultiprocessor(&per_cu, (const void*)enc_fwd, NTHREADS, LDS_BYTES) != hipSuccess || per_cu < 1)
            fprintf(stderr, "kernel_launch: note: occupancy query reports %d workgroups per CU\n", per_cu);
        (void)hipGetLastError();
        grid = cus;
        if (grid != 256) { fprintf(stderr, "kernel_launch: built for 256 CUs, device has %d; nothing launched\n", cus); grid = -1; return; }
    }
    if (grid < 0) return;
    if (hipMemsetAsync((char*)d_ws + WS_CTL, 0, CTL_ZERO_BYTES, stream) != hipSuccess) return;
    Args a{};
    for (int i = 0; i < 22; ++i) a.in[i] = (const float*)d_in[i];
    a.out = (float*)d_out; a.ws = (unsigned char*)d_ws;
#if MK_N_LAUNCHES == 1
    a.ph_lo = 0; a.ph_hi = NPHASES;
    hipLaunchKernelGGL(enc_fwd, dim3(grid), dim3(NTHREADS), LDS_BYTES, stream, a);
#else
    for (int p = 0; p < NPHASES; ++p) { a.ph_lo = p; a.ph_hi = p + 1; hipLaunchKernelGGL(enc_fwd, dim3(grid), dim3(NTHREADS), LDS_BYTES, stream, a);
    }
#endif
}
```

```cpp
#include <hip/hip_runtime.h>
#include <cstdio>
#include <cstdint>

#ifndef MK_N_LAUNCHES
#define MK_N_LAUNCHES 1
#endif

#define LAS __attribute__((address_space(3)))
#define GAS __attribute__((address_space(1)))
typedef unsigned short bf16_t;
typedef short bf16x8 __attribute__((ext_vector_type(8)));
typedef short bf16x4 __attribute__((ext_vector_type(4)));
typedef float f32x4 __attribute__((ext_vector_type(4)));
typedef float f32x2 __attribute__((ext_vector_type(2)));
typedef unsigned u32x4 __attribute__((ext_vector_type(4)));
typedef unsigned u32x2 __attribute__((ext_vector_type(2)));
typedef int i32x4 __attribute__((ext_vector_type(4)));
typedef int i32x8 __attribute__((ext_vector_type(8)));

constexpr int D = 2048, NB = 2, SEQ = 16384, M = NB * SEQ, NMETA = 16, NH = 16, HD = 128, GW = 64, GR = 256;
constexpr int FF = 7168, NE = 8, NQKV = 3 * D, NGU = 2 * FF;
constexpr float RMS_EPS = 1e-6f;
constexpr float LOG2E = 1.4426950408889634f;
constexpr int NWAVES = 8, NTHREADS = 512;
constexpr int MAXTILES = 264;

constexpr size_t MiB = 1u << 20;
constexpr size_t WS_CTL = 0, CTL_ZERO_BYTES = 64 * 1024;
constexpr size_t WS_META = 1 * MiB;
constexpr size_t MT_QKV = WS_META, MT_O = MT_QKV + 16 * NQKV * 4, MT_H1 = MT_O + 16 * D * 4, MT_GU = MT_H1 + 16 * D * 4, MT_H2 = MT_GU + 16 * NGU * 4,
                 MT_CGU = MT_H2 + 16 * D * 4, MT_END = MT_CGU + 16 * 2 * D * 4;
static_assert(MT_END <= 3 * MiB, "meta scratch");
constexpr size_t WS_RS1 = 5 * MiB + 512 * 1024, WS_RS2 = WS_RS1 + (size_t)M * 8 * 4;
constexpr size_t WS_MOE = 4 * MiB;
constexpr size_t MO_TOKE = WS_MOE, MO_TOKG = MO_TOKE + (size_t)M * 8, MO_CNT = MO_TOKG + (size_t)M * 8, MO_ROWINFO = MO_CNT + 256 * 8 * 4,
                 MO_ROWGATE = MO_ROWINFO + (size_t)MAXTILES * 256 * 4, MO_TILEE = MO_ROWGATE + (size_t)MAXTILES * 256 * 4, MO_END = MO_TILEE + 2048;
static_assert(MO_END <= 5 * MiB + 512 * 1024, "moe tables");
constexpr size_t WS_WB = 8 * MiB;
constexpr size_t W_QKV = WS_WB, W_O = W_QKV + (size_t)NQKV * D * 2, W_GU = W_O + (size_t)D * D * 2, W_DN = W_GU + (size_t)NGU * D * 2,
                 W_IN = W_DN + (size_t)D * FF * 2, W_OUT = W_IN + (size_t)NQKV * D * 2, W_MGU = W_OUT + (size_t)D * D * 2, W_MDN = W_MGU + (size_t)NE * NGU * D,
                 W_END = W_MDN + (size_t)NE * D * FF;
static_assert(W_END == (8 + 148 + 336) * MiB, "weights");
constexpr size_t WS_XA = W_END;
constexpr size_t WS_BIG = WS_XA + (size_t)M * D * 2;
constexpr size_t WS_XBUF = WS_BIG + (size_t)MAXTILES * 256 * FF;
constexpr size_t W_QKV8 = WS_XBUF + (size_t)MAXTILES * 256 * D;
constexpr size_t W_O8 = W_QKV8 + (size_t)NQKV * D;
constexpr size_t W_GU8 = W_O8 + (size_t)D * D;
constexpr size_t WS_H1B = W_GU8 + (size_t)NGU * D;
constexpr size_t WS_H2B = WS_H1B + (size_t)M * D * 2;
constexpr size_t W_DN8 = WS_H2B + (size_t)M * D * 2;
constexpr size_t WS_END = W_DN8 + (size_t)D * FF;
static_assert((size_t)MAXTILES * 256 * FF >= (size_t)M * FF * 2, "BIG holds the dense act too");
constexpr size_t WS_XQ = WS_XA + (size_t)M * D;
constexpr size_t WS_Y1 = WS_XA;

constexpr int CW_TMO = 0, CW_NTILES = 64, CW_BAR = 4096;

constexpr int RING_BYTES = 131072;
constexpr int MISC_OFF = RING_BYTES;
constexpr int LDS_BYTES = 163840 - 1024;
constexpr int XBW_OFF = LDS_BYTES - 64;

#define RLX_AGENT __ATOMIC_RELAXED, __HIP_MEMORY_SCOPE_AGENT
#define LDS_WAIT() asm volatile("s_waitcnt lgkmcnt(0)" ::: "memory")
#define VM_WAIT() asm volatile("s_waitcnt vmcnt(0)" ::: "memory")
typedef __bf16 bf16v2 __attribute__((ext_vector_type(2)));
__device__ __forceinline__ unsigned cvt_pk_bf16(float lo, float hi) { const f32x2 v = (f32x2){lo, hi}; return __builtin_bit_cast(unsigned, __builtin_convertvector(v, bf16v2)); }
__device__ __forceinline__ float bf2f(unsigned short b) { return __builtin_bit_cast(float, (unsigned)b << 16); }
__device__ __forceinline__ float bflo(unsigned w) { return __builtin_bit_cast(float, w << 16); }
__device__ __forceinline__ float bfhi(unsigned w) { return __builtin_bit_cast(float, w & 0xffff0000u); }
__device__ __forceinline__ float wave_sum(float v) {
#pragma unroll
    for (int o = 1; o < 64; o <<= 1) v += __shfl_xor(v, o);
    return v;
}
__device__ __forceinline__ float wave_max(float v) {
#pragma unroll
    for (int o = 1; o < 64; o <<= 1) v = fmaxf(v, __shfl_xor(v, o));
    return v;
}
__device__ __forceinline__ void ld8bf(const bf16_t* p, float (&z)[8]) { const u32x4 w = *(const u32x4*)p;
    z[0] = bflo(w.x); z[1] = bfhi(w.x); z[2] = bflo(w.y); z[3] = bfhi(w.y); z[4] = bflo(w.z); z[5] = bfhi(w.z); z[6] = bflo(w.w); z[7] = bfhi(w.w); }
__device__ __forceinline__ void lds_add(LAS int* p, int v) { __hip_atomic_fetch_add((int*)p, v, __ATOMIC_RELAXED, __HIP_MEMORY_SCOPE_WORKGROUP); }
__device__ __forceinline__ unsigned ld_agent(const unsigned* p) { return __hip_atomic_load(p, RLX_AGENT); }
__device__ __forceinline__ float ld_agent_f(const float* p) { return __builtin_bit_cast(float, __hip_atomic_load((const unsigned*)p, RLX_AGENT)); }
__device__ __forceinline__ int ld_agent_i(const int* p) { return (int)__hip_atomic_load((const unsigned*)p, RLX_AGENT); }


constexpr float SC_ACT = 8.f, SC_WDN = 64.f;
__device__ __forceinline__ float sat8(float v) { return __builtin_amdgcn_fmed3f(v, -448.f, 448.f); }
__device__ __forceinline__ unsigned pk4_fp8(float a, float b, float c, float d) { int w = 0; w = __builtin_amdgcn_cvt_pk_fp8_f32(sat8(a), sat8(b), w, false); w = __builtin_amdgcn_cvt_pk_fp8_f32(sat8(c), sat8(d), w, true); return (unsigned)w; }

constexpr float SC_A8B = 24.f;
constexpr float SC_A8 = 28.f, SC_W8 = 1536.f;
constexpr float SC_O8 = 160.f;
constexpr float SC_YR = 20.f;
constexpr float SC_ACTR = 32.f, SC_WDR = 2880.f;
__device__ __forceinline__ void wht_inlane8(float (&v)[8]) {
#pragma unroll
    for (int h = 1; h < 8; h <<= 1)
#pragma unroll
        for (int i = 0; i < 8; ++i) if ((i & h) == 0) { const float a = v[i], b = v[i + h]; v[i] = a + b; v[i + h] = a - b; }
}
__device__ __forceinline__ unsigned q8m(float v) { const float MG = 12582912.f; return __builtin_bit_cast(unsigned, __builtin_amdgcn_fmed3f(v + MG, MG - 127.f, MG + 127.f)); }
__device__ __forceinline__ unsigned pk4_i8(float a, float b, float c, float d) {
    const unsigned lo = __builtin_amdgcn_perm(q8m(b), q8m(a), 0x0c0c0400u), hi = __builtin_amdgcn_perm(q8m(d), q8m(c), 0x0c0c0400u);
    return __builtin_amdgcn_perm(hi, lo, 0x05040100u); }

namespace pg8 {
constexpr int BM = 256, BK = 64, HALF = 128, HTB = HALF * BK * 2, STAGE_BYTES = 8 * HTB, NXCD = 8;
__host__ __device__ __forceinline__ int lds_byte(int r, int c) { const int st = (r >> 4) * 2 + (c >> 5), rr = r & 15, cc = c & 31, ob = rr * 64 + cc * 2; return st * 1024 + (ob ^ (((ob >> 9) & 1) << 5)); }
__host__ __device__ __forceinline__ void stage_rc(int b, int& R, int& C) { const int st = b / 1024, sb = b % 1024, swz = sb ^ (((sb >> 9) & 1) << 5); R = (st >> 1) * 16 + swz / 64; C = (st & 1) * 32 + (swz % 64) / 2; }
__host__ __device__ __forceinline__ int perm32(int rho) { const int n = rho >> 4, i = rho & 15; return 8 * (i >> 2) + 4 * n + (i & 3); }

struct Unit { int pm, pn, pb, po, ui, roff; };
struct Gemm { const void* A; const void* Bt; int KB; };

__device__ __forceinline__ bool tile_of(int i, int G, int c, int nM, int nN, int& pm, int& pn) {
    const int WGM = nN <= 24 ? 4 : 8;
    const int nwg = nM * nN; const long L = (long)i * G + c; if (L >= nwg) return false;
    int wgid = (int)L; { const int q = nwg / NXCD, r = nwg % NXCD, xcd = wgid % NXCD, off = wgid / NXCD; wgid = (xcd < r ? xcd * (q + 1) : r * (q + 1) + (xcd - r) * q) + off; }
    const int nig = WGM * nN, gid = wgid / nig, fm = gid * WGM, gsz = (nM - fm) < WGM ? (nM - fm) : WGM;
    pm = fm + ((wgid % nig) % gsz); pn = (wgid % nig) / gsz; return true;
}
struct StaticOrder {
    static constexpr bool GATHER = false;
    int nM, nN, G, c;
    __device__ __forceinline__ void init(int M_, int N_, int G_, int c_) { nM = M_ / BM; nN = N_ / BM; G = G_; c = c_; }
    __device__ __forceinline__ bool next(int i, Unit& u) const { int pm, pn; if (!tile_of(i, G, c, nM, nN, pm, pn)) return false; u.pm = pm; u.pn = pn; u.pb = pn; u.po = pm; u.roff = 0; return true; }
};
__device__ __forceinline__ int lds_ld_i32(unsigned addr) { int r; asm volatile("ds_read_b32 %0, %1\n\ts_waitcnt lgkmcnt(0)" : "=v"(r) : "v"(addr) : "memory"); return r; }
template <bool GA> struct MoeOrderT {
    static constexpr bool GATHER = GA;
    int nM, nN, G, c, t0; LAS const int* tile_e; bool a_local; const int* rowinfo; LAS unsigned char* gl; int imax;
    __device__ __forceinline__ bool next(int i, Unit& u) const {
        int pm, pn; if (i >= imax || !tile_of(i, G, c, nM, nN, pm, pn)) return false;
        u.roff = 0;
        const int e = __builtin_amdgcn_readfirstlane(lds_ld_i32((unsigned)(size_t)(tile_e + t0 + pm)));
        u.pn = pn; u.pb = e * nN + pn; u.pm = a_local ? pm : t0 + pm; u.po = a_local ? t0 + pm : pm; return true; }
    __device__ __forceinline__ bool row_tile(int i, int& tile) const { int pm, pn; if (!tile_of(i, G, c, nM, nN, pm, pn)) return false; tile = t0 + pm; return true; }
};
struct MoeTailOrder {
    static constexpr bool GATHER = false;
    int nM, nN, G, c, i0; LAS const int* tile_e;
    __device__ __forceinline__ bool next(int i, Unit& u) const {
        const int nleft = nM * nN - i0 * G, j = i * G + c; if (nleft <= 0 || j >= 2 * nleft) return false;
        int pm, pn; if (!tile_of(i0, G, j >> 1, nM, nN, pm, pn)) return false;
        const int e = __builtin_amdgcn_readfirstlane(lds_ld_i32((unsigned)(size_t)(tile_e + pm)));
        u.pn = pn; u.pb = e * nN + pn; u.pm = pm; u.po = pm; u.roff = (j & 1) * HALF; return true; }
};
typedef MoeOrderT<false> MoeOrder;
typedef MoeOrderT<true> MoeGatherOrder;

struct EpiStoreBf16 {
    static constexpr bool PERM = true, RS_LDS = false;
    bf16_t* O; int ldc; float sc;
    __device__ __forceinline__ void operator()(const f32x4 (&acc)[2][2][4][2], const Unit& u, int wr, int wc, int fr, int fq) const {
        const int row0 = u.po * BM + wr * 64 + fr, col0 = u.pn * BM + wc * 32 + 8 * fq;
#pragma unroll
        for (int ai = 0; ai < 2; ++ai)
#pragma unroll
            for (int m = 0; m < 4; ++m) { bf16_t* rowp = O + (size_t)(row0 + ai * HALF + m * 16) * ldc + col0;
#pragma unroll
                for (int bj = 0; bj < 2; ++bj) { const f32x4 v0 = acc[ai][bj][m][0] * sc, v1 = acc[ai][bj][m][1] * sc;
                    u32x4 w; w.x = cvt_pk_bf16(v0[0], v0[1]); w.y = cvt_pk_bf16(v0[2], v0[3]); w.z = cvt_pk_bf16(v1[0], v1[1]); w.w = cvt_pk_bf16(v1[2], v1[3]);
                    *(u32x4*)(rowp + bj * HALF) = w; } }
    }
};
struct EpiQKV {
    static constexpr bool PERM = true, RS_LDS = false;
    bf16_t* O; int ldc; float sc; const float* q_gain; const float* k_gain; LAS float* P;
    __device__ __forceinline__ void operator()(const f32x4 (&acc)[2][2][4][2], const Unit& u, int wr, int wc, int fr, int fq) const {
        const int rl0 = wr * 64 + fr, row0 = u.po * BM + rl0, col0 = u.pn * BM + wc * 32 + 8 * fq;
        if (u.pn >= 16) {
#pragma unroll
            for (int ai = 0; ai < 2; ++ai)
#pragma unroll
                for (int m = 0; m < 4; ++m) { bf16_t* rowp = O + (size_t)(row0 + ai * HALF + m * 16) * ldc + col0;
#pragma unroll
                    for (int bj = 0; bj < 2; ++bj) { const f32x4 v0 = acc[ai][bj][m][0] * sc, v1 = acc[ai][bj][m][1] * sc;
                        u32x4 w; w.x = cvt_pk_bf16(v0[0], v0[1]); w.y = cvt_pk_bf16(v0[2], v0[3]); w.z = cvt_pk_bf16(v1[0], v1[1]); w.w = cvt_pk_bf16(v1[2], v1[3]);
                        *(u32x4*)(rowp + bj * HALF) = w; } }
            return;
        }
#pragma unroll
        for (int ai = 0; ai < 2; ++ai)
#pragma unroll
            for (int m = 0; m < 4; ++m)
#pragma unroll
                for (int bj = 0; bj < 2; ++bj) { const f32x4 a = acc[ai][bj][m][0], b = acc[ai][bj][m][1];
                    float ss = (a.x * a.x + a.y * a.y) + (a.z * a.z + a.w * a.w) + (b.x * b.x + b.y * b.y) + (b.z * b.z + b.w * b.w);
                    ss += __shfl_xor(ss, 16); ss += __shfl_xor(ss, 32);
                    if (fq == 0) P[((rl0 + ai * HALF + m * 16) * 2 + bj) * 4 + wc] = ss; }
        asm volatile("s_waitcnt lgkmcnt(0)" ::: "memory"); __builtin_amdgcn_s_barrier(); asm volatile("" ::: "memory");
        const bool isq = u.pn < 8; const float* gn = (isq ? q_gain : k_gain) + wc * 32 + 8 * fq; const float gs = isq ? 0.08838834764831845f * LOG2E : 1.0f;
        const f32x4 g0 = *(const f32x4*)gn * gs, g1 = *(const f32x4*)(gn + 4) * gs;
#pragma unroll
        for (int ai = 0; ai < 2; ++ai)
#pragma unroll
            for (int m = 0; m < 4; ++m) { bf16_t* rowp = O + (size_t)(row0 + ai * HALF + m * 16) * ldc + col0;
#pragma unroll
                for (int bj = 0; bj < 2; ++bj) { const f32x4 q = *(const LAS f32x4*)(P + ((rl0 + ai * HALF + m * 16) * 2 + bj) * 4);
                    const float r = __builtin_amdgcn_rsqf(((q.x + q.y) + (q.z + q.w)) * (sc * sc) * (1.0f / HD) + RMS_EPS) * sc;
                    const f32x4 v0 = acc[ai][bj][m][0] * g0 * r, v1 = acc[ai][bj][m][1] * g1 * r;
                    u32x4 w; w.x = cvt_pk_bf16(v0[0], v0[1]); w.y = cvt_pk_bf16(v0[2], v0[3]); w.z = cvt_pk_bf16(v1[0], v1[1]); w.w = cvt_pk_bf16(v1[2], v1[3]);
                    *(u32x4*)(rowp + bj * HALF) = w; } }
    }
};
template <bool BASE_BF16> struct EpiResidNormB {
    static constexpr bool PERM = true, RS_LDS = false;
    const void* base; bf16_t* ob; unsigned char* hb; float* rsp; int ldc; LAS float* P; float sc; float hsc;
    __device__ __forceinline__ void operator()(const f32x4 (&acc)[2][2][4][2], const Unit& u, int wr, int wc, int fr, int fq) const {
        const int rl0 = wr * 64 + fr, row0 = u.po * BM + rl0, col0 = u.pn * BM + wc * 32 + 8 * fq;
#pragma unroll
        for (int ai = 0; ai < 2; ++ai)
#pragma unroll
            for (int m = 0; m < 4; ++m) { const int row = row0 + ai * HALF + m * 16; const size_t off = (size_t)row * ldc + col0; float ss = 0.f;
#pragma unroll
                for (int bj = 0; bj < 2; ++bj) { f32x4 b0, b1;
                    if constexpr (BASE_BF16) { const u32x4 w = *(const u32x4*)((const bf16_t*)base + off + bj * HALF);
                        b0 = (f32x4){bflo(w.x), bfhi(w.x), bflo(w.y), bfhi(w.y)}; b1 = (f32x4){bflo(w.z), bfhi(w.z), bflo(w.w), bfhi(w.w)}; }
                    else { const f32x4* bp = (const f32x4*)((const float*)base + off + bj * HALF); b0 = bp[0]; b1 = bp[1]; }
                    const f32x4 v0 = b0 + acc[ai][bj][m][0] * sc, v1 = b1 + acc[ai][bj][m][1] * sc;
                    u32x4 w; w.x = cvt_pk_bf16(v0[0], v0[1]); w.y = cvt_pk_bf16(v0[2], v0[3]); w.z = cvt_pk_bf16(v1[0], v1[1]); w.w = cvt_pk_bf16(v1[2], v1[3]);
                    *(u32x4*)(ob + off + bj * HALF) = w;
                    u32x2 q; q.x = pk4_i8(v0[0] * hsc, v0[1] * hsc, v0[2] * hsc, v0[3] * hsc); q.y = pk4_i8(v1[0] * hsc, v1[1] * hsc, v1[2] * hsc, v1[3] * hsc);
                    *(u32x2*)(hb + off + bj * HALF) = q;
                    ss += ((v0.x * v0.x + v0.y * v0.y) + (v0.z * v0.z + v0.w * v0.w)) + ((v1.x * v1.x + v1.y * v1.y) + (v1.z * v1.z + v1.w * v1.w)); }
                ss += __shfl_xor(ss, 16); ss += __shfl_xor(ss, 32);
                if (fq == 0) P[(rl0 + ai * HALF + m * 16) * 4 + wc] = ss; }
        asm volatile("s_waitcnt lgkmcnt(0)" ::: "memory"); __builtin_amdgcn_s_barrier(); asm volatile("" ::: "memory");
        const int t = threadIdx.x;
        if (t < BM) { const LAS f32x4* pp = (const LAS f32x4*)(P + t * 4); const f32x4 q = *pp; rsp[(size_t)(u.po * BM + t) * 8 + u.pn] = (q.x + q.y) + (q.z + q.w); }
    }
};
struct EpiResidB {
    static constexpr bool PERM = true, RS_LDS = false;
    const bf16_t* base; bf16_t* ob; int ldc; float sc;
    __device__ __forceinline__ void operator()(const f32x4 (&acc)[2][2][4][2], const Unit& u, int wr, int wc, int fr, int fq) const {
        const int row0 = u.po * BM + wr * 64 + fr, col0 = u.pn * BM + wc * 32 + 8 * fq;
#pragma unroll
        for (int ai = 0; ai < 2; ++ai)
#pragma unroll
            for (int m = 0; m < 4; ++m) { const size_t off = (size_t)(row0 + ai * HALF + m * 16) * ldc + col0;
#pragma unroll
                for (int bj = 0; bj < 2; ++bj) { const u32x4 b = *(const u32x4*)(base + off + bj * HALF);
                    const f32x4 v0 = (f32x4){bflo(b.x), bfhi(b.x), bflo(b.y), bfhi(b.y)} + acc[ai][bj][m][0] * sc, v1 = (f32x4){bflo(b.z), bfhi(b.z), bflo(b.w), bfhi(b.w)} + acc[ai][bj][m][1] * sc;
                    u32x4 w; w.x = cvt_pk_bf16(v0[0], v0[1]); w.y = cvt_pk_bf16(v0[2], v0[3]); w.z = cvt_pk_bf16(v1[0], v1[1]); w.w = cvt_pk_bf16(v1[2], v1[3]);
                    *(u32x4*)(ob + off + bj * HALF) = w; } }
    }
};
__device__ __forceinline__ void rs_prefetch(const float* rs, LAS float* PR, const Unit& u, int wid, int tid) {
    __builtin_amdgcn_global_load_lds((const unsigned*)(rs + (size_t)(u.po * BM) * 8 + tid * 4), (LAS unsigned*)((LAS unsigned char*)PR + (u.ui & 1) * 8192 + wid * 1024), 16, 0, 0); }
__device__ __forceinline__ float row_rstd8(const LAS float* PR, const Unit& u, int rl) { const LAS f32x4* p = (const LAS f32x4*)(PR + (u.ui & 1) * 2048 + rl * 8); const f32x4 a = p[0], b = p[1];
    return __builtin_amdgcn_rsqf((((a.x + a.y) + (a.z + a.w)) + ((b.x + b.y) + (b.z + b.w))) * (1.0f / D) + RMS_EPS); }
__device__ __forceinline__ float silu_mul(float g, float u) { return g * u * __builtin_amdgcn_rcpf(1.0f + __builtin_amdgcn_exp2f(-g * LOG2E)); }
__device__ __forceinline__ f32x4 silu_mul4(f32x4 g, f32x4 u) {
    const f32x2 ga = (f32x2){g.x, g.y}, gb = (f32x2){g.z, g.w}, ua = (f32x2){u.x, u.y}, ub = (f32x2){u.z, u.w};
    const f32x2 ta = ga * (-LOG2E), tb = gb * (-LOG2E);
    f32x2 ea, eb; ea.x = __builtin_amdgcn_exp2f(ta.x); ea.y = __builtin_amdgcn_exp2f(ta.y); eb.x = __builtin_amdgcn_exp2f(tb.x); eb.y = __builtin_amdgcn_exp2f(tb.y);
    const f32x2 da = ea + 1.0f, db = eb + 1.0f;
    f32x2 ra, rb; ra.x = __builtin_amdgcn_rcpf(da.x); ra.y = __builtin_amdgcn_rcpf(da.y); rb.x = __builtin_amdgcn_rcpf(db.x); rb.y = __builtin_amdgcn_rcpf(db.y);
    const f32x2 oa = (ga * ua) * ra, ob = (gb * ub) * rb;
    return (f32x4){oa.x, oa.y, ob.x, ob.y}; }
struct EpiSwiGLU {
    static constexpr bool PERM = true, RS_LDS = true;
    unsigned char* O; int ldc; const float* rs; float sc; LAS float* PR;
    __device__ __forceinline__ void prefetch(const Unit& u, int wid, int tid) const { rs_prefetch(rs, PR, u, wid, tid); }
    __device__ __forceinline__ void operator()(const f32x4 (&acc)[2][2][4][2], const Unit& u, int wr, int wc, int fr, int fq) const {
        const int row0 = u.po * BM + wr * 64 + fr, col0 = u.pn * HALF + wc * 32 + 8 * fq; const float qs = SC_ACTR * 0.35355339059327373f;
#pragma unroll
        for (int ai = 0; ai < 2; ++ai)
#pragma unroll
            for (int m = 0; m < 4; ++m) { const int row = row0 + ai * HALF + m * 16; unsigned char* rowp = O + (size_t)row * ldc + col0;
                const float r = row_rstd8(PR, u, wr * 64 + fr + ai * HALF + m * 16) * sc;
                const f32x4 g0 = acc[ai][0][m][0] * r, g1 = acc[ai][0][m][1] * r, u0 = acc[ai][1][m][0] * r, u1 = acc[ai][1][m][1] * r;
                const f32x4 s0 = silu_mul4(g0, u0), s1 = silu_mul4(g1, u1);
                float a[8] = {s0[0], s0[1], s0[2], s0[3], s1[0], s1[1], s1[2], s1[3]};
                wht_inlane8(a);
                u32x2 w; w.x = pk4_i8(a[0] * qs, a[1] * qs, a[2] * qs, a[3] * qs); w.y = pk4_i8(a[4] * qs, a[5] * qs, a[6] * qs, a[7] * qs);
                *(u32x2*)rowp = w; }
    }
};
struct EpiWin {
    static constexpr bool PERM = true, RS_LDS = true;
    bf16_t* O; int ldc; const float* rs; float sc; LAS float* PR;
    __device__ __forceinline__ void prefetch(const Unit& u, int wid, int tid) const { rs_prefetch(rs, PR, u, wid, tid); }
    __device__ __forceinline__ void operator()(const f32x4 (&acc)[2][2][4][2], const Unit& u, int wr, int wc, int fr, int fq) const {
        const int row0 = u.po * BM + wr * 64 + fr;
        float rr[2][4];
#pragma unroll
        for (int ai = 0; ai < 2; ++ai)
#pragma unroll
            for (int m = 0; m < 4; ++m) rr[ai][m] = row_rstd8(PR, u, wr * 64 + fr + ai * HALF + m * 16) * sc;
        if (u.pn < 8) {
            const int col0 = u.pn * BM + wc * 32 + 8 * fq;
#pragma unroll
            for (int ai = 0; ai < 2; ++ai)
#pragma unroll
                for (int m = 0; m < 4; ++m) { bf16_t* rowp = O + (size_t)(row0 + ai * HALF + m * 16) * ldc + col0;
#pragma unroll
                    for (int bj = 0; bj < 2; ++bj) { const f32x4 v0 = acc[ai][bj][m][0] * rr[ai][m], v1 = acc[ai][bj][m][1] * rr[ai][m];
                        u32x4 w; w.x = cvt_pk_bf16(v0[0], v0[1]); w.y = cvt_pk_bf16(v0[2], v0[3]); w.z = cvt_pk_bf16(v1[0], v1[1]); w.w = cvt_pk_bf16(v1[2], v1[3]);
                        *(u32x4*)(rowp + bj * HALF) = w; } }
        } else {
            const int col0 = D + (u.pn - 8) * HALF + wc * 32 + 8 * fq;
#pragma unroll
            for (int ai = 0; ai < 2; ++ai)
#pragma unroll
                for (int m = 0; m < 4; ++m) { bf16_t* rowp = O + (size_t)(row0 + ai * HALF + m * 16) * ldc + col0;
                    const float r2 = rr[ai][m] * rr[ai][m]; const f32x4 a0 = acc[ai][0][m][0] * acc[ai][1][m][0] * r2, a1 = acc[ai][0][m][1] * acc[ai][1][m][1] * r2;
                    u32x4 w; w.x = cvt_pk_bf16(a0[0], a0[1]); w.y = cvt_pk_bf16(a0[2], a0[3]); w.z = cvt_pk_bf16(a1[0], a1[1]); w.w = cvt_pk_bf16(a1[2], a1[3]);
                    *(u32x4*)rowp = w; }
        }
    }
};
struct EpiSwiGLU8 {
    static constexpr bool PERM = true, RS_LDS = false;
    unsigned char* O; int ldc;
    __device__ __forceinline__ void operator()(const f32x4 (&acc)[2][2][4][2], const Unit& u, int wr, int wc, int fr, int fq) const {
        const int row0 = u.po * BM + wr * 64 + fr, col0 = u.pn * HALF + wc * 32 + 8 * fq; const float si = 1.0f / (SC_A8 * SC_W8);
#pragma unroll
        for (int ai = 0; ai < 2; ++ai)
#pragma unroll
            for (int m = 0; m < 4; ++m) { unsigned char* rowp = O + (size_t)(row0 + ai * HALF + m * 16) * ldc + col0;
                const f32x4 g0 = acc[ai][0][m][0] * si, g1 = acc[ai][0][m][1] * si, u0 = acc[ai][1][m][0] * (si * SC_ACT), u1 = acc[ai][1][m][1] * (si * SC_ACT);
                const f32x4 s0 = silu_mul4(g0, u0), s1 = silu_mul4(g1, u1);
                u32x2 w; w.x = pk4_fp8(s0[0], s0[1], s0[2], s0[3]); w.y = pk4_fp8(s1[0], s1[1], s1[2], s1[3]);
                __builtin_nontemporal_store(w, (u32x2*)rowp); }
    }
};
template <bool HM = false> struct EpiMoeDownT {
    static constexpr bool PERM = true, RS_LDS = false;
    bf16_t* Y0; bf16_t* Y1; const int* rowinfo; const float* rowgate; float osc;
    __device__ __forceinline__ void operator()(const f32x4 (&acc)[2][2][4][2], const Unit& u, int wr, int wc, int fr, int fq) const {
        const int row0 = u.po * BM + u.roff + wr * 64 + fr, col0 = u.pn * BM + wc * 32 + 8 * fq;
#pragma unroll
        for (int ai = 0; ai < (HM ? 1 : 2); ++ai)
#pragma unroll
            for (int m = 0; m < 4; ++m) { const int r = row0 + ai * HALF + m * 16; const int info = rowinfo[r]; const float g = rowgate[r] * osc;
                if (info >= 0) { const int tok = info & 0xffff; bf16_t* rowp = ((info >> 16) == 0 ? Y0 : Y1) + (size_t)tok * D + col0;
#pragma unroll
                    for (int bj = 0; bj < 2; ++bj) { const f32x4 v0 = acc[ai][bj][m][0] * g, v1 = acc[ai][bj][m][1] * g;
                        u32x4 w; w.x = cvt_pk_bf16(v0[0], v0[1]); w.y = cvt_pk_bf16(v0[2], v0[3]); w.z = cvt_pk_bf16(v1[0], v1[1]); w.w = cvt_pk_bf16(v1[2], v1[3]);
                        *(u32x4*)(rowp + bj * HALF) = w; } } }
    }
};
typedef EpiMoeDownT<false> EpiMoeDown;

template <class Epi, class Sched, int FMT = -1, bool HALFM = false>
__device__ __forceinline__ void gemm_phase(LAS unsigned char* lds, const Gemm g, const Sched& S, const Epi& E) {
    const int tid = threadIdx.x, wid = __builtin_amdgcn_readfirstlane(tid >> 6), lane = tid & 63, wr = wid >> 2, wc = wid & 3, fr = lane & 15, fq = lane >> 4;
    const int KB = g.KB, nt = KB / (BK * 2);
    constexpr bool GA = Sched::GATHER;
    unsigned voffA, voffB; int gR, gC2;
    { int R, C; stage_rc(tid * 16, R, C); const int Rb = Epi::PERM ? ((R & ~31) + perm32(R & 31)) : R; voffA = (unsigned)(R * KB + C * 2); voffB = (unsigned)(Rb * KB + C * 2); gR = R; gC2 = C * 2; }
    const size_t pstep = (size_t)64 * KB;
    const size_t kstep = (size_t)(BK * 2);
    const size_t hstep = (size_t)HALF * KB;
    const size_t tstep = 2 * hstep;
    const size_t hstepA = GA ? 0 : hstep;
    const unsigned ldsw = (unsigned)wid * 1024u;
    const int aoff = lds_byte(wr * 64 + fr, fq * 8), boff = lds_byte(wc * 32 + fr, fq * 8);
#define PG8_SA(b, h) (((b) * 2 + (h)) * HTB)
#define PG8_SB(b, h) ((4 + (b) * 2 + (h)) * HTB)
#define PG8_STAGE2(bufoff, gbase, v0, v1, pst) do { _Pragma("unroll") for (int _i = 0; _i < 2; ++_i) { unsigned _vo = _i ? (v1) : (v0); asm volatile("" : "+v"(_vo)); \
        const char* _gb = (const char*)(gbase) + _i * (pst); asm volatile("" : "+s"(_gb)); \
        __builtin_amdgcn_global_load_lds((const unsigned*)(_gb + _vo), (LAS unsigned*)(lds + (bufoff) + ldsw + _i * 8192), 16, 0, 0); } } while (0)
#define PG8_STAGE(bufoff, gbase, voff) PG8_STAGE2(bufoff, gbase, voff, voff, pstep)
#define PG8_STAGE_A(bufoff, gbase, h, nx) do { if constexpr (GA) PG8_STAGE2(bufoff, gbase, ((nx) ? vn[h][0] : vc[h][0]), ((nx) ? vn[h][1] : vc[h][1]), 0); else PG8_STAGE2(bufoff, gbase, voffA, voffA, pstep); } while (0)
#define PG8_GISSUE(tile, slot) __builtin_amdgcn_global_load_lds((const unsigned*)(S.rowinfo + (size_t)(tile) * 256 + lane * 4), (LAS unsigned*)(S.gl + wid * 2048 + (slot) * 1024), 16, 0, 0)
#define PG8_GREAD(dst, slot) do { _Pragma("unroll") for (int _h = 0; _h < 2; ++_h) _Pragma("unroll") for (int _i = 0; _i < 2; ++_i) { \
        const int _info = lds_ld_i32((unsigned)(size_t)(S.gl + wid * 2048 + (slot) * 1024) + (unsigned)((_h * 128 + _i * 64 + gR) * 4)); \
        dst[_h][_i] = (unsigned)((_info < 0 ? 0 : (_info & 0xffff)) * KB + gC2); } } while (0)
#define PG8_LDA(dst, b, h) do { _Pragma("unroll") for (int m = 0; m < 4; ++m) { dst[m].lo = *(const LAS i32x4*)(lds + PG8_SA(b, h) + aoff + m * 2048); dst[m].hi = *(const LAS i32x4*)(lds + PG8_SA(b, h) + aoff + m * 2048 + 1024); } } while (0)
#define PG8_LDB(dst, b, h) do { _Pragma("unroll") for (int n = 0; n < 2; ++n) { dst[n].lo = *(const LAS i32x4*)(lds + PG8_SB(b, h) + boff + n * 2048); dst[n].hi = *(const LAS i32x4*)(lds + PG8_SB(b, h) + boff + n * 2048 + 1024); } } while (0)
#define PG8_MMA(ai, bj, At, Bt) do { __builtin_amdgcn_s_setprio(1); _Pragma("unroll") for (int m = 0; m < 4; ++m) _Pragma("unroll") for (int n = 0; n < 2; ++n) { \
        if constexpr (FMT == 0) acc[ai][bj][m][n] = __builtin_amdgcn_mfma_scale_f32_16x16x128_f8f6f4(Bt[n], At[m], acc[ai][bj][m][n], 0, 0, 0, 0x7f7f7f7f, 0, 0x7f7f7f7f); \
        else if constexpr (FMT == 8) { const i32x4 _bl = Bt[n].lo, _bh = Bt[n].hi, _al = At[m].lo, _ah = At[m].hi; i32x4 _c = __builtin_bit_cast(i32x4, acc[ai][bj][m][n]); \
               _c = __builtin_amdgcn_mfma_i32_16x16x64_i8(_bl, _al, _c, 0, 0, 0); _c = __builtin_amdgcn_mfma_i32_16x16x64_i8(_bh, _ah, _c, 0, 0, 0); acc[ai][bj][m][n] = __builtin_bit_cast(f32x4, _c); } \
        else { const i32x4 _bl = Bt[n].lo, _bh = Bt[n].hi, _al = At[m].lo, _ah = At[m].hi; \
               acc[ai][bj][m][n] = __builtin_amdgcn_mfma_f32_16x16x32_bf16(__builtin_bit_cast(bf16x8, _bl), __builtin_bit_cast(bf16x8, _al), acc[ai][bj][m][n], 0, 0, 0); \
               acc[ai][bj][m][n] = __builtin_amdgcn_mfma_f32_16x16x32_bf16(__builtin_bit_cast(bf16x8, _bh), __builtin_bit_cast(bf16x8, _ah), acc[ai][bj][m][n], 0, 0, 0); } } __builtin_amdgcn_s_setprio(0); } while (0)
#define PG8_WAIT_V(n) asm volatile("s_waitcnt vmcnt(" #n ")" ::: "memory")
#define PG8_WAIT_VK() do { if constexpr (HALFM) asm volatile("s_waitcnt vmcnt(6)" ::: "memory"); else asm volatile("s_waitcnt vmcnt(8)" ::: "memory"); } while (0)
#define PG8_WAIT_L(n) asm volatile("s_waitcnt lgkmcnt(" #n ")" ::: "memory")
#define PG8_BAR __builtin_amdgcn_s_barrier()
#define PG8_SCHED __builtin_amdgcn_sched_barrier(0)
    Unit cur, nxt; int ui = 0;
    if (!S.next(0, cur)) return;
    cur.ui = 0;
    if constexpr (Epi::RS_LDS) E.prefetch(cur, wid, tid);
    f32x4 acc[2][2][4][2];
#pragma unroll
    for (int a = 0; a < 2; ++a)
#pragma unroll
        for (int b = 0; b < 2; ++b)
#pragma unroll
            for (int m = 0; m < 4; ++m)
#pragma unroll
                for (int n = 0; n < 2; ++n) { typedef unsigned long long u64x2_t __attribute__((ext_vector_type(2))); u64x2_t z_; asm volatile("v_mov_b64 %0, 0" : "=v"(z_.x)); asm volatile("v_mov_b64 %0, 0" : "=v"(z_.y)); acc[a][b][m][n] = __builtin_bit_cast(f32x4, z_); }
    i32x8 At[4], B0[2], B1[2];
    unsigned vc[2][2], vn[2][2];
    if constexpr (GA) { int t1; PG8_GISSUE(cur.pm, 0); if (S.row_tile(1, t1)) PG8_GISSUE(t1, 1); asm volatile("s_waitcnt vmcnt(0)" ::: "memory"); PG8_GREAD(vc, 0);
#pragma unroll
        for (int h = 0; h < 2; ++h) { vn[h][0] = vc[h][0]; vn[h][1] = vc[h][1]; } }
    const char* cA = GA ? (const char*)g.A : (const char*)g.A + (size_t)cur.pm * tstep + (HALFM ? (size_t)cur.roff * KB : 0); const char* cB = (const char*)g.Bt + (size_t)cur.pb * tstep;
    PG8_STAGE(PG8_SB(0, 0), cB, voffB); PG8_STAGE(PG8_SB(0, 1), cB + hstep, voffB); PG8_STAGE_A(PG8_SA(0, 0), cA, 0, false); if constexpr (!HALFM) PG8_STAGE_A(PG8_SA(0, 1), cA + hstepA, 1, false);
    if (wr == 1) PG8_BAR;
    if constexpr (HALFM) PG8_WAIT_V(0); else PG8_WAIT_V(2);
    PG8_BAR;
    PG8_STAGE(PG8_SB(1, 0), cB + kstep, voffB); PG8_STAGE_A(PG8_SA(1, 0), cA + kstep, 0, false); PG8_STAGE(PG8_SB(1, 1), cB + hstep + kstep, voffB);
    PG8_WAIT_V(6); PG8_BAR;
    for (;;) {
        const bool has_next = S.next(ui + 1, nxt); nxt.ui = ui + 1;
        if constexpr (GA) { if (has_next) PG8_GREAD(vn, (ui + 1) & 1); int t2; if (S.row_tile(ui + 2, t2)) PG8_GISSUE(t2, ui & 1); }
        const char* nA = GA ? cA : (has_next ? (const char*)g.A + (size_t)nxt.pm * tstep + (HALFM ? (size_t)nxt.roff * KB : 0) : cA); const char* nB = has_next ? (const char*)g.Bt + (size_t)nxt.pb * tstep : cB;
        for (int t = 0; t < nt; t += 2) {
            const bool last = (t == nt - 2);
            const char* a1 = cA + (size_t)(t + 1) * kstep;
            const char* a2 = last ? nA : cA + (size_t)(t + 2) * kstep; const char* b2 = last ? nB : cB + (size_t)(t + 2) * kstep;
            const char* a3 = a2 + kstep; const char* b3 = b2 + kstep;
            PG8_LDB(B0, 0, 0); PG8_LDB(B1, 0, 1); PG8_SCHED; PG8_LDA(At, 0, 0); if constexpr (!HALFM) PG8_STAGE_A(PG8_SA(1, 1), a1 + hstepA, 1, false);
            PG8_WAIT_VK(); PG8_WAIT_L(0); PG8_BAR; PG8_MMA(0, 0, At, B0); PG8_MMA(0, 1, At, B1); PG8_BAR; PG8_SCHED;
            if constexpr (!HALFM) PG8_LDA(At, 0, 1);
            PG8_STAGE(PG8_SB(0, 0), b2, voffB); PG8_STAGE(PG8_SB(0, 1), b2 + hstep, voffB); PG8_STAGE_A(PG8_SA(0, 0), a2, 0, last);
            PG8_WAIT_VK(); PG8_WAIT_L(0); PG8_BAR; if constexpr (!HALFM) { PG8_MMA(1, 0, At, B0); PG8_MMA(1, 1, At, B1); } PG8_BAR; PG8_SCHED;
            PG8_LDB(B0, 1, 0); PG8_LDB(B1, 1, 1); PG8_SCHED; PG8_LDA(At, 1, 0); if constexpr (!HALFM) PG8_STAGE_A(PG8_SA(0, 1), a2 + hstepA, 1, last);
            PG8_WAIT_VK(); PG8_WAIT_L(0); PG8_BAR; PG8_MMA(0, 0, At, B0); PG8_MMA(0, 1, At, B1); PG8_BAR; PG8_SCHED;
            if constexpr (!HALFM) PG8_LDA(At, 1, 1);
            PG8_STAGE(PG8_SB(1, 0), b3, voffB); PG8_STAGE(PG8_SB(1, 1), b3 + hstep, voffB); PG8_STAGE_A(PG8_SA(1, 0), a3, 0, last);
            PG8_WAIT_VK(); PG8_WAIT_L(0); PG8_BAR; if constexpr (!HALFM) { PG8_MMA(1, 0, At, B0); PG8_MMA(1, 1, At, B1); } PG8_BAR; PG8_SCHED;
        }
        if (wr == 0) PG8_BAR;
        if constexpr (FMT == 8) {
#pragma unroll
            for (int a = 0; a < 2; ++a)
#pragma unroll
                for (int b = 0; b < 2; ++b)
#pragma unroll
                    for (int m = 0; m < 4; ++m)
#pragma unroll
                        for (int n = 0; n < 2; ++n) acc[a][b][m][n] = __builtin_convertvector(__builtin_bit_cast(i32x4, acc[a][b][m][n]), f32x4); }
        E(acc, cur, wr, wc, fr, fq);
        if (!has_next) break;
        if constexpr (Epi::RS_LDS) E.prefetch(nxt, wid, tid);
#pragma unroll
        for (int a = 0; a < 2; ++a)
#pragma unroll
            for (int b = 0; b < 2; ++b)
#pragma unroll
                for (int m = 0; m < 4; ++m)
#pragma unroll
                    for (int n = 0; n < 2; ++n) { typedef unsigned long long u64x2_t __attribute__((ext_vector_type(2))); u64x2_t z_; asm volatile("v_mov_b64 %0, 0" : "=v"(z_.x)); asm volatile("v_mov_b64 %0, 0" : "=v"(z_.y)); acc[a][b][m][n] = __builtin_bit_cast(f32x4, z_); }
        cur = nxt; cA = nA; cB = nB; ++ui;
        if constexpr (GA) {
#pragma unroll
            for (int h = 0; h < 2; ++h) { vc[h][0] = vn[h][0]; vc[h][1] = vn[h][1]; } }
        if (wr == 1) PG8_BAR;
    }
    PG8_WAIT_V(0);
    PG8_BAR;
#undef PG8_SA
#undef PG8_SB
#undef PG8_STAGE
#undef PG8_STAGE2
#undef PG8_STAGE_A
#undef PG8_GISSUE
#undef PG8_GREAD
#undef PG8_LDA
#undef PG8_LDB
#undef PG8_MMA
#undef PG8_WAIT_V
#undef PG8_WAIT_VK
#undef PG8_WAIT_L
#undef PG8_BAR
#undef PG8_SCHED
}
}

#define XB_TMO      128
#define XB_XCNT(j)  (256  + 64 * (j))
#define XB_XSUB(j)  (1280 + 64 * (j))
#define XB_XGEN(j)  (2304 + 64 * (j))
#define XB_TOP      3328
#define XB_TOPGEN   3392
#define XCD_BAR_WORDS 3456
#define XB_SPIN_CAP (1u << 20)
__device__ __forceinline__ unsigned xb_ld(unsigned* p)              { return __hip_atomic_load(p, __ATOMIC_RELAXED, __HIP_MEMORY_SCOPE_AGENT); }
__device__ __forceinline__ unsigned xb_add(unsigned* p, unsigned v) { return __hip_atomic_fetch_add(p, v, __ATOMIC_RELAXED, __HIP_MEMORY_SCOPE_AGENT); }
__device__ __forceinline__ unsigned xb_xcc_id() { return (unsigned)__builtin_amdgcn_s_getreg((3 << 11) | 20) & 0xFu; }
#define XB_SPIN(cond, bar) do { unsigned _sp = 0; while (cond) { __builtin_amdgcn_s_sleep(1); \
    if ((++_sp & 255u) == 0u) { if (xb_ld(&(bar)[XB_TMO])) break; if (_sp > XB_SPIN_CAP) { atomicAdd(&(bar)[XB_TMO], 1u); break; } } } } while (0)
struct XcdBarrier { unsigned* bar; unsigned x; volatile LAS unsigned* st; };
__device__ __forceinline__ XcdBarrier xcd_barrier_post(unsigned* bar, volatile LAS unsigned* st) {
    XcdBarrier b; b.bar = bar; b.x = xb_xcc_id(); b.st = st;
    if (threadIdx.x == 0) (void)xb_add(&bar[XB_XCNT(b.x)], 1u);
    return b;
}
__device__ __forceinline__ void xcd_barrier_complete(unsigned* bar, unsigned x, unsigned& nloc, unsigned& nx) {
    const unsigned G = gridDim.x * gridDim.y * gridDim.z;
    unsigned sum, cnt, mine, sp = 0u;
    for (;;) {
        sum = 0u; cnt = 0u; mine = 0u;
#pragma unroll
        for (unsigned j = 0; j < 16; ++j) { const unsigned c = xb_ld(&bar[XB_XCNT(j)]); sum += c; cnt += (c > 0u) ? 1u : 0u; mine = (j == x) ? c : mine; }
        if (sum == G) break;
        __builtin_amdgcn_s_sleep(1);
        if ((++sp & 255u) == 0u) { if (xb_ld(&bar[XB_TMO])) break; if (sp > XB_SPIN_CAP) { atomicAdd(&bar[XB_TMO], 1u); break; } }
    }
    nloc = mine > 0u ? mine : 1u; nx = cnt > 0u ? cnt : 1u;
}
__device__ __forceinline__ void xcd_barrier(const XcdBarrier& b) {
    asm volatile("s_waitcnt vmcnt(0)" ::: "memory");
    __syncthreads();
    if (threadIdx.x == 0) {
        unsigned* bar = b.bar;
        __builtin_amdgcn_s_waitcnt(0);
        unsigned nloc = b.st[0], nx = b.st[1];
        if (nloc == 0u) { xcd_barrier_complete(bar, b.x, nloc, nx); b.st[0] = nloc; b.st[1] = nx; }
        const unsigned old = xb_add(&bar[XB_XSUB(b.x)], 1u);
        const unsigned gen = old / nloc;
        if (old + 1u == (gen + 1u) * nloc) {
            __builtin_amdgcn_fence(__ATOMIC_RELEASE, "agent");
            asm volatile("s_waitcnt vmcnt(0)" ::: "memory");
            const unsigned og = xb_add(&bar[XB_TOP], 1u);
            const unsigned tg = og / nx;
            if (og + 1u == (tg + 1u) * nx) xb_add(&bar[XB_TOPGEN], 1u);
            else XB_SPIN(xb_ld(&bar[XB_TOPGEN]) == tg, bar);
            __builtin_amdgcn_fence(__ATOMIC_ACQUIRE, "agent");
            xb_add(&bar[XB_XGEN(b.x)], 1u);
            asm volatile("s_waitcnt vmcnt(0)" ::: "memory");
        } else {
            XB_SPIN(xb_ld(&bar[XB_XGEN(b.x)]) == gen, bar);
            __builtin_amdgcn_fence(__ATOMIC_ACQUIRE, "agent");
            asm volatile("s_waitcnt vmcnt(0)" ::: "memory");
        }
    }
    __syncthreads();
}

constexpr int P0S = 65;
__device__ __forceinline__ void p0_load_tile(const float* W, int N, int k0, int n0, LAS float* scr, int lane, const float* kgain = nullptr) {
    f32x4 v[16];
#pragma unroll
    for (int i = 0; i < 16; ++i) v[i] = *(const f32x4*)(W + (size_t)(k0 + 4 * i + (lane >> 4)) * N + n0 + 4 * (lane & 15));
    if (kgain) {
#pragma unroll
        for (int i = 0; i < 16; ++i) v[i] = v[i] * kgain[k0 + 4 * i + (lane >> 4)]; }
#pragma unroll
    for (int i = 0; i < 16; ++i) { LAS float* d = scr + (4 * i + (lane >> 4)) * P0S + 4 * (lane & 15); d[0] = v[i].x; d[1] = v[i].y; d[2] = v[i].z; d[3] = v[i].w; }
    LDS_WAIT(); asm volatile("" ::: "memory");
}
__device__ __forceinline__ void p0_transpose_item(const float* W, int K, int N, bf16_t* WT, int k0, int n0, int drow0, LAS float* scr, int lane, const float* kgain = nullptr) {
    p0_load_tile(W, N, k0, n0, scr, lane, kgain);
    const int c = lane & 7;
#pragma unroll
    for (int j = 0; j < 8; ++j) { const int n = (lane >> 3) + 8 * j; const LAS float* s = scr + (8 * c) * P0S + n;
        u32x4 o; o.x = cvt_pk_bf16(s[0 * P0S], s[1 * P0S]); o.y = cvt_pk_bf16(s[2 * P0S], s[3 * P0S]); o.z = cvt_pk_bf16(s[4 * P0S], s[5 * P0S]); o.w = cvt_pk_bf16(s[6 * P0S], s[7 * P0S]);
        *(u32x4*)(WT + (size_t)(drow0 + n) * K + k0 + 8 * c) = o; }
    LDS_WAIT(); asm volatile("" ::: "memory");
}
template <int BLK>
__device__ __forceinline__ void p0_item_dn(const float* W, int K, int N, bf16_t* WT  , unsigned char* WT8, float wsc, int k0, int n0, LAS float* scr, int lane) {
    p0_load_tile(W, N, k0, n0, scr, lane, nullptr);
    if (WT) { const int c = lane & 7;
#pragma unroll
      for (int j = 0; j < 8; ++j) { const int n = (lane >> 3) + 8 * j; const LAS float* s = scr + (8 * c) * P0S + n;
          u32x4 o; o.x = cvt_pk_bf16(s[0 * P0S], s[1 * P0S]); o.y = cvt_pk_bf16(s[2 * P0S], s[3 * P0S]); o.z = cvt_pk_bf16(s[4 * P0S], s[5 * P0S]); o.w = cvt_pk_bf16(s[6 * P0S], s[7 * P0S]);
          *(u32x4*)(WT + (size_t)(n0 + n) * K + k0 + 8 * c) = o; } }
    { const int c = lane & 3; const float sc = wsc * (BLK == 32 ? 0.17677669529663687f : 0.35355339059327373f);
#pragma unroll
      for (int j = 0; j < 4; ++j) { const int n = (lane >> 2) + 16 * j; const LAS float* s = scr + (16 * c) * P0S + n;
          float f[16];
#pragma unroll
          for (int e = 0; e < 16; ++e) f[e] = s[e * P0S];
#pragma unroll
          for (int h = 1; h < (BLK == 32 ? 16 : 8); h <<= 1)
#pragma unroll
              for (int i = 0; i < 16; ++i) if ((i & h) == 0) { const float a = f[i], b = f[i + h]; f[i] = a + b; f[i + h] = a - b; }
#pragma unroll
          for (int e = 0; e < 16; ++e) { if constexpr (BLK == 32) { const float o = __shfl_xor(f[e], 1); f[e] = ((c & 1) ? o - f[e] : f[e] + o) * sc; } else f[e] *= sc; }
          u32x4 o; o.x = pk4_i8(f[0], f[1], f[2], f[3]); o.y = pk4_i8(f[4], f[5], f[6], f[7]); o.z = pk4_i8(f[8], f[9], f[10], f[11]); o.w = pk4_i8(f[12], f[13], f[14], f[15]);
          *(u32x4*)(WT8 + (size_t)(n0 + n) * K + k0 + 16 * c) = o; } }
    LDS_WAIT(); asm volatile("" ::: "memory");
}
__device__ __forceinline__ void p0_matrix(const float* W, int K, int N, bf16_t* WT, int ilv_half  , int r, LAS float* scr, int lane, const float* kgain = nullptr) {
    const int nblk = N / 64, kb = (r / (4 * nblk)) * 4 + (r & 3), nb = (r >> 2) % nblk, n0 = 64 * nb;
    const int drow0 = ilv_half < 0 ? n0 : (n0 / 128) * 256 + ilv_half * 128 + (n0 % 128);
    p0_transpose_item(W, K, N, WT, 64 * kb, n0, drow0, scr, lane, kgain);
}
__device__ __forceinline__ void p0_transpose_item8(const float* W, int K, int N, unsigned char* WT, int k0, int n0, int drow0, float sc, LAS float* scr, int lane) {
    p0_load_tile(W, N, k0, n0, scr, lane);
    const int c = lane & 3;
#pragma unroll
    for (int j = 0; j < 4; ++j) { const int n = (lane >> 2) + 16 * j; const LAS float* s = scr + (16 * c) * P0S + n;
        u32x4 o; o.x = pk4_fp8(s[0 * P0S] * sc, s[1 * P0S] * sc, s[2 * P0S] * sc, s[3 * P0S] * sc); o.y = pk4_fp8(s[4 * P0S] * sc, s[5 * P0S] * sc, s[6 * P0S] * sc, s[7 * P0S] * sc);
        o.z = pk4_fp8(s[8 * P0S] * sc, s[9 * P0S] * sc, s[10 * P0S] * sc, s[11 * P0S] * sc); o.w = pk4_fp8(s[12 * P0S] * sc, s[13 * P0S] * sc, s[14 * P0S] * sc, s[15 * P0S] * sc);
        *(u32x4*)(WT + (size_t)(drow0 + n) * K + k0 + 16 * c) = o; }
    LDS_WAIT(); asm volatile("" ::: "memory");
}
__device__ __forceinline__ void p0_matrix8(const float* W, int K, int N, unsigned char* WT, int ilv_half, float sc, int r, LAS float* scr, int lane) {
    const int nblk = N / 64, kb = (r / (4 * nblk)) * 4 + (r & 3), nb = (r >> 2) % nblk, n0 = 64 * nb;
    const int drow0 = ilv_half < 0 ? n0 : (n0 / 128) * 256 + ilv_half * 128 + (n0 % 128);
    p0_transpose_item8(W, K, N, WT, 64 * kb, n0, drow0, sc, scr, lane);
}

__device__ __forceinline__ void p0_transpose_item_i8(const float* W, int K, int N, unsigned char* WT, int k0, int n0, int drow0, float sc, LAS float* scr, int lane, const float* kgain) {
    p0_load_tile(W, N, k0, n0, scr, lane, kgain);
    const int c = lane & 3;
#pragma unroll
    for (int j = 0; j < 4; ++j) { const int n = (lane >> 2) + 16 * j; const LAS float* s = scr + (16 * c) * P0S + n;
        u32x4 o; o.x = pk4_i8(s[0 * P0S] * sc, s[1 * P0S] * sc, s[2 * P0S] * sc, s[3 * P0S] * sc); o.y = pk4_i8(s[4 * P0S] * sc, s[5 * P0S] * sc, s[6 * P0S] * sc, s[7 * P0S] * sc);
        o.z = pk4_i8(s[8 * P0S] * sc, s[9 * P0S] * sc, s[10 * P0S] * sc, s[11 * P0S] * sc); o.w = pk4_i8(s[12 * P0S] * sc, s[13 * P0S] * sc, s[14 * P0S] * sc, s[15 * P0S] * sc);
        *(u32x4*)(WT + (size_t)(drow0 + n) * K + k0 + 16 * c) = o; }
    LDS_WAIT(); asm volatile("" ::: "memory");
}
__device__ __forceinline__ void p0_matrix_i8(const float* W, int K, int N, unsigned char* WT, int ilv_half, float sc, int r, LAS float* scr, int lane, const float* kgain) {
    const int nblk = N / 64, kb = (r / (4 * nblk)) * 4 + (r & 3), nb = (r >> 2) % nblk, n0 = 64 * nb;
    const int drow0 = ilv_half < 0 ? n0 : (n0 / 128) * 256 + ilv_half * 128 + (n0 % 128);
    p0_transpose_item_i8(W, K, N, WT, 64 * kb, n0, drow0, sc, scr, lane, kgain);
}

__device__ __forceinline__ void rms_rows_to_bf16(const float* x, const float* gain, bf16_t* o, int m0, int step, int m1, int lane) {
    f32x4 g[4][2];
#pragma unroll
    for (int j = 0; j < 4; ++j) { const f32x4* gp = (const f32x4*)(gain + 8 * (lane + 64 * j)); g[j][0] = gp[0]; g[j][1] = gp[1]; }
    for (int m = m0; m < m1; m += step) {
        const float* xrow = x + (size_t)m * D; bf16_t* orow = o + (size_t)m * D;
        f32x4 v[4][2]; float s = 0.f;
#pragma unroll
        for (int j = 0; j < 4; ++j) { const f32x4* p = (const f32x4*)(xrow + 8 * (lane + 64 * j)); v[j][0] = p[0]; v[j][1] = p[1]; }
#pragma unroll
        for (int j = 0; j < 4; ++j)
            s += (v[j][0].x * v[j][0].x + v[j][0].y * v[j][0].y) + (v[j][0].z * v[j][0].z + v[j][0].w * v[j][0].w) + (v[j][1].x * v[j][1].x + v[j][1].y * v[j][1].y) + (v[j][1].z * v[j][1].z + v[j][1].w * v[j][1].w);
        const float rstd = 1.0f / sqrtf(wave_sum(s) * (1.0f / D) + RMS_EPS);
#pragma unroll
        for (int j = 0; j < 4; ++j) { const f32x4 a = v[j][0] * rstd * g[j][0], b = v[j][1] * rstd * g[j][1];
            u32x4 w; w.x = cvt_pk_bf16(a.x, a.y); w.y = cvt_pk_bf16(a.z, a.w); w.z = cvt_pk_bf16(b.x, b.y); w.w = cvt_pk_bf16(b.z, b.w);
            *(u32x4*)(orow + 8 * (lane + 64 * j)) = w; }
    }
}

__device__ __forceinline__ void rms_rows_to_i8(const float* x, const float* gain, unsigned char* o, int m0, int step, int m1, int lane) {
    f32x4 g[4][2];
#pragma unroll
    for (int j = 0; j < 4; ++j) { const f32x4* gp = (const f32x4*)(gain + 8 * (lane + 64 * j)); g[j][0] = gp[0] * SC_A8; g[j][1] = gp[1] * SC_A8; }
    for (int m = m0; m < m1; m += step) {
        const float* xrow = x + (size_t)m * D; unsigned char* orow = o + (size_t)m * D;
        f32x4 v[4][2]; float s = 0.f;
#pragma unroll
        for (int j = 0; j < 4; ++j) { const f32x4* p = (const f32x4*)(xrow + 8 * (lane + 64 * j)); v[j][0] = p[0]; v[j][1] = p[1]; }
#pragma unroll
        for (int j = 0; j < 4; ++j)
            s += (v[j][0].x * v[j][0].x + v[j][0].y * v[j][0].y) + (v[j][0].z * v[j][0].z + v[j][0].w * v[j][0].w) + (v[j][1].x * v[j][1].x + v[j][1].y * v[j][1].y) + (v[j][1].z * v[j][1].z + v[j][1].w * v[j][1].w);
        const float rstd = 1.0f / sqrtf(wave_sum(s) * (1.0f / D) + RMS_EPS);
#pragma unroll
        for (int j = 0; j < 4; ++j) { const f32x4 a = v[j][0] * rstd * g[j][0], b = v[j][1] * rstd * g[j][1];
            u32x2 w; w.x = pk4_i8(a.x, a.y, a.z, a.w); w.y = pk4_i8(b.x, b.y, b.z, b.w); *(u32x2*)(orow + 8 * (lane + 64 * j)) = w; }
    }
}


__device__ __forceinline__ void meta_rstd(const float* src, LAS float* rs, int wave, int lane) {
#pragma unroll
    for (int rr = 0; rr < 2; ++rr) { const int row = 2 * wave + rr; float s = 0.f;
#pragma unroll
        for (int j = 0; j < 8; ++j) { const f32x4 v = *(const f32x4*)(src + (size_t)row * D + 4 * (lane + 64 * j)); s += (v.x * v.x + v.y * v.y) + (v.z * v.z + v.w * v.w); }
        s = wave_sum(s); if (lane == 0) rs[row] = 1.0f / sqrtf(s * (1.0f / D) + RMS_EPS); }
    __syncthreads();
}

struct FNorm { const float* src; const float* gain; const LAS float* rstd; int K;
    __device__ __forceinline__ void operator()(int row, int k, float (&a)[8]) const { const f32x4* p = (const f32x4*)(src + (size_t)row * K + k); const float r = rstd[row]; f32x4 x = p[0] * r, y = p[1] * r;
        if (gain) { const f32x4* gp = (const f32x4*)(gain + k); x = x * gp[0]; y = y * gp[1]; } a[0] = x.x; a[1] = x.y; a[2] = x.z; a[3] = x.w; a[4] = y.x; a[5] = y.y; a[6] = y.z; a[7] = y.w; } };
struct FCvt { const float* src; int K;
    __device__ __forceinline__ void operator()(int row, int k, float (&a)[8]) const { const f32x4* p = (const f32x4*)(src + (size_t)row * K + k); const f32x4 x = p[0], y = p[1];
        a[0] = x.x; a[1] = x.y; a[2] = x.z; a[3] = x.w; a[4] = y.x; a[5] = y.y; a[6] = y.z; a[7] = y.w; } };
template <int WF, int C, class AL, class CM, class EP>
__device__ __forceinline__ void meta_gemm_mc(const void* Btv, int K, int ngroups, float wsc, const AL& A, const CM& colmap, const EP& E, int gw, int NGW, int lane) {
    for (int g = gw; g < ngroups; g += NGW) {
#pragma unroll 1
        for (int rb = 0; rb < 16; rb += 4) {
            float acc[4][C];
#pragma unroll
            for (int r = 0; r < 4; ++r)
#pragma unroll
                for (int c = 0; c < C; ++c) acc[r][c] = 0.f;
#pragma unroll 1
            for (int k = lane * 8; k < K; k += 512) {
                float a[4][8];
#pragma unroll
                for (int r = 0; r < 4; ++r) A(rb + r, k, a[r]);
#pragma unroll
                for (int c = 0; c < C; ++c) { const int n = colmap(g, c); float wf[8];
                    if constexpr (WF == 0) { const u32x4 w = *(const u32x4*)((const bf16_t*)Btv + (size_t)n * K + k);
                        wf[0] = bflo(w.x); wf[1] = bfhi(w.x); wf[2] = bflo(w.y); wf[3] = bfhi(w.y); wf[4] = bflo(w.z); wf[5] = bfhi(w.z); wf[6] = bflo(w.w); wf[7] = bfhi(w.w); }
                    else { const u32x2 w = *(const u32x2*)((const unsigned char*)Btv + (size_t)n * K + k);
                        if constexpr (WF == 1) {
#pragma unroll
                            for (int e = 0; e < 4; ++e) { wf[e] = (float)((int)(w.x << (24 - 8 * e)) >> 24); wf[4 + e] = (float)((int)(w.y << (24 - 8 * e)) >> 24); } }
                        else { wf[0] = __builtin_amdgcn_cvt_f32_fp8((int)w.x, 0); wf[1] = __builtin_amdgcn_cvt_f32_fp8((int)w.x, 1); wf[2] = __builtin_amdgcn_cvt_f32_fp8((int)w.x, 2); wf[3] = __builtin_amdgcn_cvt_f32_fp8((int)w.x, 3);
                               wf[4] = __builtin_amdgcn_cvt_f32_fp8((int)w.y, 0); wf[5] = __builtin_amdgcn_cvt_f32_fp8((int)w.y, 1); wf[6] = __builtin_amdgcn_cvt_f32_fp8((int)w.y, 2); wf[7] = __builtin_amdgcn_cvt_f32_fp8((int)w.y, 3); } }
#pragma unroll
                    for (int r = 0; r < 4; ++r)
#pragma unroll
                        for (int e = 0; e < 8; ++e) acc[r][c] += a[r][e] * wf[e]; }
            }
#pragma unroll
            for (int r = 0; r < 4; ++r)
#pragma unroll
                for (int c = 0; c < C; ++c) acc[r][c] = wave_sum(acc[r][c]) * wsc;
            E(rb, g, acc, lane);
        }
    }
}
template <int C> struct CMCons { __device__ __forceinline__ int operator()(int g, int c) const { return g * C + c; } };
struct CMGateUp { __device__ __forceinline__ int operator()(int g, int c) const { const int ch = 4 * g + (c & 3); return (ch >> 7) * 256 + (ch & 127) + (c >> 2) * 128; } };
template <int C> struct EStoreC { float* out; int ldc;
    __device__ __forceinline__ void operator()(int rb, int g, const float (&v)[4][C], int lane) const {
#pragma unroll
        for (int r = 0; r < 4; ++r)
#pragma unroll
            for (int c = 0; c < C; ++c) if (lane == r * C + c) out[(size_t)(rb + r) * ldc + g * C + c] = v[r][c]; } };
template <int C> struct EResidC { const float* base; float* out; int ldc;
    __device__ __forceinline__ void operator()(int rb, int g, const float (&v)[4][C], int lane) const {
#pragma unroll
        for (int r = 0; r < 4; ++r)
#pragma unroll
            for (int c = 0; c < C; ++c) if (lane == r * C + c) { const size_t o = (size_t)(rb + r) * ldc + g * C + c; out[o] = base[o] + v[r][c]; } } };
struct ESiluAct { float* act;
    __device__ __forceinline__ void operator()(int rb, int g, const float (&v)[4][8], int lane) const {
#pragma unroll
        for (int r = 0; r < 4; ++r)
#pragma unroll
            for (int c = 0; c < 4; ++c) if (lane == r * 4 + c) act[(size_t)(rb + r) * FF + 4 * g + c] = pg8::silu_mul(v[r][c], v[r][c + 4]); } };

namespace att {
constexpr int NSLOT = 3, SLOT = 32768, OFF_KM = 98304, OFF_VM = OFF_KM + 4096, OFF_QM = OFF_VM + 4096, OFF_BIAS = OFF_QM + 4096, OFF_MB = OFF_BIAS + 4096, OFF_SC = OFF_MB + 256;
constexpr int BIAS_SLACK = 256;
__device__ __forceinline__ int swzK(int key) { return ((key >> 3) & 3) * 4 + (key & 3); }
__device__ __forceinline__ int gswV(int row) { return ((row & 3) << 2) | ((row >> 2) & 3); }
__device__ __forceinline__ int r0_of(int r) { const int a = r - 4; return a < 0 ? 0 : (a > GR - 8 ? GR - 8 : a); }
__device__ __forceinline__ bf16x4 tr_read(unsigned addr) { bf16x4 r; asm volatile("ds_read_b64_tr_b16 %0, %1" : "=v"(r) : "v"(addr)); return r; }

__device__ __forceinline__ void meta_step(LAS unsigned char* lds, const bf16x8 (&qf)[4], float Mq, f32x4 (&O)[8], float& lsum, int fr, int fq, int lane) {
    f32x4 s = (f32x4){0.f, 0.f, 0.f, 0.f};
#pragma unroll
    for (int ks = 0; ks < 4; ++ks) { const bf16x8 kf = *(const LAS bf16x8*)(lds + OFF_KM + fr * 256 + (((4 * ks + fq) ^ fr) << 4)); s = __builtin_amdgcn_mfma_f32_16x16x32_bf16(kf, qf[ks], s, 0, 0, 0); }
    const LAS float* mb = (const LAS float*)(lds + OFF_MB);
    float p[4];
#pragma unroll
    for (int i = 0; i < 4; ++i) { p[i] = __builtin_amdgcn_exp2f(s[i] + mb[4 * fq + i] - Mq); lsum += p[i]; }
    u32x4 pw; pw.x = cvt_pk_bf16(p[0], p[1]); pw.y = cvt_pk_bf16(p[2], p[3]); pw.z = 0u; pw.w = 0u;
    const bf16x8 pf = __builtin_bit_cast(bf16x8, pw);
    const int g = lane >> 4, q = (lane & 15) >> 2, pp = lane & 3, row = 4 * g + q;
    const unsigned vbase = (unsigned)(size_t)(lds + OFF_VM) + 256u * row + 8u * (pp & 1);
    bf16x4 v[8];
#pragma unroll
    for (int dt = 0; dt < 8; ++dt) v[dt] = tr_read(vbase + 16u * ((unsigned)(2 * dt + (pp >> 1)) ^ (unsigned)gswV(row)));
    asm volatile("s_waitcnt lgkmcnt(0)" : "+v"(v[0]), "+v"(v[1]), "+v"(v[2]), "+v"(v[3]), "+v"(v[4]), "+v"(v[5]), "+v"(v[6]), "+v"(v[7]) :: "memory");
#pragma unroll
    for (int dt = 0; dt < 8; ++dt) { bf16x8 vf; vf[0] = v[dt][0]; vf[1] = v[dt][1]; vf[2] = v[dt][2]; vf[3] = v[dt][3]; vf[4] = v[dt][0]; vf[5] = v[dt][1]; vf[6] = v[dt][2]; vf[7] = v[dt][3];
        O[dt] = __builtin_amdgcn_mfma_f32_16x16x32_bf16(vf, pf, O[dt], 0, 0, 0); }
}

__device__ __forceinline__ void attn_phase(LAS unsigned char* lds, const bf16_t* qkv, const float* qkv_m, const float* q_gain, const float* k_gain, const float* rel_bias,
                                           const float* meta_bias, bf16_t* o, float* o_m, int G, int bid) {
    const int tid = threadIdx.x, wid = __builtin_amdgcn_readfirstlane(tid >> 6), lane = tid & 63, fr = lane & 15, fq = lane >> 4;
    const int UPW = (NB * NH * (GR / 2)) / G;
    const int u0 = bid * UPW, bh = u0 / (GR / 2), b = bh / NH, h = bh % NH;
    const float QSCALE = 0.08838834764831845f * LOG2E;
    if (tid < 256) { const int m = tid >> 4, ch = tid & 15;
        { const f32x4* p = (const f32x4*)(qkv_m + (size_t)m * NQKV + D + h * HD + ch * 8); const f32x4 a = p[0], c = p[1];
          float ss = (a.x * a.x + a.y * a.y) + (a.z * a.z + a.w * a.w) + (c.x * c.x + c.y * c.y) + (c.z * c.z + c.w * c.w);
          ss += __shfl_xor(ss, 1); ss += __shfl_xor(ss, 2); ss += __shfl_xor(ss, 4); ss += __shfl_xor(ss, 8);
          const float r = 1.0f / sqrtf(ss * (1.0f / HD) + RMS_EPS); const f32x4* gp = (const f32x4*)(k_gain + ch * 8); const f32x4 x = a * gp[0] * r, y = c * gp[1] * r;
          u32x4 w; w.x = cvt_pk_bf16(x.x, x.y); w.y = cvt_pk_bf16(x.z, x.w); w.z = cvt_pk_bf16(y.x, y.y); w.w = cvt_pk_bf16(y.z, y.w);
          *(LAS u32x4*)(lds + OFF_KM + m * 256 + ((ch ^ m) << 4)) = w; }
        { const f32x4* p = (const f32x4*)(qkv_m + (size_t)m * NQKV + 2 * D + h * HD + ch * 8); const f32x4 a = p[0], c = p[1];
          u32x4 w; w.x = cvt_pk_bf16(a.x, a.y); w.y = cvt_pk_bf16(a.z, a.w); w.z = cvt_pk_bf16(c.x, c.y); w.w = cvt_pk_bf16(c.z, c.w);
          *(LAS u32x4*)(lds + OFF_VM + m * 256 + ((ch ^ gswV(m)) << 4)) = w; }
        { const f32x4* p = (const f32x4*)(qkv_m + (size_t)m * NQKV + h * HD + ch * 8); const f32x4 a = p[0], c = p[1];
          float ss = (a.x * a.x + a.y * a.y) + (a.z * a.z + a.w * a.w) + (c.x * c.x + c.y * c.y) + (c.z * c.z + c.w * c.w);
          ss += __shfl_xor(ss, 1); ss += __shfl_xor(ss, 2); ss += __shfl_xor(ss, 4); ss += __shfl_xor(ss, 8);
          const float r = QSCALE / sqrtf(ss * (1.0f / HD) + RMS_EPS); const f32x4* gp = (const f32x4*)(q_gain + ch * 8); const f32x4 x = a * gp[0] * r, y = c * gp[1] * r;
          u32x4 w; w.x = cvt_pk_bf16(x.x, x.y); w.y = cvt_pk_bf16(x.z, x.w); w.z = cvt_pk_bf16(y.x, y.y); w.w = cvt_pk_bf16(y.z, y.w);
          *(LAS u32x4*)(lds + OFF_QM + m * 256 + (ch << 4)) = w; }
    }
    { LAS float* bt = (LAS float*)(lds + OFF_BIAS); for (int i = tid; i < 1024; i += NTHREADS) { const int j = i - BIAS_SLACK; bt[i] = (j >= 0 && j < 15 * 31) ? rel_bias[h * 465 + j] * LOG2E : 0.f; }
      if (tid < 16) ((LAS float*)(lds + OFF_MB))[tid] = meta_bias[h * 16 + tid] * LOG2E; }
    __syncthreads();
    float maxbias, KB;
    { const LAS float* bt = (const LAS float*)(lds + OFF_BIAS) + BIAS_SLACK; float mx = -1e30f;
      for (int i = lane; i < 465; i += 64) mx = fmaxf(mx, bt[i]);
      if (lane < 16) mx = fmaxf(mx, ((const LAS float*)(lds + OFF_MB))[lane]);
      maxbias = wave_max(mx);
      KB = wave_max(fmaxf(fabsf(k_gain[lane]), fabsf(k_gain[lane + 64]))) * 11.313708498984761f * 1.01f; }
    const int j = wid & 3, cq = 16 * j + fr, kc0 = (16 * j - 8) < 0 ? 0 : ((16 * j - 8) > 32 ? 32 : (16 * j - 8));
    const int c0 = (cq - 8) < 0 ? 0 : ((cq - 8) > GW - 16 ? GW - 16 : (cq - 8)), dlo = c0 - cq;
    const int cb = kc0 + 8 * fq - cq + 15;
    unsigned vmask = 0u;
#pragma unroll
    for (int t = 0; t < 2; ++t)
#pragma unroll
        for (int i = 0; i < 4; ++i) { const int dc = kc0 + 8 * fq + 4 * t + i - cq; if (dc >= dlo && dc <= dlo + 15) vmask |= 1u << (4 * t + i); }
    unsigned koff[2];
#pragma unroll
    for (int t = 0; t < 2; ++t) { const int key = kc0 + 8 * (fr >> 2) + (fr & 3) + 4 * t; koff[t] = (unsigned)(key * 256) | ((unsigned)swzK(key) << 16); }
    const int tg = lane >> 4, tq = (lane & 15) >> 2, tp = lane & 3;
    unsigned vrow[2], vsw[2];
#pragma unroll
    for (int t = 0; t < 2; ++t) { const int row = kc0 + 8 * tg + 4 * t + tq; vrow[t] = (unsigned)(row * 256 + 8 * (tp & 1)); vsw[t] = (unsigned)gswV(row); }
    unsigned dK[2], dV[2];
#pragma unroll
    for (int ii = 0; ii < 2; ++ii) { const int p = tid + 512 * ii, key = p >> 4, sc = p & 15; dK[ii] = (unsigned)(key * (NQKV * 2) + ((sc ^ swzK(key)) << 4)); dV[ii] = (unsigned)(key * (NQKV * 2) + ((sc ^ gswV(key)) << 4)); }
    const char* kbase = (const char*)qkv + ((size_t)b * SEQ * NQKV + D + h * HD) * 2;
    const unsigned ldsw = (unsigned)wid * 1024u;
#define ATT_ISSUE(krow, slot) do { const char* _s = kbase + (size_t)(krow) * (GW * NQKV * 2); _Pragma("unroll") for (int _i = 0; _i < 2; ++_i) { \
        __builtin_amdgcn_global_load_lds((const unsigned*)(_s + dK[_i]), (LAS unsigned*)(lds + (slot) * SLOT + ldsw + _i * 8192), 16, 0, 0); \
        __builtin_amdgcn_global_load_lds((const unsigned*)(_s + D * 2 + dV[_i]), (LAS unsigned*)(lds + (slot) * SLOT + 16384 + ldsw + _i * 8192), 16, 0, 0); } } while (0)

    if (b == 0 && (bid % (G / (NB * NH))) == 0 && wid == 0) {
        bf16x8 qf[4]; float ssq = 0.f;
#pragma unroll
        for (int ks = 0; ks < 4; ++ks) { qf[ks] = *(const LAS bf16x8*)(lds + OFF_QM + fr * 256 + ((4 * ks + fq) << 4));
#pragma unroll
            for (int e = 0; e < 8; ++e) { const float f = bf2f((unsigned short)qf[ks][e]); ssq += f * f; } }
        ssq += __shfl_xor(ssq, 16); ssq += __shfl_xor(ssq, 32);
        const float Mq = sqrtf(ssq) * KB + maxbias;
        f32x4 O[8]; float lsum = 0.f;
#pragma unroll
        for (int dt = 0; dt < 8; ++dt) O[dt] = (f32x4){0.f, 0.f, 0.f, 0.f};
        meta_step(lds, qf, Mq, O, lsum, fr, fq, lane);
        lsum += __shfl_xor(lsum, 16); lsum += __shfl_xor(lsum, 32);
        const float inv = 1.0f / lsum;
#pragma unroll
        for (int dt = 0; dt < 8; ++dt) *(f32x4*)(o_m + (size_t)fr * D + h * HD + 16 * dt + 4 * fq) = O[dt] * inv;
    }

    int iu = 0, irp = (u0 % (GR / 2)), ilo = r0_of(2 * irp), ihi = r0_of(2 * irp + 1) + 7, ii_ = ilo, gI = 0;
#define ATT_ADV() do { if (++ii_ > ihi) { ++iu; ++irp; if (iu < UPW) { ilo = r0_of(2 * irp); ihi = r0_of(2 * irp + 1) + 7; ii_ = ilo; } } } while (0)
    for (int d = 0; d < 2; ++d) if (iu < UPW) { ATT_ISSUE(ii_, gI % NSLOT); ATT_ADV(); ++gI; }
    int gC = 0;
    for (int ku = 0; ku < UPW; ++ku) {
        const int rp = (u0 % (GR / 2)) + ku, qr = 2 * rp + (wid >> 2), r0w = r0_of(qr), lo = r0_of(2 * rp), hi = r0_of(2 * rp + 1) + 7;
        const size_t qrow = (size_t)b * SEQ + (size_t)qr * GW + cq;
        bf16x8 qf[4]; float ssq = 0.f;
#pragma unroll
        for (int ks = 0; ks < 4; ++ks) { qf[ks] = *(const bf16x8*)(qkv + qrow * NQKV + h * HD + 32 * ks + 8 * fq);
#pragma unroll
            for (int e = 0; e < 8; ++e) { const float f = bf2f((unsigned short)qf[ks][e]); ssq += f * f; } }
        ssq += __shfl_xor(ssq, 16); ssq += __shfl_xor(ssq, 32);
        const float Mq = sqrtf(ssq) * KB + maxbias;
        f32x4 O[8]; float lsum = 0.f;
#pragma unroll
        for (int dt = 0; dt < 8; ++dt) O[dt] = (f32x4){0.f, 0.f, 0.f, 0.f};
        for (int i = lo; i <= hi; ++i) {
            if (gI > gC + 1) asm volatile("s_waitcnt vmcnt(4)" ::: "memory"); else asm volatile("s_waitcnt vmcnt(0)" ::: "memory");
            __builtin_amdgcn_s_barrier();
            if (iu < UPW) { ATT_ISSUE(ii_, gI % NSLOT); ATT_ADV(); ++gI; }
            if (i >= r0w && i <= r0w + 7) {
                const int slot = gC % NSLOT; const int dr = i - qr;
                LAS unsigned char* sk = lds + slot * SLOT;
                f32x4 s[2];
#pragma unroll
                for (int t = 0; t < 2; ++t) { s[t] = (f32x4){0.f, 0.f, 0.f, 0.f};
#pragma unroll
                    for (int ks = 0; ks < 4; ++ks) { const bf16x8 kf = *(const LAS bf16x8*)(sk + (koff[t] & 0xffffu) + ((((unsigned)(4 * ks + fq)) ^ (koff[t] >> 16)) << 4));
                        s[t] = __builtin_amdgcn_mfma_f32_16x16x32_bf16(kf, qf[ks], s[t], 0, 0, 0); } }
                const LAS float* bt = (const LAS float*)(lds + OFF_BIAS) + BIAS_SLACK + (dr + 7) * 31 + cb;
                float p[8];
#pragma unroll
                for (int t = 0; t < 2; ++t)
#pragma unroll
                    for (int e = 0; e < 4; ++e) { const float v = __builtin_amdgcn_exp2f(s[t][e] + bt[4 * t + e] - Mq); p[4 * t + e] = ((vmask >> (4 * t + e)) & 1u) ? v : 0.f; lsum += p[4 * t + e]; }
                u32x4 pw; pw.x = cvt_pk_bf16(p[0], p[1]); pw.y = cvt_pk_bf16(p[2], p[3]); pw.z = cvt_pk_bf16(p[4], p[5]); pw.w = cvt_pk_bf16(p[6], p[7]);
                const bf16x8 pf = __builtin_bit_cast(bf16x8, pw);
                const unsigned vb = (unsigned)(size_t)(sk + 16384);
#pragma unroll
                for (int hb = 0; hb < 2; ++hb) {
                    bf16x4 v0[4], v1[4];
#pragma unroll
                    for (int d4 = 0; d4 < 4; ++d4) { const int dt = 4 * hb + d4;
                        v0[d4] = tr_read(vb + vrow[0] + 16u * (((unsigned)(2 * dt + (tp >> 1))) ^ vsw[0]));
                        v1[d4] = tr_read(vb + vrow[1] + 16u * (((unsigned)(2 * dt + (tp >> 1))) ^ vsw[1])); }
                    asm volatile("s_waitcnt lgkmcnt(0)" : "+v"(v0[0]), "+v"(v0[1]), "+v"(v0[2]), "+v"(v0[3]), "+v"(v1[0]), "+v"(v1[1]), "+v"(v1[2]), "+v"(v1[3]) :: "memory");
#pragma unroll
                    for (int d4 = 0; d4 < 4; ++d4) { bf16x8 vf; vf[0] = v0[d4][0]; vf[1] = v0[d4][1]; vf[2] = v0[d4][2]; vf[3] = v0[d4][3]; vf[4] = v1[d4][0]; vf[5] = v1[d4][1]; vf[6] = v1[d4][2]; vf[7] = v1[d4][3];
                        O[4 * hb + d4] = __builtin_amdgcn_mfma_f32_16x16x32_bf16(vf, pf, O[4 * hb + d4], 0, 0, 0); }
                }
            }
            ++gC;
        }
        meta_step(lds, qf, Mq, O, lsum, fr, fq, lane);
        lsum += __shfl_xor(lsum, 16); lsum += __shfl_xor(lsum, 32);
        const float inv = 1.0f / lsum;
#pragma unroll
        for (int dt = 0; dt < 8; ++dt) { const f32x4 v = O[dt] * (inv * SC_O8);
            *(unsigned*)((unsigned char*)o + qrow * D + h * HD + 16 * dt + 4 * fq) = pk4_i8(v[0], v[1], v[2], v[3]); }
    }
    VM_WAIT();
    __syncthreads();
#undef ATT_ISSUE
#undef ATT_ADV
}
}


constexpr int NPHASES = 17;
struct Args { const float* in[22]; float* out; unsigned char* ws; int ph_lo, ph_hi; };
static_assert(sizeof(Args) == 22 * 8 + 8 + 8 + 8, "Args has no padding");
enum { I_X = 0, I_META, I_ATTN_NORM, I_WQKV, I_QGAIN, I_KGAIN, I_RELBIAS, I_METABIAS, I_WO, I_CONV_NORM, I_WIN, I_CONVW, I_WOUT, I_DENSE_NORM, I_WGATE, I_WUP, I_WDOWN,
       I_MOE_NORM, I_WROUTER, I_MGATE, I_MUP, I_MDOWN };

__global__ void __launch_bounds__(NTHREADS, 2) enc_fwd(Args args) {
    extern __shared__ __attribute__((aligned(16))) unsigned char lds_raw[];
    LAS unsigned char* lds = (LAS unsigned char*)lds_raw;
    const int tid = threadIdx.x, lane = tid & 63, wave = __builtin_amdgcn_readfirstlane(tid >> 6);
    const int G = gridDim.x, bid = blockIdx.x;
    const int gw = bid * NWAVES + wave, NGW = G * NWAVES;
    unsigned char* ws = args.ws;
    unsigned* ctl = (unsigned*)(ws + WS_CTL);
    float* out = args.out;
    bf16_t* XA = (bf16_t*)(ws + WS_XA); bf16_t* BIG = (bf16_t*)(ws + WS_BIG); bf16_t* Y1 = (bf16_t*)(ws + WS_Y1);
    unsigned char* XQ = ws + WS_XQ; unsigned char* ACT8 = ws + WS_BIG;
    float* rs1 = (float*)(ws + WS_RS1); float* rs2 = (float*)(ws + WS_RS2); unsigned char* HB1 = ws + WS_XBUF;
    bf16_t* H1B = (bf16_t*)(ws + WS_H1B); bf16_t* H2B = (bf16_t*)(ws + WS_H2B); bf16_t* H3B = H1B; bf16_t* Y0 = H2B;
    float* qkv_m = (float*)(ws + MT_QKV); float* o_m = (float*)(ws + MT_O); float* h1_m = (float*)(ws + MT_H1); float* act_m = (float*)(ws + MT_GU); float* h2_m = (float*)(ws + MT_H2); float* cgu_m = (float*)(ws + MT_CGU);
    int* tok_e = (int*)(ws + MO_TOKE); float* tok_g = (float*)(ws + MO_TOKG); int* cnt = (int*)(ws + MO_CNT); int* rowinfo = (int*)(ws + MO_ROWINFO); float* rowgate = (float*)(ws + MO_ROWGATE); int* tile_e = (int*)(ws + MO_TILEE);

    if (tid < 2) ((LAS unsigned*)(lds + XBW_OFF))[tid] = 0u;
    __syncthreads();
#if MK_N_LAUNCHES == 1
    XcdBarrier bar = xcd_barrier_post(ctl + CW_BAR, (volatile LAS unsigned*)(lds + XBW_OFF));
#define GRID_BAR() xcd_barrier(bar)
#else
#define GRID_BAR() do { } while (0)
#endif
    const int lo = args.ph_lo, hi = args.ph_hi;
#define IN(k) (lo <= (k) && (k) < hi)
#define SEAM(k) do { if (IN((k) + 1)) GRID_BAR(); } while (0)


    if (IN(0)) {
        LAS float* scr = (LAS float*)(lds + wave * 16896);
        constexpr int I_A = (D / 64) * (NQKV / 64), I_B = (D / 64) * (D / 64), I_F = (D / 64) * (FF / 64), I_Dn = (FF / 64) * (D / 64);
        static_assert(I_F == I_Dn, "items");
        constexpr int NITEMS = 2 * I_A + 2 * I_B + 3 * I_F + 3 * NE * I_F;
        for (int it = gw; it < NITEMS; it += NGW) {
            int r = it;
            if (r < I_A) { p0_matrix_i8(args.in[I_WQKV], D, NQKV, ws + W_QKV8, -1, SC_W8, r, scr, lane, nullptr); continue; } r -= I_A;
            if (r < I_B) { p0_matrix_i8(args.in[I_WO], D, D, ws + W_O8, -1, SC_W8, r, scr, lane, nullptr); continue; } r -= I_B;
            if (r < I_F) { p0_matrix_i8(args.in[I_WGATE], D, FF, ws + W_GU8, 0, SC_W8, r, scr, lane, args.in[I_DENSE_NORM]); continue; } r -= I_F;
            if (r < I_F) { p0_matrix_i8(args.in[I_WUP], D, FF, ws + W_GU8, 1, SC_W8, r, scr, lane, args.in[I_DENSE_NORM]); continue; } r -= I_F;
            if (r < I_F) { const int nblk = D / 64, kb = (r / (4 * nblk)) * 4 + (r & 3), nb = (r >> 2) % nblk;
                p0_item_dn<8>(args.in[I_WDOWN], FF, D, (bf16_t*)(ws + W_DN), ws + W_DN8, SC_WDR, 64 * kb, 64 * nb, scr, lane); continue; } r -= I_F;
            if (r < I_A) {
                const int nblk = NQKV / 64, kb = (r / (4 * nblk)) * 4 + (r & 3), nb = (r >> 2) % nblk, n0 = 64 * nb; int drow0;
                if (n0 < D) drow0 = n0; else { const int part = (n0 - D) / D, zc = (n0 - D) % D; drow0 = D + (zc / 128) * 256 + part * 128 + (zc % 128); }
                p0_transpose_item_i8(args.in[I_WIN], D, NQKV, ws + W_IN, 64 * kb, n0, drow0, SC_W8, scr, lane, args.in[I_CONV_NORM]); continue; } r -= I_A;
            if (r < I_B) { const int nblk = D / 64, kb = (r / (4 * nblk)) * 4 + (r & 3), nb = (r >> 2) % nblk;
                p0_item_dn<32>(args.in[I_WOUT], D, D, nullptr, ws + W_OUT, SC_W8, 64 * kb, 64 * nb, scr, lane); continue; } r -= I_B;
            { const int which = r / (NE * I_F), rr = r % (NE * I_F), e = rr / I_F, ri = rr % I_F;
              if (which == 0) p0_matrix_i8(args.in[I_MGATE] + (size_t)e * D * FF, D, FF, ws + W_MGU + (size_t)e * NGU * D, 0, SC_W8, ri, scr, lane, nullptr);
              else if (which == 1) p0_matrix_i8(args.in[I_MUP] + (size_t)e * D * FF, D, FF, ws + W_MGU + (size_t)e * NGU * D, 1, SC_W8, ri, scr, lane, nullptr);
              else p0_matrix8(args.in[I_MDOWN] + (size_t)e * FF * D, FF, D, ws + W_MDN + (size_t)e * D * FF, -1, SC_WDN, ri, scr, lane); }
        }
        rms_rows_to_i8(args.in[I_X], args.in[I_ATTN_NORM], (unsigned char*)XA, gw, NGW, M, lane);
        SEAM(0);
    }
    if (IN(1)) {
        { pg8::Gemm g{XA, ws + W_QKV8, D}; pg8::StaticOrder S; S.init(M, NQKV, G, bid); pg8::EpiQKV E{BIG, NQKV, 1.0f / (SC_A8 * SC_W8), args.in[I_QGAIN], args.in[I_KGAIN], (LAS float*)(lds + MISC_OFF)};
          pg8::gemm_phase<pg8::EpiQKV, pg8::StaticOrder, 8>(lds, g, S, E); }
        { LAS float* rs = (LAS float*)(lds + 8192); meta_rstd(args.in[I_META], rs, wave, lane);
          FNorm A{args.in[I_META], args.in[I_ATTN_NORM], rs, D}; EStoreC<3> E{qkv_m, NQKV};
          meta_gemm_mc<1, 3>(ws + W_QKV8, D, NQKV / 3, 1.0f / SC_W8, A, CMCons<3>{}, E, gw, NGW, lane); }
        SEAM(1);
    }
    if (IN(3)) {
        att::attn_phase(lds, BIG, qkv_m, args.in[I_QGAIN], args.in[I_KGAIN], args.in[I_RELBIAS], args.in[I_METABIAS], XA, o_m, G, bid);
        SEAM(3);
    }
    if (IN(4)) {
        { pg8::Gemm g{XA, ws + W_O8, D}; pg8::StaticOrder S; S.init(M, D, G, bid); pg8::EpiResidNormB<false> E{args.in[I_X], H1B, HB1, rs1, D, (LAS float*)(lds + MISC_OFF), 1.0f / (SC_O8 * SC_W8), SC_A8};
          pg8::gemm_phase<pg8::EpiResidNormB<false>, pg8::StaticOrder, 8>(lds, g, S, E); }
        { FCvt A{o_m, D}; EResidC<1> E{args.in[I_META], h1_m, D}; meta_gemm_mc<1, 1>(ws + W_O8, D, D, 1.0f / SC_W8, A, CMCons<1>{}, E, gw, NGW, lane); }
        SEAM(4);
    }
    if (IN(6)) {
        { pg8::Gemm g{HB1, ws + W_GU8, D}; pg8::StaticOrder S; S.init(M, NGU, G, bid); pg8::EpiSwiGLU E{(unsigned char*)BIG, FF, rs1, 1.0f / (SC_A8 * SC_W8), (LAS float*)(lds + MISC_OFF)};
          pg8::gemm_phase<pg8::EpiSwiGLU, pg8::StaticOrder, 8>(lds, g, S, E); }
        { LAS float* rs = (LAS float*)(lds + 8192); meta_rstd(h1_m, rs, wave, lane);
          FNorm A{h1_m, nullptr, rs, D}; ESiluAct E{act_m}; meta_gemm_mc<1, 8>(ws + W_GU8, D, FF / 4, 1.0f / SC_W8, A, CMGateUp{}, E, gw, NGW, lane); }
        SEAM(6);
    }
    if (IN(7)) {
        { pg8::Gemm g{BIG, ws + W_DN8, FF}; pg8::StaticOrder S; S.init(M, D, G, bid); pg8::EpiResidNormB<true> E{H1B, H2B, (unsigned char*)XA, rs2, D, (LAS float*)(lds + MISC_OFF), 1.0f / (SC_ACTR * SC_WDR), SC_A8B};
          pg8::gemm_phase<pg8::EpiResidNormB<true>, pg8::StaticOrder, 8>(lds, g, S, E); }
        if (wave < 4) { FCvt A{act_m, FF}; EResidC<2> E{h1_m, h2_m, D}; meta_gemm_mc<0, 2>(ws + W_DN, FF, D / 2, 1.0f, A, CMCons<2>{}, E, bid * 4 + wave, G * 4, lane); }
        SEAM(7);
    }
    if (IN(9)) {
        { pg8::Gemm g{XA, ws + W_IN, D}; pg8::StaticOrder S; S.init(M, NQKV, G, bid); pg8::EpiWin E{BIG, 2 * D, rs2, 1.0f / (SC_A8B * SC_W8), (LAS float*)(lds + MISC_OFF)};
          pg8::gemm_phase<pg8::EpiWin, pg8::StaticOrder, 8>(lds, g, S, E); }
        { LAS float* rs = (LAS float*)(lds + 8192); meta_rstd(h2_m, rs, wave, lane);
          FNorm A{h2_m, nullptr, rs, D}; EStoreC<2> E{cgu_m, 2 * D}; meta_gemm_mc<1, 2>(ws + W_IN + (size_t)D * D, D, D, 1.0f / SC_W8, A, CMCons<2>{}, E, gw, NGW, lane); }
        SEAM(9);
    }
    if (IN(10)) {
        const int cc = tid & 255, half = tid >> 8;
        const float* cw = args.in[I_CONVW] + (size_t)cc * 8 * 3;
        float w0[8], w1[8], w2[8];
#pragma unroll
        for (int e = 0; e < 8; ++e) { w0[e] = cw[3 * e]; w1[e] = cw[3 * e + 1]; w2[e] = cw[3 * e + 2]; }
        const int RPW = M / G;
        const int m0 = bid * RPW + half * (RPW / 2), m1 = m0 + RPW / 2;
#define ldz(m_, z_) ld8bf(BIG + (size_t)(m_) * (2 * D) + D + cc * 8, z_)
        float zp[8], zc[8], zn[8];
        if ((m0 % SEQ) == 0) { const float* gp = cgu_m + (size_t)15 * (2 * D) + (cc * 8 / 128) * 256 + (cc * 8 % 128);
#pragma unroll
            for (int e = 0; e < 8; ++e) zp[e] = gp[e] * gp[128 + e]; }
        else ldz(m0 - 1, zp);
        ldz(m0, zc);
        for (int m = m0; m < m1; m += 4) {
            u32x4 zw[4], bw[4];
#pragma unroll
            for (int i = 0; i < 4; ++i) { const int mm = m + 1 + i, mc = mm < M ? mm : M - 1; zw[i] = *(const u32x4*)(BIG + (size_t)mc * (2 * D) + D + cc * 8);
                if ((mm % SEQ) == 0) zw[i] = (u32x4){0u, 0u, 0u, 0u}; }
#pragma unroll
            for (int i = 0; i < 4; ++i) bw[i] = *(const u32x4*)(BIG + (size_t)(m + i) * (2 * D) + cc * 8);
#pragma unroll
            for (int i = 0; i < 4; ++i) {
                zn[0] = bflo(zw[i].x); zn[1] = bfhi(zw[i].x); zn[2] = bflo(zw[i].y); zn[3] = bfhi(zw[i].y); zn[4] = bflo(zw[i].z); zn[5] = bfhi(zw[i].z); zn[6] = bflo(zw[i].w); zn[7] = bfhi(zw[i].w);
                const float bg[8] = {bflo(bw[i].x), bfhi(bw[i].x), bflo(bw[i].y), bfhi(bw[i].y), bflo(bw[i].z), bfhi(bw[i].z), bflo(bw[i].w), bfhi(bw[i].w)};
                float y[8];
#pragma unroll
                for (int e = 0; e < 8; ++e) y[e] = bg[e] * (zp[e] * w0[e] + zc[e] * w1[e] + zn[e] * w2[e]);
                wht_inlane8(y);
#pragma unroll
                for (int e = 0; e < 8; ++e) { const float o = __shfl_xor(y[e], 1); y[e] = (cc & 1) ? o - y[e] : y[e] + o; }
#pragma unroll
                for (int e = 0; e < 8; ++e) { const float o = __shfl_xor(y[e], 2); y[e] = ((cc & 2) ? o - y[e] : y[e] + o) * (SC_YR * 0.17677669529663687f); }
                u32x2 o; o.x = pk4_i8(y[0], y[1], y[2], y[3]); o.y = pk4_i8(y[4], y[5], y[6], y[7]);
                *(u32x2*)((unsigned char*)XA + (size_t)(m + i) * D + cc * 8) = o;
#pragma unroll
                for (int e = 0; e < 8; ++e) { zp[e] = zc[e]; zc[e] = zn[e]; }
            }
        }
#undef ldz
        SEAM(10);
    }
    if (IN(11)) {
        { pg8::Gemm g{XA, ws + W_OUT, D}; pg8::StaticOrder S; S.init(M, D, G, bid); pg8::EpiResidB E{H2B, H3B, D, 1.0f / (SC_YR * SC_W8)};
          pg8::gemm_phase<pg8::EpiResidB, pg8::StaticOrder, 8>(lds, g, S, E); }
        SEAM(11);
    }
    if (IN(12)) {
        constexpr int RSTR = 4096 + 32;
        LAS unsigned char* wl = lds;
        LAS int* lcnt = (LAS int*)(lds + 2 * 8 * RSTR);
        for (int i = tid; i < D * NE; i += NTHREADS) { const int k = i >> 3, e = i & 7; const float w = args.in[I_WROUTER][i] * args.in[I_MOE_NORM][k];
            const unsigned hi = cvt_pk_bf16(w, 0.f) & 0xffffu; const float rem = w - bf2f((unsigned short)hi); const unsigned lo = cvt_pk_bf16(rem, 0.f) & 0xffffu;
            *(LAS unsigned short*)(wl + e * RSTR + 2 * k) = (unsigned short)hi; *(LAS unsigned short*)(wl + 8 * RSTR + e * RSTR + 2 * k) = (unsigned short)lo; }
        if (tid < 8) lcnt[tid] = 0;
        __syncthreads();
        const int RPW = M / G, RPV = RPW / NWAVES;
        static_assert(M / 256 / NWAVES == 16, "one 16-row MFMA block per wave");
        const int row0 = bid * RPW + wave * RPV, r = lane & 15, kq = lane >> 4;
        float rstd;
        { const bf16_t* yrow = H3B + (size_t)(row0 + r) * D + 8 * kq;
          const LAS unsigned char* xrow = wl + (r & 7) * RSTR + 16 * kq;
          f32x4 acc = (f32x4){0.f, 0.f, 0.f, 0.f}, gram = (f32x4){0.f, 0.f, 0.f, 0.f}; float ss = 0.f;
#pragma unroll 1
          for (int ib = 0; ib < D / 32; ib += 8) {
              u32x4 y[8];
#pragma unroll
              for (int j = 0; j < 8; ++j) y[j] = *(const u32x4*)(yrow + 32 * (ib + j));
#pragma unroll
              for (int j = 0; j < 8; ++j) { const bf16x8 yf = __builtin_bit_cast(bf16x8, y[j]);
                  const bf16x8 xh = *(const LAS bf16x8*)(xrow + 64 * (ib + j)), xl = *(const LAS bf16x8*)(xrow + 8 * RSTR + 64 * (ib + j));
                  acc = __builtin_amdgcn_mfma_f32_16x16x32_bf16(xh, yf, acc, 0, 0, 0); acc = __builtin_amdgcn_mfma_f32_16x16x32_bf16(xl, yf, acc, 0, 0, 0);
                  gram = __builtin_amdgcn_mfma_f32_16x16x32_bf16(yf, yf, gram, 0, 0, 0); }
          }
          { const float dsel = (r & 3) == 0 ? gram[0] : (r & 3) == 1 ? gram[1] : (r & 3) == 2 ? gram[2] : gram[3]; ss = __shfl(dsel, (r >> 2) * 16 + r); }
          rstd = 1.0f / sqrtf(ss * (1.0f / D) + RMS_EPS);
          float lg[8];
#pragma unroll
          for (int i = 0; i < 4; ++i) { lg[i] = acc[i] * rstd; lg[4 + i] = __shfl_xor(acc[i], 16) * rstd; }
          int e0 = 0; float l0 = lg[0];
#pragma unroll
          for (int e = 1; e < 8; ++e) if (lg[e] > l0) { l0 = lg[e]; e0 = e; }
          int e1 = -1; float l1 = -3.0e38f;
#pragma unroll
          for (int e = 0; e < 8; ++e) if (e != e0 && lg[e] > l1) { l1 = lg[e]; e1 = e; }
          const float g0 = 1.0f / (1.0f + __expf(l1 - l0)), g1 = 1.0f - g0; const int mm = row0 + r;
          if (kq == 0) { tok_e[2 * mm] = e0; tok_e[2 * mm + 1] = e1; tok_g[2 * mm] = g0; tok_g[2 * mm + 1] = g1; lds_add(&lcnt[e0], 1); lds_add(&lcnt[e1], 1); } }
        { const float* gain = args.in[I_MOE_NORM]; f32x4 gg[4][2];
#pragma unroll
          for (int j = 0; j < 4; ++j) { const f32x4* gp = (const f32x4*)(gain + 8 * (lane + 64 * j)); gg[j][0] = gp[0] * SC_A8; gg[j][1] = gp[1] * SC_A8; }
          u32x4 vn[4];
#pragma unroll
          for (int j = 0; j < 4; ++j) vn[j] = *(const u32x4*)(H3B + (size_t)row0 * D + 8 * (lane + 64 * j));
          for (int rr = 0; rr < RPV; ++rr) { const int m = row0 + rr; const float rs = __shfl(rstd, rr);
              u32x4 vc[4];
#pragma unroll
              for (int j = 0; j < 4; ++j) vc[j] = vn[j];
              if (rr + 1 < RPV) {
#pragma unroll
                  for (int j = 0; j < 4; ++j) vn[j] = *(const u32x4*)(H3B + (size_t)(m + 1) * D + 8 * (lane + 64 * j)); }
#pragma unroll
              for (int j = 0; j < 4; ++j) { const f32x4 a = (f32x4){bflo(vc[j].x), bfhi(vc[j].x), bflo(vc[j].y), bfhi(vc[j].y)} * rs * gg[j][0], b = (f32x4){bflo(vc[j].z), bfhi(vc[j].z), bflo(vc[j].w), bfhi(vc[j].w)} * rs * gg[j][1];
                  u32x2 w; w.x = pk4_i8(a.x, a.y, a.z, a.w); w.y = pk4_i8(b.x, b.y, b.z, b.w);
                  *(u32x2*)(XQ + (size_t)m * D + 8 * (lane + 64 * j)) = w; } } }
        __syncthreads();
        if (tid < 8) cnt[bid * 8 + tid] = lcnt[tid];
        SEAM(12);
    }
    if (IN(13)) {
        LAS int* tot = (LAS int*)lds; LAS int* pre = tot + 8; LAS int* start = tot + 16; LAS int* wcnt = tot + 32;
        if (tid < 16) tot[tid] = 0;
        __syncthreads();
        if (tid < 256) { const i32x4 a = *(const i32x4*)(cnt + tid * 8), c = *(const i32x4*)(cnt + tid * 8 + 4);
            const int v[8] = {a.x, a.y, a.z, a.w, c.x, c.y, c.z, c.w};
#pragma unroll
            for (int e = 0; e < 8; ++e) { lds_add(&tot[e], v[e]); if (tid < bid) lds_add(&pre[e], v[e]); } }
        __syncthreads();
        if (tid == 0) { int s = 0; for (int e = 0; e < 8; ++e) { start[e] = s; s += (tot[e] + 255) / 256 * 256; } start[8] = s; }
        __syncthreads();
        const int RPW = M / G;
        int my_e = 0, my_tok = 0, my_k = 0; float my_g = 0.f;
        if (tid < 2 * RPW) { my_tok = bid * RPW + (tid >> 1); my_k = tid & 1; my_e = tok_e[2 * my_tok + my_k]; my_g = tok_g[2 * my_tok + my_k]; }
        int rank_in_wave = 0;
        if (tid < 2 * RPW) {
#pragma unroll
            for (int e = 0; e < 8; ++e) { const unsigned long long mk = __ballot(my_e == e); if (my_e == e) rank_in_wave = __popcll(mk & ((1ull << lane) - 1ull)); if (lane == 0) wcnt[wave * 8 + e] = __popcll(mk); }
        }
        __syncthreads();
        if (tid < 2 * RPW) { int r = start[my_e] + pre[my_e] + rank_in_wave; for (int w = 0; w < wave; ++w) r += wcnt[w * 8 + my_e];
            rowinfo[r] = my_tok | (my_k << 16); rowgate[r] = my_g; }
        if (bid == 0) {
            for (int e = 0; e < 8; ++e) { const int a = start[e] + tot[e], z = start[e + 1]; for (int r = a + tid; r < z; r += NTHREADS) { rowinfo[r] = -1; rowgate[r] = 0.f; } }
            const int nt = start[8] / 256;
            for (int t = tid; t < nt; t += NTHREADS) { int e = 0; while (e < 7 && t * 256 >= start[e + 1]) ++e; tile_e[t] = e; }
            if (tid == 0) ctl[CW_NTILES] = (unsigned)nt;
        }
        __syncthreads();
        SEAM(13);
    }
    if (IN(14)) {
        const int ntl = (int)__builtin_amdgcn_readfirstlane(ld_agent(ctl + CW_NTILES));
        LAS int* te = (LAS int*)(lds + MISC_OFF + 16384);
        for (int i = tid; i < ntl; i += NTHREADS) te[i] = tile_e[i];
        __syncthreads();
        if (ntl > 0) { pg8::Gemm g{XQ, ws + W_MGU, D}; pg8::MoeGatherOrder S{ntl, NGU / 256, G, bid, 0, te, false, rowinfo, lds + MISC_OFF, 1 << 30}; pg8::EpiSwiGLU8 E{ACT8, FF};
            pg8::gemm_phase<pg8::EpiSwiGLU8, pg8::MoeGatherOrder, 8>(lds, g, S, E); }
        SEAM(14);
    }
    if (IN(15)) {
        const int ntl = (int)__builtin_amdgcn_readfirstlane(ld_agent(ctl + CW_NTILES));
        LAS int* te = (LAS int*)(lds + MISC_OFF + 16384);
        for (int i = tid; i < ntl; i += NTHREADS) te[i] = tile_e[i];
        __syncthreads();
        if (ntl > 0) { pg8::Gemm g{ACT8, ws + W_MDN, FF}; const int full = (ntl * (D / 256)) / G;
            { pg8::MoeOrder S{ntl, D / 256, G, bid, 0, te, true, nullptr, nullptr, full}; pg8::EpiMoeDown E{Y0, Y1, rowinfo, rowgate, 1.0f / (SC_ACT * SC_WDN)};
              pg8::gemm_phase<pg8::EpiMoeDown, pg8::MoeOrder, 0>(lds, g, S, E); }
            { pg8::MoeTailOrder S{ntl, D / 256, G, bid, full, te}; pg8::EpiMoeDownT<true> E{Y0, Y1, rowinfo, rowgate, 1.0f / (SC_ACT * SC_WDN)};
              pg8::gemm_phase<pg8::EpiMoeDownT<true>, pg8::MoeTailOrder, 0, true>(lds, g, S, E); } }
        SEAM(15);
    }
    if (IN(16)) {
        const size_t n8 = (size_t)M * D / 8;
        for (size_t i = (size_t)bid * NTHREADS + tid; i < n8; i += (size_t)G * NTHREADS) {
            const u32x4 h = *(const u32x4*)(H3B + i * 8), w0 = *(const u32x4*)(Y0 + i * 8), w1 = *(const u32x4*)(Y1 + i * 8); f32x4* o = (f32x4*)(out + i * 8);
            f32x4 a, b;
            a.x = bflo(h.x) + (bflo(w0.x) + bflo(w1.x)); a.y = bfhi(h.x) + (bfhi(w0.x) + bfhi(w1.x)); a.z = bflo(h.y) + (bflo(w0.y) + bflo(w1.y)); a.w = bfhi(h.y) + (bfhi(w0.y) + bfhi(w1.y));
            b.x = bflo(h.z) + (bflo(w0.z) + bflo(w1.z)); b.y = bfhi(h.z) + (bfhi(w0.z) + bfhi(w1.z)); b.z = bflo(h.w) + (bflo(w0.w) + bflo(w1.w)); b.w = bfhi(h.w) + (bfhi(w0.w) + bfhi(w1.w));
            o[0] = a; o[1] = b;
        }
    }
#undef IN
#undef SEAM
}

extern "C" void kernel_launch(void* const* d_in, const int* in_sizes, int n_in, void* d_out, int out_size, void* d_ws, size_t ws_size, hipStream_t stream) {
    static int grid = 0;
    if (grid == 0) {
        if (n_in != 22 || in_sizes[0] != M * D || out_size != M * D || ws_size < WS_END) {
            fprintf(stderr, "kernel_launch: unexpected shapes (n_in %d, in0 %d, out %d, ws %zu < %zu); nothing launched\n", n_in, n_in > 0 ? in_sizes[0] : -1, out_size, ws_size, (size_t)WS_END); grid = -1; return; }
        int dev = 0, cus = 0, per_cu = 0;
        if (hipGetDevice(&dev) != hipSuccess || hipDeviceGetAttribute(&cus, hipDeviceAttributeMultiprocessorCount, dev) != hipSuccess) { grid = -1; return; }
        if (hipFuncSetAttribute((const void*)enc_fwd, hipFuncAttributeMaxDynamicSharedMemorySize, LDS_BYTES) != hipSuccess) { fprintf(stderr, "kernel_launch: hipFuncSetAttribute failed\n"); grid = -1; return; }
        if (hipOccupancyMaxActiveBlocksPerMultiprocessor(&per_cu, (const void*)enc_fwd, NTHREADS, LDS_BYTES) != hipSuccess || per_cu < 1)
            fprintf(stderr, "kernel_launch: note: occupancy query reports %d workgroups per CU\n", per_cu);
        (void)hipGetLastError();
        grid = cus;
        if (grid != 256) { fprintf(stderr, "kernel_launch: built for 256 CUs, device has %d; nothing launched\n", cus); grid = -1; return; }
    }
    if (grid < 0) return;
    if (hipMemsetAsync((char*)d_ws + WS_CTL, 0, CTL_ZERO_BYTES, stream) != hipSuccess) return;
    Args a{};
    for (int i = 0; i < 22; ++i) a.in[i] = (const float*)d_in[i];
    a.out = (float*)d_out; a.ws = (unsigned char*)d_ws;
#if MK_N_LAUNCHES == 1
    a.ph_lo = 0; a.ph_hi = NPHASES;
    hipLaunchKernelGGL(enc_fwd, dim3(grid), dim3(NTHREADS), LDS_BYTES, stream, a);
#else
    for (int p = 0; p < NPHASES; ++p) { a.ph_lo = p; a.ph_hi = p + 1; hipLaunchKernelGGL(enc_fwd, dim3(grid), dim3(NTHREADS), LDS_BYTES, stream, a);
    }
#endif
}
```
